# Optimizing an MI355X kernel written in HIP

```python
import math
import jax, jax.numpy as jnp
from jax import lax
import numpy as np

D_MODEL = 1024
BATCH = 16
SEQ = 4096
DEPTH = 2
DEC_BATCH = 32
DEC_SEQ = 2048
PAST_LEN = 128

ATT_HEADS = 4
ATT_QK_DIM = 64
ATT_V_DIM = 128
ATT_WIDTH = ATT_HEADS * ATT_V_DIM
LSTM_HEADS = 4
LSTM_QK_DIM = 64
LSTM_V_DIM = 128
LSTM_WIDTH = LSTM_HEADS * LSTM_V_DIM
MIX_WIDTH = ATT_WIDTH + LSTM_WIDTH
N_GATES = 4 * LSTM_HEADS
COL_WIDTHS = (ATT_HEADS * 2 * ATT_QK_DIM,
              ATT_HEADS * 2 * ATT_QK_DIM,
              ATT_WIDTH,
              LSTM_HEADS * LSTM_QK_DIM,
              LSTM_HEADS * LSTM_QK_DIM,
              LSTM_WIDTH,
              LSTM_WIDTH,
              N_GATES)
IN_WIDTH = 512 + 512 + 512 + 256 + 256 + 512 + 512 + 16
V_COLS = ((1024, 1536), (2048, 2560))
D_FF = 2816
CONV_WIDTH = 3
Q_BLOCK = 128
CHUNK = 128
ALPHA = (2 * DEPTH) ** 0.25
BETA = (8 * DEPTH) ** -0.25
EPS = 1e-5

kernel_name = "hybrid_diffattn_mlstm_encoder"


def _split_cols(proj):
    out, start = [], 0
    for w in COL_WIDTHS:
        out.append(proj[..., start:start + w])
        start += w
    return out


def _layer_norm(x, g, b):
    xf = x.astype(jnp.float32)
    mu = jnp.mean(xf, -1, keepdims=True)
    var = jnp.mean(jnp.square(xf - mu), -1, keepdims=True)
    y = (xf - mu) * lax.rsqrt(var + EPS) * g.astype(jnp.float32) + b.astype(jnp.float32)
    return y.astype(x.dtype)


def _head_rmsnorm(h, gain):
    B, S, H, dv = h.shape
    hf = h.astype(jnp.float32)
    hf = hf * lax.rsqrt(jnp.mean(hf * hf, -1, keepdims=True) + EPS)
    return hf.reshape(B, S, H * dv) * gain.astype(jnp.float32)


def _alibi_slopes(n):
    return jnp.power(2.0, -8.0 * jnp.arange(1, n + 1, dtype=jnp.float32) / n)


def _diff_attention(q, k, v, lam):
    B, S, H, _, dk = q.shape
    dv = v.shape[-1]
    nb = S // Q_BLOCK
    qb = (q * (dk ** -0.5)).reshape(B, nb, Q_BLOCK, H, 2, dk).transpose(1, 0, 2, 3, 4, 5)
    pos_k = jnp.arange(S, dtype=jnp.float32)
    slopes = _alibi_slopes(H)

    def block(args):
        qi, start = args
        pos_q = start + jnp.arange(Q_BLOCK, dtype=jnp.float32)
        bias = -slopes[:, None, None] * jnp.abs(pos_q[:, None] - pos_k[None, :])
        s = jnp.einsum('bqhcd,bshcd->bhcqs', qi, k, preferred_element_type=jnp.float32)
        p = jax.nn.softmax(s + bias[None, :, None], axis=-1)
        a = p[:, :, 0] - lam * p[:, :, 1]
        return jnp.einsum('bhqs,bshd->bqhd', a.astype(v.dtype), v)

    starts = jnp.arange(nb, dtype=jnp.float32) * Q_BLOCK
    out = lax.map(block, (qb, starts))
    return out.transpose(1, 0, 2, 3, 4).reshape(B, S, H, dv)


def _mlstm_direction(q, k, v, ig, lf):
    B, H, S, dk = q.shape
    dv = v.shape[-1]
    L = CHUNK
    nc = S // L
    qc = q.reshape(B, H, nc, L, dk)
    kc = k.reshape(B, H, nc, L, dk)
    vc = v.reshape(B, H, nc, L, dv)
    igc = ig.reshape(B, H, nc, L)
    b = jnp.cumsum(lf.reshape(B, H, nc, L), axis=-1)
    g = b[..., -1]
    tri = jnp.tril(jnp.ones((L, L), dtype=bool))
    D = jnp.where(tri, b[..., :, None] - b[..., None, :] + igc[..., None, :], -jnp.inf)
    w_end = g[..., None] - b + igc
    m_loc = jnp.max(w_end, -1)
    e_end = jnp.exp(w_end - m_loc[..., None])
    ke = kc.astype(jnp.float32) * e_end[..., None]
    C_loc = jnp.einsum('bhcld,bhcle->bhcde', ke, vc.astype(jnp.float32))
    n_loc = jnp.sum(ke, axis=3)

    def step(carry, inp):
        C, n, m = carry
        Cl, nl, ml, gc = inp
        m_new = jnp.maximum(gc + m, ml)
        a = jnp.exp(gc + m - m_new)
        bb = jnp.exp(ml - m_new)
        C_new = a[..., None, None] * C + bb[..., None, None] * Cl
        n_new = a[..., None] * n + bb[..., None] * nl
        return (C_new, n_new, m_new), (C, n, m)

    init = (jnp.zeros((B, H, dk, dv), jnp.float32), jnp.zeros((B, H, dk), jnp.float32),
            jnp.zeros((B, H), jnp.float32))
    xs = (jnp.moveaxis(C_loc, 2, 0), jnp.moveaxis(n_loc, 2, 0),
          jnp.moveaxis(m_loc, 2, 0), jnp.moveaxis(g, 2, 0))
    _, (C_prev, n_prev, m_prev) = lax.scan(step, init, xs)
    C_prev = jnp.moveaxis(C_prev, 0, 2)
    n_prev = jnp.moveaxis(n_prev, 0, 2)
    m_prev = jnp.moveaxis(m_prev, 0, 2)

    inter_log = b + m_prev[..., None]
    m_out = jnp.maximum(inter_log, jnp.max(D, -1))
    e_inter = jnp.exp(inter_log - m_out)
    P = jnp.exp(D - m_out[..., None])
    qf = qc.astype(jnp.float32)
    sqk = jnp.einsum('bhcjd,bhcsd->bhcjs', qf, kc.astype(jnp.float32)) * P
    num = (e_inter[..., None] * jnp.einsum('bhcjd,bhcde->bhcje', qf, C_prev)
           + jnp.einsum('bhcjs,bhcse->bhcje', sqk, vc.astype(jnp.float32)))
    den = e_inter * jnp.einsum('bhcjd,bhcd->bhcj', qf, n_prev) + jnp.sum(sqk, -1)
    h = num / jnp.maximum(jnp.abs(den), jnp.exp(-m_out))[..., None]
    return h.reshape(B, H, S, dv)


def _mixer(x, w_in, gate_bias, lam_q1, lam_k1, lam_q2, lam_k2, att_g, lstm_g, w_out, lam_init):
    B, S, _ = x.shape
    aq, ak, av, lq, lk, lv, lo, lg = _split_cols(x @ w_in)
    lam = (jnp.exp(jnp.sum(lam_q1.astype(jnp.float32) * lam_k1.astype(jnp.float32)))
           - jnp.exp(jnp.sum(lam_q2.astype(jnp.float32) * lam_k2.astype(jnp.float32))) + lam_init)
    att = _diff_attention(aq.reshape(B, S, ATT_HEADS, 2, ATT_QK_DIM),
                          ak.reshape(B, S, ATT_HEADS, 2, ATT_QK_DIM),
                          av.reshape(B, S, ATT_HEADS, ATT_V_DIM), lam)
    att = _head_rmsnorm(att, att_g) * (1.0 - lam_init)
    q = lq.reshape(B, S, LSTM_HEADS, LSTM_QK_DIM).transpose(0, 2, 1, 3)
    k = (lk.reshape(B, S, LSTM_HEADS, LSTM_QK_DIM) * (LSTM_QK_DIM ** -0.5)).transpose(0, 2, 1, 3)
    v = lv.reshape(B, S, LSTM_HEADS, LSTM_V_DIM).transpose(0, 2, 1, 3)
    gates = (lg.astype(jnp.float32) + gate_bias.astype(jnp.float32)).reshape(B, S, 4, LSTM_HEADS)
    gates = gates.transpose(2, 0, 3, 1)
    ig_f, lf_f = gates[0], jax.nn.log_sigmoid(gates[1])
    ig_b, lf_b = gates[2], jax.nn.log_sigmoid(gates[3])
    h_f = _mlstm_direction(q, k, v, ig_f, lf_f)
    fl = lambda t: jnp.flip(t, axis=2)
    h_b = fl(_mlstm_direction(fl(q), fl(k), fl(v), fl(ig_b), fl(lf_b)))
    h = (h_f + h_b).transpose(0, 2, 1, 3)
    lstm = jax.nn.sigmoid(lo.astype(jnp.float32)) * _head_rmsnorm(h, lstm_g)
    mixed = jnp.concatenate([att, lstm], axis=-1).astype(x.dtype)
    return mixed @ w_out


def _conv_ffn(x, w_gu, conv_w, conv_b, w_down):
    S = x.shape[1]
    gu = x @ w_gu
    gate, up = gu[..., :D_FF], gu[..., D_FF:]
    half = CONV_WIDTH // 2
    gp = jnp.pad(gate, ((0, 0), (half, half), (0, 0)))
    conv = conv_b.astype(gate.dtype) + sum(gp[:, j:j + S] * conv_w[j] for j in range(CONV_WIDTH))
    hmid = jax.nn.gelu(conv.astype(jnp.float32), approximate=False) * up.astype(jnp.float32)
    return hmid.astype(x.dtype) @ w_down


def _trunk(x, w_in, gate_bias, lam_q1, lam_k1, lam_q2, lam_k2, att_norm_g, lstm_norm_g, w_out,
           ln1_g, ln1_b, w_gu, conv_w, conv_b, w_down, ln2_g, ln2_b):
    for l in range(DEPTH):
        lam_init = 0.8 - 0.6 * math.exp(-0.3 * l)
        mix = _mixer(x, w_in[l], gate_bias[l], lam_q1[l], lam_k1[l], lam_q2[l], lam_k2[l],
                     att_norm_g[l], lstm_norm_g[l], w_out[l], lam_init)
        x = _layer_norm(ALPHA * x + mix.astype(x.dtype), ln1_g[l], ln1_b[l])
        ffn = _conv_ffn(x, w_gu[l], conv_w[l], conv_b[l], w_down[l])
        x = _layer_norm(ALPHA * x + ffn.astype(x.dtype), ln2_g[l], ln2_b[l])
    return x


def setup_inputs(seed: int = 0) -> dict:
    key = jax.random.key(seed)
    ks = jax.random.split(key, 20)
    f32 = jnp.float32
    nrm = lambda k, shape: jax.random.normal(k, shape, f32)
    col = jnp.arange(IN_WIDTH)
    v_mask = ((col >= V_COLS[0][0]) & (col < V_COLS[0][1])) | ((col >= V_COLS[1][0]) & (col < V_COLS[1][1]))
    col_scale = jnp.where(v_mask, BETA, 1.0).astype(f32)
    w_in = nrm(ks[2], (DEPTH, D_MODEL, IN_WIDTH)) * (D_MODEL ** -0.5) * col_scale
    f_off = jnp.linspace(3.0, 6.0, LSTM_HEADS, dtype=f32)
    zero_h = jnp.zeros((LSTM_HEADS,), f32)
    gate_off = jnp.concatenate([zero_h, f_off, zero_h, f_off])
    gate_bias = gate_off + 0.1 * nrm(ks[3], (DEPTH, N_GATES))
    return {
        "x_prompt": nrm(ks[0], (BATCH, SEQ, D_MODEL)),
        "x_sample": nrm(ks[1], (DEC_BATCH, DEC_SEQ, D_MODEL)),
        "w_in": w_in,
        "gate_bias": gate_bias,
        "lam_q1": 0.1 * nrm(ks[4], (DEPTH, ATT_QK_DIM)),
        "lam_k1": 0.1 * nrm(ks[5], (DEPTH, ATT_QK_DIM)),
        "lam_q2": 0.1 * nrm(ks[6], (DEPTH, ATT_QK_DIM)),
        "lam_k2": 0.1 * nrm(ks[7], (DEPTH, ATT_QK_DIM)),
        "att_norm_g": 1.0 + 0.02 * nrm(ks[8], (DEPTH, ATT_WIDTH)),
        "lstm_norm_g": 1.0 + 0.02 * nrm(ks[9], (DEPTH, LSTM_WIDTH)),
        "w_out": nrm(ks[10], (DEPTH, MIX_WIDTH, D_MODEL)) * (MIX_WIDTH ** -0.5) * BETA,
        "ln1_g": 1.0 + 0.02 * nrm(ks[11], (DEPTH, D_MODEL)),
        "ln1_b": 0.02 * nrm(ks[12], (DEPTH, D_MODEL)),
        "w_gu": nrm(ks[13], (DEPTH, D_MODEL, 2 * D_FF)) * (D_MODEL ** -0.5) * BETA,
        "conv_w": nrm(ks[14], (DEPTH, CONV_WIDTH, D_FF)) * (CONV_WIDTH ** -0.5),
        "conv_b": 0.02 * nrm(ks[15], (DEPTH, D_FF)),
        "w_down": nrm(ks[16], (DEPTH, D_FF, D_MODEL)) * (D_FF ** -0.5) * BETA,
        "ln2_g": 1.0 + 0.02 * nrm(ks[17], (DEPTH, D_MODEL)),
        "ln2_b": 0.02 * nrm(ks[18], (DEPTH, D_MODEL)),
    }


def reference(x_prompt, x_sample, w_in, gate_bias, lam_q1, lam_k1, lam_q2, lam_k2, att_norm_g,
              lstm_norm_g, w_out, ln1_g, ln1_b, w_gu, conv_w, conv_b, w_down, ln2_g, ln2_b):
    y_prompt = _trunk(x_prompt, w_in, gate_bias, lam_q1, lam_k1, lam_q2, lam_k2, att_norm_g, lstm_norm_g,
                      w_out, ln1_g, ln1_b, w_gu, conv_w, conv_b, w_down, ln2_g, ln2_b)
    y_sample = _trunk(x_sample, w_in, gate_bias, lam_q1, lam_k1, lam_q2, lam_k2, att_norm_g, lstm_norm_g,
                      w_out, ln1_g, ln1_b, w_gu, conv_w, conv_b, w_down, ln2_g, ln2_b)
    return (y_prompt, y_sample)
```

```cpp
#include <hip/hip_runtime.h>
#include <hip/hip_cooperative_groups.h>
#include <cstdio>
#include <cstdint>
namespace cg = cooperative_groups;

#ifndef PHMASK
#define PHMASK 0xffff
#endif
#ifndef MK_MULTI
#define MK_MULTI 1
#endif

#define LAS __attribute__((address_space(3)))
typedef unsigned short bf16_t;
typedef short bf16x8 __attribute__((ext_vector_type(8)));
typedef short s16x4 __attribute__((ext_vector_type(4)));
typedef float f32x2 __attribute__((ext_vector_type(2)));
typedef float f32x4 __attribute__((ext_vector_type(4)));
typedef float f32x8 __attribute__((ext_vector_type(8)));
typedef float f32x16 __attribute__((ext_vector_type(16)));
typedef unsigned u32x2 __attribute__((ext_vector_type(2)));
typedef unsigned u32x4 __attribute__((ext_vector_type(4)));

constexpr int DM = 1024, NPROJ = 3072, NPROJ_PAD = 3328, NIN = 3088, DFF = 2816, NGU = 5632;
constexpr int MT = 65536;
constexpr float ALPHA = 1.4142135623730951f, EPS = 1e-5f;
constexpr int LDS_BYTES = 147456;
constexpr int EPI_LDS = 131072;

constexpr size_t MiB = 1u << 20;
constexpr size_t WS_CTL = 0, CTL_BYTES = 1 * MiB;
constexpr size_t CTL_C1IN = 65536, CTL_C2IN = 81920, CTL_C1GU = 98304, CTL_C2GU = 147456;
constexpr size_t WS_LAM = 1 * MiB;
constexpr size_t WS_WIN = 2 * MiB, WS_WOUT = 15 * MiB, WS_WGU = 19 * MiB, WS_WDN = 41 * MiB;
constexpr size_t WS_ST1 = 52 * MiB, WS_ST2 = 54 * MiB, WS_GATES = 56 * MiB, WS_EDGE = 60 * MiB;
constexpr size_t WS_XB = 80 * MiB, WS_MIXED = 208 * MiB, WS_PROJ = 336 * MiB, WS_END = 720 * MiB;

__device__ __forceinline__ unsigned cvt_pk_bf16(float lo, float hi) { unsigned r; asm volatile("v_cvt_pk_bf16_f32 %0, %1, %2" : "=v"(r) : "v"(lo), "v"(hi)); return r; }
__device__ __forceinline__ float bf2f(bf16_t b) { return __uint_as_float(((unsigned)b) << 16); }
__device__ __forceinline__ bf16_t f2bf(float f) { return (bf16_t)(cvt_pk_bf16(f, 0.f) & 0xffffu); }
__device__ __forceinline__ float gelu_erf(float v) {
    const float av = fabsf(v), t = __builtin_amdgcn_rcpf(av * 0.2316418882f + 1.0f);
    float q = t * 0.5307027145f + (-0.7265760135f); q = q * t + 0.7107068705f; q = q * t + (-0.142248368f); q = q * t + 0.127414796f; q = q * t;
    const float e = __builtin_amdgcn_exp2f((v * v) * (-0.72134752044f));
    const float m = v * (q * e);
    return v < 0.f ? m : v - m;
}
__device__ __forceinline__ int crow(int r, int hi) { return (r & 3) + 8 * (r >> 2) + 4 * hi; }
#define EPI_BAR() do { asm volatile("s_waitcnt lgkmcnt(0)" ::: "memory"); __builtin_amdgcn_s_barrier(); asm volatile("" ::: "memory"); } while (0)
#define SBAR() __builtin_amdgcn_sched_barrier(0)
__device__ __forceinline__ int opaque_tid() { int t = threadIdx.x; asm volatile("" : "+v"(t)); return t; }

namespace pg8 {
constexpr int BM = 256, BK = 64, HALF = 128, HTB = HALF * BK * 2, STAGE_BYTES = 8 * HTB, NXCD = 8, WGM = 8;
__host__ __device__ __forceinline__ int lds_byte(int r, int c) { const int st = (r >> 4) * 2 + (c >> 5), rr = r & 15, cc = c & 31, ob = rr * 64 + cc * 2; return st * 1024 + (ob ^ (((ob >> 9) & 1) << 5)); }
__host__ __device__ __forceinline__ void stage_rc(int b, int& R, int& C) { const int st = b / 1024, sb = b % 1024, swz = sb ^ (((sb >> 9) & 1) << 5); R = (st >> 1) * 16 + swz / 64; C = (st & 1) * 32 + (swz % 64) / 2; }
__host__ __device__ __forceinline__ int perm32(int rho) { const int n = rho >> 4, i = rho & 15; return 8 * (i >> 2) + 4 * n + (i & 3); }
struct Unit { int pm, pn; };
struct Gemm { const bf16_t* A; const bf16_t* Bt; int M, N, K; };
struct StaticOrder {
    int nM, nN, nwg, G, c;
    __host__ __device__ void init(int M, int N, int G_, int c_) { nM = M / BM; nN = N / BM; nwg = nM * nN; G = G_; c = c_; }
    __host__ __device__ bool next(int i, Unit& u) const {
        const long L = (long)i * G + c; if (L >= nwg) return false;
        int wgid = (int)L; { const int q = nwg / NXCD, r = nwg % NXCD, xcd = wgid % NXCD, off = wgid / NXCD; wgid = (xcd < r ? xcd * (q + 1) : r * (q + 1) + (xcd - r) * q) + off; }
        const int nig = WGM * nN, gid = wgid / nig, fm = gid * WGM, gsz = (nM - fm) < WGM ? (nM - fm) : WGM;
        u.pm = fm + ((wgid % nig) % gsz); u.pn = (wgid % nig) / gsz; return true;
    }
    __device__ __forceinline__ void a_ready(const Unit&) const {}
    __device__ __forceinline__ void done(const Unit&) const {}
};

template <class Epi, class Sched>
__device__ __forceinline__ void gemm_phase(LAS unsigned char* lds, const Gemm g, const Sched& S, const Epi& E) {
    const int tid = opaque_tid(), wid = __builtin_amdgcn_readfirstlane(tid >> 6), lane = tid & 63, wr = wid >> 2, wc = wid & 3, fr = lane & 15, fq = lane >> 4;
    const int K = g.K, nt = K / BK;
    unsigned voffA[2], voffB[2];
#pragma unroll
    for (int i = 0; i < 2; ++i) { int R, C; stage_rc(tid * 16 + i * 8192, R, C); const int Rb = Epi::PERM ? ((R & ~31) + perm32(R & 31)) : R;
        voffA[i] = (unsigned)(R * K + C) * 2u; voffB[i] = (unsigned)(Rb * K + C) * 2u; }
    const size_t kstep = (size_t)(BK * 2);
    const size_t hstep = (size_t)HALF * K * 2;
    const size_t tstep = 2 * hstep;
    const unsigned ldsw = (unsigned)wid * 1024u;
    const int aoff = lds_byte(wr * 64 + fr, fq * 8), boff = lds_byte(wc * 32 + fr, fq * 8);
#define PG8_SA(b, h) (((b) * 2 + (h)) * HTB)
#define PG8_SB(b, h) ((4 + (b) * 2 + (h)) * HTB)
#define PG8_STAGE(bufoff, gbase, voff) do { _Pragma("unroll") for (int _i = 0; _i < 2; ++_i) \
        __builtin_amdgcn_global_load_lds((const unsigned*)((const char*)(gbase) + (voff)[_i]), (LAS unsigned*)(lds + (bufoff) + ldsw + _i * 8192), 16, 0, 0); } while (0)
#define PG8_LDA(dst, b, h) do { _Pragma("unroll") for (int m = 0; m < 4; ++m) _Pragma("unroll") for (int k = 0; k < 2; ++k) dst[m][k] = *(const LAS bf16x8*)(lds + PG8_SA(b, h) + aoff + m * 2048 + k * 1024); } while (0)
#define PG8_LDB(dst, b, h) do { _Pragma("unroll") for (int n = 0; n < 2; ++n) _Pragma("unroll") for (int k = 0; k < 2; ++k) dst[n][k] = *(const LAS bf16x8*)(lds + PG8_SB(b, h) + boff + n * 2048 + k * 1024); } while (0)
#define PG8_MMA(ai, bj, At, Bt) do { __builtin_amdgcn_s_setprio(1); _Pragma("unroll") for (int m = 0; m < 4; ++m) _Pragma("unroll") for (int n = 0; n < 2; ++n) _Pragma("unroll") for (int k = 0; k < 2; ++k) \
        acc[ai][bj][m][n] = __builtin_amdgcn_mfma_f32_16x16x32_bf16(Bt[n][k], At[m][k], acc[ai][bj][m][n], 0, 0, 0); __builtin_amdgcn_s_setprio(0); } while (0)
#define PG8_WAIT_V(n) asm volatile("s_waitcnt vmcnt(" #n ")" ::: "memory")
#define PG8_WAIT_L(n) asm volatile("s_waitcnt lgkmcnt(" #n ")" ::: "memory")
#define PG8_BAR __builtin_amdgcn_s_barrier()
#define PG8_SCHED __builtin_amdgcn_sched_barrier(0)
    Unit cur, nxt; int ui = 0;
    if (!S.next(0, cur)) return;
    f32x4 acc[2][2][4][2];
#pragma unroll
    for (int a = 0; a < 2; ++a)
#pragma unroll
        for (int b = 0; b < 2; ++b)
#pragma unroll
            for (int m = 0; m < 4; ++m)
#pragma unroll
                for (int n = 0; n < 2; ++n) acc[a][b][m][n] = (f32x4){0.f, 0.f, 0.f, 0.f};
    bf16x8 At[4][2], B0[2][2], B1[2][2];
    const char* cA = (const char*)g.A + (size_t)cur.pm * tstep; const char* cB = (const char*)g.Bt + (size_t)cur.pn * tstep;
    PG8_STAGE(PG8_SB(0, 0), cB, voffB); PG8_STAGE(PG8_SB(0, 1), cB + hstep, voffB); PG8_STAGE(PG8_SA(0, 0), cA, voffA); PG8_STAGE(PG8_SA(0, 1), cA + hstep, voffA);
    if (wr == 1) PG8_BAR;
    PG8_WAIT_V(2); PG8_BAR;
    PG8_STAGE(PG8_SB(1, 0), cB + kstep, voffB); PG8_STAGE(PG8_SA(1, 0), cA + kstep, voffA); PG8_STAGE(PG8_SB(1, 1), cB + hstep + kstep, voffB);
    PG8_WAIT_V(6); PG8_BAR;
    for (;;) {
        const bool has_next = S.next(ui + 1, nxt);
        const char* nA = has_next ? (const char*)g.A + (size_t)nxt.pm * tstep : cA; const char* nB = has_next ? (const char*)g.Bt + (size_t)nxt.pn * tstep : cB;
        for (int t = 0; t < nt; t += 2) {
            const bool last = (t == nt - 2);
            const char* a1 = cA + (size_t)(t + 1) * kstep;
            const char* a2 = last ? nA : cA + (size_t)(t + 2) * kstep; const char* b2 = last ? nB : cB + (size_t)(t + 2) * kstep;
            const char* a3 = a2 + kstep; const char* b3 = b2 + kstep;
            PG8_LDB(B0, 0, 0); PG8_LDB(B1, 0, 1); PG8_SCHED; PG8_LDA(At, 0, 0); PG8_STAGE(PG8_SA(1, 1), a1 + hstep, voffA);
            PG8_WAIT_V(8); PG8_WAIT_L(0); PG8_BAR; PG8_MMA(0, 0, At, B0); PG8_MMA(0, 1, At, B1); PG8_BAR; PG8_SCHED;
            PG8_LDA(At, 0, 1); PG8_STAGE(PG8_SB(0, 0), b2, voffB); PG8_STAGE(PG8_SB(0, 1), b2 + hstep, voffB); PG8_STAGE(PG8_SA(0, 0), a2, voffA);
            PG8_WAIT_V(8); PG8_WAIT_L(0); PG8_BAR; PG8_MMA(1, 0, At, B0); PG8_MMA(1, 1, At, B1); PG8_BAR; PG8_SCHED;
            PG8_LDB(B0, 1, 0); PG8_LDB(B1, 1, 1); PG8_SCHED; PG8_LDA(At, 1, 0); PG8_STAGE(PG8_SA(0, 1), a2 + hstep, voffA);
            PG8_WAIT_V(8); PG8_WAIT_L(0); PG8_BAR; PG8_MMA(0, 0, At, B0); PG8_MMA(0, 1, At, B1); PG8_BAR; PG8_SCHED;
            PG8_LDA(At, 1, 1); PG8_STAGE(PG8_SB(1, 0), b3, voffB); PG8_STAGE(PG8_SB(1, 1), b3 + hstep, voffB); PG8_STAGE(PG8_SA(1, 0), a3, voffA);
            PG8_WAIT_V(8); PG8_WAIT_L(0); PG8_BAR; PG8_MMA(1, 0, At, B0); PG8_MMA(1, 1, At, B1); PG8_BAR; PG8_SCHED;
        }
        if (wr == 0) PG8_BAR;
        E(acc, cur, wr, wc, fr, fq);
        if (!has_next) break;
#pragma unroll
        for (int a = 0; a < 2; ++a)
#pragma unroll
            for (int b = 0; b < 2; ++b)
#pragma unroll
                for (int m = 0; m < 4; ++m)
#pragma unroll
                    for (int n = 0; n < 2; ++n) acc[a][b][m][n] = (f32x4){0.f, 0.f, 0.f, 0.f};
        cur = nxt; cA = nA; cB = nB; ++ui;
        if (wr == 1) PG8_BAR;
    }
    PG8_WAIT_V(0);
    PG8_BAR;
#undef PG8_SA
#undef PG8_SB
#undef PG8_STAGE
#undef PG8_LDA
#undef PG8_LDB
#undef PG8_MMA
#undef PG8_WAIT_V
#undef PG8_WAIT_L
#undef PG8_BAR
#undef PG8_SCHED
}
}

__device__ __forceinline__ void row_stats(const f32x2* st, int row, float& mu, float& rstd) {
    const f32x4 a = *(const f32x4*)(st + (size_t)row * 4), b = *(const f32x4*)(st + (size_t)row * 4 + 2);
    const float s = (a[0] + a[2]) + (b[0] + b[2]), q = (a[1] + a[3]) + (b[1] + b[3]);
    mu = s * (1.f / 1024.f); const float var = fmaxf(q * (1.f / 1024.f) - mu * mu, 0.f); rstd = rsqrtf(var + EPS);
}

__device__ __forceinline__ void tile_stats_to_lds(const f32x2* st, int row0, LAS f32x2* S, int tid) {
    if (tid < 256) { float mu, rstd; row_stats(st, row0 + tid, mu, rstd); S[tid] = (f32x2){mu, rstd}; }
    EPI_BAR();
}
struct EpiProj {
    static constexpr bool PERM = true;
    bf16_t* O; float* gates; const float* gate_bias; const f32x2* stats; const float* c1; const float* c2; LAS f32x2* S;
    __device__ __forceinline__ void operator()(f32x4 (&acc)[2][2][4][2], const pg8::Unit& u, int wr, int wc, int fr, int fq) const {
        asm volatile("" : "+v"(fr), "+v"(fq));
        const int colt = u.pn * 256 + wc * 32 + 8 * fq;
        if (stats) tile_stats_to_lds(stats, u.pm * 256, S, (wr * 4 + wc) * 64 + fq * 16 + fr);
        f32x4 c1v[2][2], c2v[2][2];
#pragma unroll
        for (int bj = 0; bj < 2; ++bj)
#pragma unroll
            for (int n = 0; n < 2; ++n) {
                if (stats) { c1v[bj][n] = *(const f32x4*)(c1 + colt + bj * 128 + 4 * n); c2v[bj][n] = *(const f32x4*)(c2 + colt + bj * 128 + 4 * n); }
                else { c1v[bj][n] = (f32x4){0.f, 0.f, 0.f, 0.f}; c2v[bj][n] = (f32x4){0.f, 0.f, 0.f, 0.f}; } }
        const float sc = (u.pn < 2 || u.pn == 7) ? 0.125f : 1.0f;
#pragma unroll
        for (int ai = 0; ai < 2; ++ai)
#pragma unroll
            for (int m = 0; m < 4; ++m) {
                const int row = u.pm * 256 + ai * 128 + wr * 64 + m * 16 + fr;
                float mu = 0.f, rstd = 1.f; if (stats) { const f32x2 sr = S[ai * 128 + wr * 64 + m * 16 + fr]; mu = sr.x; rstd = sr.y; }
                if (u.pn < 12) {
#pragma unroll
                    for (int bj = 0; bj < 2; ++bj) {
                        const f32x4 v0 = ((acc[ai][bj][m][0] - mu * c1v[bj][0]) * rstd + c2v[bj][0]) * sc, v1 = ((acc[ai][bj][m][1] - mu * c1v[bj][1]) * rstd + c2v[bj][1]) * sc;
                        u32x4 w; w.x = cvt_pk_bf16(v0[0], v0[1]); w.y = cvt_pk_bf16(v0[2], v0[3]); w.z = cvt_pk_bf16(v1[0], v1[1]); w.w = cvt_pk_bf16(v1[2], v1[3]);
                        *(u32x4*)(O + (size_t)row * NPROJ + colt + bj * 128) = w; }
                } else if (wc == 0 && fq < 2) {
#pragma unroll
                    for (int n = 0; n < 2; ++n) {
                        const f32x4 gb = *(const f32x4*)(gate_bias + 8 * fq + 4 * n);
                        *(f32x4*)(gates + (size_t)row * 16 + 8 * fq + 4 * n) = (acc[ai][0][m][n] - mu * c1v[0][n]) * rstd + c2v[0][n] + gb; }
                }
            }
    }
};

struct EpiRes {
    static constexpr bool PERM = false;
    const float* xin; float* v; const f32x2* st_in; const float* g_in; const float* b_in; f32x2* st_out; bf16_t* xb; LAS f32x2* P; LAS f32x2* S;
    __device__ __forceinline__ void operator()(f32x4 (&acc)[2][2][4][2], const pg8::Unit& u, int wr, int wc, int fr, int fq) const {
        asm volatile("" : "+v"(fr), "+v"(fq));
        const int colb = u.pn * 256 + wc * 32 + 4 * fq;
        if (!xin) tile_stats_to_lds(st_in, u.pm * 256, S, (wr * 4 + wc) * 64 + fq * 16 + fr);
        f32x4 gv[2][2], bv[2][2];
#pragma unroll
        for (int bj = 0; bj < 2; ++bj)
#pragma unroll
            for (int n = 0; n < 2; ++n) {
                if (!xin) { gv[bj][n] = *(const f32x4*)(g_in + colb + bj * 128 + n * 16); bv[bj][n] = *(const f32x4*)(b_in + colb + bj * 128 + n * 16); }
                else { gv[bj][n] = (f32x4){1.f, 1.f, 1.f, 1.f}; bv[bj][n] = (f32x4){0.f, 0.f, 0.f, 0.f}; } }
#pragma unroll
        for (int ai = 0; ai < 2; ++ai)
#pragma unroll
            for (int m = 0; m < 4; ++m) {
                const int rl = ai * 128 + wr * 64 + m * 16 + fr; const int row = u.pm * 256 + rl;
                float mu = 0.f, rstd = 1.f; if (!xin) { const f32x2 sr = S[rl]; mu = sr.x; rstd = sr.y; }
                const float* src = xin ? xin : v;
                float s = 0.f, q = 0.f;
#pragma unroll
                for (int bj = 0; bj < 2; ++bj)
#pragma unroll
                    for (int n = 0; n < 2; ++n) {
                        const size_t off = (size_t)row * DM + colb + bj * 128 + n * 16;
                        const f32x4 xv = *(const f32x4*)(src + off);
                        const f32x4 xp = (xv - mu) * rstd * gv[bj][n] + bv[bj][n];
                        const f32x4 o = xp * ALPHA + acc[ai][bj][m][n];
                        *(f32x4*)(v + off) = o;
                        if (xb) { u32x2 w; w.x = cvt_pk_bf16(o[0], o[1]); w.y = cvt_pk_bf16(o[2], o[3]); *(u32x2*)(xb + off) = w; }
                        s += (o[0] + o[1]) + (o[2] + o[3]); q += (o[0] * o[0] + o[1] * o[1]) + (o[2] * o[2] + o[3] * o[3]);
                    }
                s += __shfl_xor(s, 16); s += __shfl_xor(s, 32); q += __shfl_xor(q, 16); q += __shfl_xor(q, 32);
                if (fq == 0) P[rl * 4 + wc] = (f32x2){s, q};
            }
        EPI_BAR();
        const int tid = (wr * 4 + wc) * 64 + fq * 16 + fr;
        if (tid < 256) {
            const f32x2 a = P[tid * 4 + 0], b = P[tid * 4 + 1], c = P[tid * 4 + 2], d = P[tid * 4 + 3];
            st_out[(size_t)(u.pm * 256 + tid) * 4 + u.pn] = (f32x2){(a.x + b.x) + (c.x + d.x), (a.y + b.y) + (c.y + d.y)};
        }
    }
};

struct EpiGU {
    static constexpr bool PERM = false;
    bf16_t* hmid; float* edge; const f32x2* stats; const float* c1; const float* c2; const float* cw; const float* cb; LAS float* halo; LAS f32x2* S;
    __device__ __forceinline__ void operator()(f32x4 (&acc)[2][2][4][2], const pg8::Unit& u, int wr, int wc, int fr, int fq) const {
        asm volatile("" : "+v"(fr), "+v"(fq));
        const int colb = wc * 32 + 4 * fq; const int lane = fq * 16 + fr;
        const int jch0 = u.pn * 128 + colb;
        tile_stats_to_lds(stats, u.pm * 256, S, (wr * 4 + wc) * 64 + lane);
        u32x2 gk[2][4][2], uk[2][4][2];
        {
            f32x4 c1v[2][2], c2v[2][2];
#pragma unroll
            for (int bj = 0; bj < 2; ++bj)
#pragma unroll
                for (int n = 0; n < 2; ++n) { c1v[bj][n] = *(const f32x4*)(c1 + u.pn * 256 + bj * 128 + colb + 16 * n); c2v[bj][n] = *(const f32x4*)(c2 + u.pn * 256 + bj * 128 + colb + 16 * n); }
#pragma unroll
            for (int ai = 0; ai < 2; ++ai)
#pragma unroll
                for (int m = 0; m < 4; ++m) {
                    const f32x2 sr = S[ai * 128 + wr * 64 + m * 16 + fr]; const float mu = sr.x, rstd = sr.y;
                    const int blk = ai * 2 + wr;
#pragma unroll
                    for (int n = 0; n < 2; ++n) {
                        const f32x4 gv = (acc[ai][0][m][n] - mu * c1v[0][n]) * rstd + c2v[0][n];
                        const f32x4 uv = (acc[ai][1][m][n] - mu * c1v[1][n]) * rstd + c2v[1][n];
                        gk[ai][m][n].x = cvt_pk_bf16(gv[0], gv[1]); gk[ai][m][n].y = cvt_pk_bf16(gv[2], gv[3]);
                        uk[ai][m][n].x = cvt_pk_bf16(uv[0], uv[1]); uk[ai][m][n].y = cvt_pk_bf16(uv[2], uv[3]);
                        if (m == 0) {
                            if (fr == 0) *(LAS u32x2*)(halo + (blk * 2 + 0) * 128 + (colb + 16 * n) / 2) = gk[ai][m][n];
                            if (ai == 0 && wr == 0 && fr <= 1) *(f32x4*)(edge + ((size_t)u.pm * 6 + fr) * DFF + jch0 + 16 * n) = gv;
                            if (ai == 0 && wr == 0 && fr == 0) *(f32x4*)(edge + ((size_t)u.pm * 6 + 4) * DFF + jch0 + 16 * n) = uv;
                        }
                        if (m == 3) {
                            if (fr == 15) *(LAS u32x2*)(halo + (blk * 2 + 1) * 128 + (colb + 16 * n) / 2) = gk[ai][m][n];
                            if (ai == 1 && wr == 1 && fr >= 14) *(f32x4*)(edge + ((size_t)u.pm * 6 + 2 + (fr - 14)) * DFF + jch0 + 16 * n) = gv;
                            if (ai == 1 && wr == 1 && fr == 15) *(f32x4*)(edge + ((size_t)u.pm * 6 + 5) * DFF + jch0 + 16 * n) = uv;
                        }
                    }
                    SBAR();
                }
        }
        EPI_BAR(); SBAR();
#define BLO(x) __uint_as_float((x) << 16)
#define BHI(x) __uint_as_float((x) & 0xffff0000u)
#pragma unroll
        for (int n = 0; n < 2; ++n) {
            const f32x4 w0 = *(const f32x4*)(cw + jch0 + 16 * n), w1 = *(const f32x4*)(cw + DFF + jch0 + 16 * n), w2 = *(const f32x4*)(cw + 2 * DFF + jch0 + 16 * n), cbv = *(const f32x4*)(cb + jch0 + 16 * n);
#pragma unroll
            for (int ai = 0; ai < 2; ++ai) {
                const int blk = ai * 2 + wr;
                u32x2 top = (u32x2){0u, 0u}, bot = (u32x2){0u, 0u};
                if (blk > 0) top = *(const LAS u32x2*)(halo + ((blk - 1) * 2 + 1) * 128 + (colb + 16 * n) / 2);
                if (blk < 3) bot = *(const LAS u32x2*)(halo + ((blk + 1) * 2 + 0) * 128 + (colb + 16 * n) / 2);
                u32x2 hk[4];
#pragma unroll
                for (int w = 0; w < 2; ++w) {
                    unsigned a_[4], b_[4], c_[4], d_[4];
#pragma unroll
                    for (int m = 0; m < 4; ++m) { const unsigned gv = gk[ai][m][n][w];
                        a_[m] = (unsigned)__shfl((int)gv, (lane - 1) & 63); b_[m] = (unsigned)__shfl((int)gv, (lane + 15) & 63);
                        c_[m] = (unsigned)__shfl((int)gv, (lane + 1) & 63); d_[m] = (unsigned)__shfl((int)gv, (lane - 15) & 63); }
#pragma unroll
                    for (int m = 0; m < 4; ++m) {
                        const unsigned prev = (fr > 0) ? a_[m] : (m > 0 ? b_[m > 0 ? m - 1 : 0] : top[w]);
                        const unsigned next = (fr < 15) ? c_[m] : (m < 3 ? d_[m < 3 ? m + 1 : 3] : bot[w]);
                        const unsigned cur = gk[ai][m][n][w], upw = uk[ai][m][n][w];
                        const float cv0 = cbv[2 * w] + w0[2 * w] * BLO(prev) + w1[2 * w] * BLO(cur) + w2[2 * w] * BLO(next);
                        const float cv1 = cbv[2 * w + 1] + w0[2 * w + 1] * BHI(prev) + w1[2 * w + 1] * BHI(cur) + w2[2 * w + 1] * BHI(next);
                        hk[m][w] = cvt_pk_bf16(gelu_erf(cv0) * BLO(upw), gelu_erf(cv1) * BHI(upw));
                    }
                    SBAR();
                }
#pragma unroll
                for (int m = 0; m < 4; ++m) {
                    const int rl = ai * 128 + wr * 64 + m * 16 + fr;
                    if (rl != 0 && rl != 255) *(u32x2*)(hmid + (size_t)(u.pm * 256 + rl) * DFF + jch0 + 16 * n) = hk[m];
                }
                SBAR();
            }
        }
#undef BLO
#undef BHI
    }
};

namespace att {
constexpr int KVBLK = 64, SHM_V = 16384, SHM_K = 16384, WS_OFF = 73728, OB_PITCH = 132;
constexpr float THR = 8.f;
#define KSWZ(row, colB) ((row) * 256 + ((colB) ^ (((row) & 7) << 4)))
__device__ __forceinline__ void alibi(f32x16& p0, f32x16& p1, float t0, float nslope) {
#pragma unroll
    for (int r = 0; r < 16; ++r) { const float kr = (float)((r & 3) + 8 * (r >> 2));
        p0[r] = fmaf(nslope, fabsf(t0 - kr), p0[r]); p1[r] = fmaf(nslope, fabsf(t0 - kr - 32.f), p1[r]); }
}
__device__ __forceinline__ void partialSM(f32x16& p0, f32x16& p1, float& m_reg, float& mn, float& alpha) {
    constexpr float C = 1.4426950408889634f;
    float pmax = p0[0];
#pragma unroll
    for (int r = 1; r < 16; ++r) pmax = fmaxf(pmax, p0[r]);
#pragma unroll
    for (int r = 0; r < 16; ++r) pmax = fmaxf(pmax, p1[r]);
    { auto rr = __builtin_amdgcn_permlane32_swap(__float_as_uint(pmax), __float_as_uint(pmax), false, false);
      pmax = fmaxf(__uint_as_float(rr[0]), __uint_as_float(rr[1])); }
    if (__builtin_expect(__all(pmax - m_reg <= THR), 1)) { mn = m_reg; alpha = 1.f; }
    else { mn = fmaxf(m_reg, pmax); alpha = __builtin_amdgcn_exp2f((m_reg - mn) * C); m_reg = mn; }
    const float mnC = -mn * C;
#pragma unroll
    for (int r = 0; r < 16; ++r) p0[r] = fmaf(p0[r], C, mnC);
#pragma unroll
    for (int r = 0; r < 16; ++r) p1[r] = fmaf(p1[r], C, mnC);
#pragma unroll
    for (int r = 0; r < 16; ++r) p0[r] = __builtin_amdgcn_exp2f(p0[r]);
}
__device__ __forceinline__ void finishSM(f32x16& p0, f32x16& p1, float alpha, float& l_reg, bf16x8& pa0, bf16x8& pa1, bf16x8& pa2, bf16x8& pa3) {
#pragma unroll
    for (int r = 0; r < 16; ++r) p1[r] = __builtin_amdgcn_exp2f(p1[r]);
    float ps = 0;
#pragma unroll
    for (int r = 0; r < 16; ++r) ps += p0[r];
#pragma unroll
    for (int r = 0; r < 16; ++r) ps += p1[r];
    { auto rr = __builtin_amdgcn_permlane32_swap(__float_as_uint(ps), __float_as_uint(ps), false, false);
      ps = __uint_as_float(rr[0]) + __uint_as_float(rr[1]); }
    l_reg = l_reg * alpha + ps;
#define PK4(P, BASE, OUT) do { unsigned a0 = cvt_pk_bf16(P[BASE + 0], P[BASE + 1]), a1 = cvt_pk_bf16(P[BASE + 2], P[BASE + 3]);   \
    unsigned b0 = cvt_pk_bf16(P[BASE + 4], P[BASE + 5]), b1 = cvt_pk_bf16(P[BASE + 6], P[BASE + 7]);                              \
    auto r0 = __builtin_amdgcn_permlane32_swap(a0, b0, false, false); auto r1 = __builtin_amdgcn_permlane32_swap(a1, b1, false, false); \
    u32x4 w = {r0[0], r1[0], r0[1], r1[1]}; OUT = *reinterpret_cast<bf16x8*>(&w); } while (0)
    PK4(p0, 0, pa0); PK4(p0, 8, pa1); PK4(p1, 0, pa2); PK4(p1, 8, pa3);
#undef PK4
}
__device__ __forceinline__ void qkt(f32x16& p0, f32x16& p1, const LAS char* Ks, const bf16x8* qr, int r32, int hi, int c) {
    p0 = f32x16{}; p1 = f32x16{};
#pragma unroll
    for (int d0 = 0; d0 < 4; ++d0) { const int cb = ((c * 4 + d0) * 16 + hi * 8) * 2;
        const bf16x8 b0 = *reinterpret_cast<const LAS bf16x8*>(Ks + KSWZ(r32, cb));
        const bf16x8 b1 = *reinterpret_cast<const LAS bf16x8*>(Ks + KSWZ(32 + r32, cb));
        p0 = __builtin_amdgcn_mfma_f32_32x32x16_bf16(b0, qr[d0], p0, 0, 0, 0);
        p1 = __builtin_amdgcn_mfma_f32_32x32x16_bf16(b1, qr[d0], p1, 0, 0, 0); }
}
__device__ __forceinline__ int v_st(int k, int c) { const int kk = (k & ~0xC) | ((k & 4) << 1) | ((k & 8) >> 1); return ((kk >> 3) * 4 + (c >> 5)) * 512 + ((kk & 7) * 32 + (c & 31)) * 2; }
__device__ __forceinline__ int v_rd_base(int lane) { return ((lane & 3) << 3) | (((lane >> 2) & 3) << 6) | (((lane >> 4) & 1) << 5) | (((lane >> 5) & 1) << 8); }
constexpr int v_rd_off(int d0, int ks, int half) { return d0 * 512 + ks * 4096 + half * 2048; }
template <int OFF> __device__ __forceinline__ s16x4 tr_read(int vb) {
    s16x4 r; asm volatile("ds_read_b64_tr_b16 %0, %1 offset:%2" : "=&v"(r) : "v"(vb), "i"(OFF) : "memory"); return r;
}
template <int D0> __device__ __forceinline__ void pv_one(f32x16& od, int vb, bf16x8 pa0, bf16x8 pa1, bf16x8 pa2, bf16x8 pa3) {
    const s16x4 l0 = tr_read<v_rd_off(D0, 0, 0)>(vb), h0 = tr_read<v_rd_off(D0, 0, 1)>(vb), l1 = tr_read<v_rd_off(D0, 1, 0)>(vb), h1 = tr_read<v_rd_off(D0, 1, 1)>(vb);
    const s16x4 l2 = tr_read<v_rd_off(D0, 2, 0)>(vb), h2 = tr_read<v_rd_off(D0, 2, 1)>(vb), l3 = tr_read<v_rd_off(D0, 3, 0)>(vb), h3 = tr_read<v_rd_off(D0, 3, 1)>(vb);
    asm volatile("s_waitcnt lgkmcnt(0)" ::: "memory"); SBAR();
#define PK(L, H) (bf16x8){L[0], L[1], L[2], L[3], H[0], H[1], H[2], H[3]}
    od = __builtin_amdgcn_mfma_f32_32x32x16_bf16(pa0, PK(l0, h0), od, 0, 0, 0);
    od = __builtin_amdgcn_mfma_f32_32x32x16_bf16(pa1, PK(l1, h1), od, 0, 0, 0);
    od = __builtin_amdgcn_mfma_f32_32x32x16_bf16(pa2, PK(l2, h2), od, 0, 0, 0);
    od = __builtin_amdgcn_mfma_f32_32x32x16_bf16(pa3, PK(l3, h3), od, 0, 0, 0);
#undef PK
}
__device__ __forceinline__ void pv_d0(f32x16* o, int vb, bf16x8 pa0, bf16x8 pa1, bf16x8 pa2, bf16x8 pa3) {
    pv_one<0>(o[0], vb, pa0, pa1, pa2, pa3); pv_one<1>(o[1], vb, pa0, pa1, pa2, pa3); pv_one<2>(o[2], vb, pa0, pa1, pa2, pa3); pv_one<3>(o[3], vb, pa0, pa1, pa2, pa3);
}

__device__ __forceinline__ void attn_unit(const bf16_t* __restrict__ proj, bf16_t* __restrict__ mixed, const float* __restrict__ att_g,
                                          int seq, long row0, int h, int qb, float lam, float nslope, float oscale, LAS char* lds) {
    const int tid = opaque_tid(), wid = tid >> 6, lane = tid & 63, r32 = lane & 31, hi = lane >> 5, c = wid >> 2, wq = wid & 3;
    LAS char* V_lds = lds; LAS char* K_lds = lds + 2 * SHM_V;
    LAS float* ws = (LAS float*)(lds + WS_OFF) + wid * 64; LAS float* li_l = ws; LAS float* al_l = ws + 32;
    float m_reg = -1e30f, l_reg = 0; f32x16 o[4] = {}; bf16x8 qr[4];
    const int qrow = qb * 128 + wq * 32 + r32;
    const bf16_t* Qw = proj + (size_t)(row0 + qrow) * NPROJ + h * 128 + c * 64 + hi * 8;
#pragma unroll
    for (int d0 = 0; d0 < 4; ++d0) qr[d0] = *reinterpret_cast<const bf16x8*>(Qw + d0 * 16);
    const bf16_t* Kh = proj + (size_t)row0 * NPROJ + 512 + h * 128; const bf16_t* Vh = proj + (size_t)row0 * NPROJ + 1024 + h * 128;
    const int sr = tid >> 4, sc = (tid & 15) * 8, vst0 = v_st(sr, sc), vst1 = v_st(32 + sr, sc);
    const int vb0 = (int)(uintptr_t)V_lds + v_rd_base(lane);
    const float qposf = (float)(qrow - 4 * hi);
    struct { bf16x8 vs0, vs1, ks0, ks1; } sr_[2];
#define SLOAD(i, k0) do { sr_[i].vs0 = *reinterpret_cast<const bf16x8*>(&Vh[(size_t)((k0) + sr) * NPROJ + sc]); sr_[i].vs1 = *reinterpret_cast<const bf16x8*>(&Vh[(size_t)((k0) + 32 + sr) * NPROJ + sc]); \
    sr_[i].ks0 = *reinterpret_cast<const bf16x8*>(&Kh[(size_t)((k0) + sr) * NPROJ + sc]); sr_[i].ks1 = *reinterpret_cast<const bf16x8*>(&Kh[(size_t)((k0) + 32 + sr) * NPROJ + sc]); } while (0)
#define SWRITE(b, i) do { *(LAS bf16x8*)(V_lds + (b) * SHM_V + vst0) = sr_[i].vs0;          \
    *(LAS bf16x8*)(V_lds + (b) * SHM_V + vst1) = sr_[i].vs1; const int kc = sc * 2;               \
    *(LAS bf16x8*)(K_lds + (b) * SHM_K + KSWZ(sr, kc)) = sr_[i].ks0;                       \
    *(LAS bf16x8*)(K_lds + (b) * SHM_K + KSWZ(32 + sr, kc)) = sr_[i].ks1; } while (0)
#define SWAIT() asm volatile("s_waitcnt vmcnt(4)" ::: "memory")
#define RESC(a) do { if (__any((a) < 1.f)) { if (hi == 0) al_l[r32] = (a); asm volatile("s_waitcnt lgkmcnt(0)" ::: "memory"); \
    for (int d = 0; d < 4; ++d) for (int r = 0; r < 16; ++r) o[d][r] *= al_l[crow(r, hi)]; } } while (0)
    f32x16 pA0, pA1, pB0, pB1; float mnA, mnB, alA, alB; bf16x8 pa0, pa1, pa2, pa3; const int NT = seq / KVBLK;
    constexpr int SE = 0, SO = 1;
    SLOAD(SE, 0); asm volatile("s_waitcnt vmcnt(0)" ::: "memory"); SWRITE(0, SE); __syncthreads();
    qkt(pA0, pA1, K_lds, qr, r32, hi, c); alibi(pA0, pA1, qposf, nslope); partialSM(pA0, pA1, m_reg, mnA, alA);
    SLOAD(SO, KVBLK); if (2 < NT) SLOAD(SE, 2 * KVBLK);
    SWAIT(); SWRITE(1, SO); __syncthreads();
    for (int j = 1; j + 1 < NT; j += 2) {
        SBAR(); qkt(pB0, pB1, K_lds + SHM_K, qr, r32, hi, c);
        finishSM(pA0, pA1, alA, l_reg, pa0, pa1, pa2, pa3); SBAR();
        SLOAD(SO, (j + 2) * KVBLK); SBAR();
        pv_d0(o, vb0, pa0, pa1, pa2, pa3); alibi(pB0, pB1, qposf - (float)(j * KVBLK), nslope); partialSM(pB0, pB1, m_reg, mnB, alB);
        __syncthreads(); SWAIT(); SWRITE(0, SE);
        RESC(alB); __syncthreads();
        SBAR(); qkt(pA0, pA1, K_lds, qr, r32, hi, c);
        finishSM(pB0, pB1, alB, l_reg, pa0, pa1, pa2, pa3); SBAR();
        if (j + 3 < NT) SLOAD(SE, (j + 3) * KVBLK); SBAR();
        pv_d0(o, vb0 + SHM_V, pa0, pa1, pa2, pa3); alibi(pA0, pA1, qposf - (float)((j + 1) * KVBLK), nslope); partialSM(pA0, pA1, m_reg, mnA, alA);
        __syncthreads(); SWAIT(); SWRITE(1, SO);
        RESC(alA); __syncthreads();
    }
    SBAR(); qkt(pB0, pB1, K_lds + SHM_K, qr, r32, hi, c);
    finishSM(pA0, pA1, alA, l_reg, pa0, pa1, pa2, pa3); SBAR();
    pv_d0(o, vb0, pa0, pa1, pa2, pa3); alibi(pB0, pB1, qposf - (float)((NT - 1) * KVBLK), nslope); partialSM(pB0, pB1, m_reg, mnB, alB);
    __syncthreads(); RESC(alB);
    finishSM(pB0, pB1, alB, l_reg, pa0, pa1, pa2, pa3); SBAR();
    pv_d0(o, vb0 + SHM_V, pa0, pa1, pa2, pa3);
    if (hi == 0) li_l[r32] = l_reg; asm volatile("s_waitcnt lgkmcnt(0)" ::: "memory");
    float rli[16];
#pragma unroll
    for (int r = 0; r < 16; ++r) rli[r] = __builtin_amdgcn_rcpf(li_l[crow(r, hi)]);
    __syncthreads();
    LAS float* OB = (LAS float*)lds;
    if (c == 1) {
#pragma unroll
        for (int r = 0; r < 16; ++r) { const int orow = wq * 32 + crow(r, hi);
#pragma unroll
            for (int d0 = 0; d0 < 4; ++d0) OB[orow * OB_PITCH + d0 * 32 + r32] = o[d0][r] * rli[r]; }
    }
    __syncthreads();
    if (c == 0) {
        float gcol[4];
#pragma unroll
        for (int d0 = 0; d0 < 4; ++d0) gcol[d0] = att_g[h * 128 + d0 * 32 + r32] * oscale;
#pragma unroll
        for (int r = 0; r < 16; ++r) { const int orow = wq * 32 + crow(r, hi);
            float dv[4]; float ss = 0.f;
#pragma unroll
            for (int d0 = 0; d0 < 4; ++d0) { dv[d0] = o[d0][r] * rli[r] - lam * OB[orow * OB_PITCH + d0 * 32 + r32]; ss += dv[d0] * dv[d0]; }
            ss += __shfl_xor(ss, 1); ss += __shfl_xor(ss, 2); ss += __shfl_xor(ss, 4); ss += __shfl_xor(ss, 8); ss += __shfl_xor(ss, 16);
            const float rs = rsqrtf(ss * (1.f / 128.f) + EPS);
            bf16_t* orp = mixed + (size_t)(row0 + qb * 128 + orow) * DM + h * 128 + r32;
#pragma unroll
            for (int d0 = 0; d0 < 4; ++d0) orp[d0 * 32] = f2bf(dv[d0] * rs * gcol[d0]); }
    }
    __syncthreads();
#undef SLOAD
#undef SWRITE
#undef SWAIT
#undef RESC
}
}

namespace ml {
constexpr int QP = 192, VP = 320, SP = 272, CP = 320;
constexpr int OFF_Q = 0, OFF_K = 24576, OFF_KE = 49152, OFF_V = 73728, OFF_C = 114688, OFF_VEC = 135168;
constexpr int V_U = 0, V_MX = 128, V_EINT = 256, V_EEND = 384, V_EMO = 512, V_QN = 640, V_RS = 768, V_GI = 896, V_GF = 1024, V_NST = 1152, V_NPART = 1216, V_SCAL = 1728;
constexpr int HS_PITCH = 132;
__device__ __forceinline__ s16x4 trr(unsigned addr) { s16x4 r; asm volatile("ds_read_b64_tr_b16 %0, %1" : "=&v"(r) : "v"(addr) : "memory"); return r; }
#define TRWAIT2(a, b) asm volatile("s_waitcnt lgkmcnt(0)" : "+v"(a), "+v"(b) :: "memory")
#define TRWAIT4(a, b, c, d) asm volatile("s_waitcnt lgkmcnt(0)" : "+v"(a), "+v"(b), "+v"(c), "+v"(d) :: "memory")
#define CAT(L, H) (bf16x8){L[0], L[1], L[2], L[3], H[0], H[1], H[2], H[3]}
__device__ __forceinline__ float logsig(float x) { return fminf(x, 0.f) - log1pf(expf(-fabsf(x))); }

__device__ __forceinline__ void mlstm_item(const bf16_t* __restrict__ proj, const float* __restrict__ gates, bf16_t* mixed, const float* __restrict__ lstm_g,
                                           int seq, long row0, int h, LAS unsigned char* lds) {
    const int tid0 = opaque_tid();
    LAS float* vec = (LAS float*)(lds + OFF_VEC);
    const unsigned lbase = (unsigned)(uintptr_t)lds;
    const int nc = seq / 128;
    constexpr float L2E = 1.4426950408889634f;
    for (int dir = 0; dir < 2; ++dir) {
        f32x16 Cst = {};
        if (tid0 < 64) vec[V_NST + tid0] = 0.f;
        float m_state = 0.f;
        __syncthreads();
        for (int cc = 0; cc < nc; ++cc) {
            int tid = tid0; asm volatile("" : "+v"(tid));
            const int wid = tid >> 6, lane = tid & 63, r = lane & 31, hh = lane >> 5, i16 = lane & 15, q4 = i16 >> 2, p4 = i16 & 3, blk = (lane >> 4) & 1;
            const int rb = wid >> 1, ch = wid & 1, db = wid >> 2, eb = wid & 3;
            const int c = dir ? nc - 1 - cc : cc;
            const long cbase = row0 + (long)c * 128;
#define POS(j) (cbase + (dir ? 127 - (j) : (j)))
#pragma unroll
            for (int i = 0; i < 2; ++i) { const int chunk = tid + 512 * i, j = chunk >> 3, c8 = chunk & 7; const bf16_t* src = proj + (size_t)POS(j) * NPROJ + h * 64 + c8 * 8;
                *(LAS bf16x8*)(lds + OFF_Q + j * QP + c8 * 16) = *(const bf16x8*)(src + 1536);
                *(LAS bf16x8*)(lds + OFF_K + j * QP + c8 * 16) = *(const bf16x8*)(src + 1792); }
#pragma unroll
            for (int i = 0; i < 4; ++i) { const int chunk = tid + 512 * i, j = chunk >> 4, c16 = chunk & 15;
                *(LAS bf16x8*)(lds + OFF_V + j * VP + c16 * 16) = *(const bf16x8*)(proj + (size_t)POS(j) * NPROJ + 2048 + h * 128 + c16 * 8); }
            if (tid < 128) { const float* gp = gates + (size_t)POS(tid) * 16; vec[V_GI + tid] = gp[(dir ? 8 : 0) + h]; vec[V_GF + tid] = gp[(dir ? 12 : 4) + h]; }
#pragma unroll
            for (int i = 0; i < 16; ++i) *(LAS bf16_t*)(lds + OFF_C + (32 * db + crow(i, hh)) * CP + (32 * eb + r) * 2) = f2bf(Cst[i]);
            __syncthreads();
            if (wid == 0) {
                const float gf0 = vec[V_GF + 2 * lane], gf1 = vec[V_GF + 2 * lane + 1], gi0 = vec[V_GI + 2 * lane], gi1 = vec[V_GI + 2 * lane + 1];
                const float lf0 = logsig(gf0), lf1 = logsig(gf1);
                float incl = lf0 + lf1;
#pragma unroll
                for (int d = 1; d < 64; d <<= 1) { const float t = __shfl_up(incl, d); if (lane >= d) incl += t; }
                const float b1 = incl, b0 = incl - lf1, g = __shfl(incl, 63);
                const float u0 = gi0 - b0, u1 = gi1 - b1;
                float cm = fmaxf(u0, u1);
#pragma unroll
                for (int d = 1; d < 64; d <<= 1) { const float t = __shfl_up(cm, d); if (lane >= d) cm = fmaxf(cm, t); }
                float excl = __shfl_up(cm, 1); if (lane == 0) excl = -INFINITY;
                const float cmx0 = fmaxf(excl, u0), cmx1 = cm, umax = __shfl(cm, 63);
                const float mp = m_state, mx0 = fmaxf(mp, cmx0), mx1 = fmaxf(mp, cmx1);
                vec[V_U + 2 * lane] = u0; vec[V_U + 2 * lane + 1] = u1; vec[V_MX + 2 * lane] = mx0; vec[V_MX + 2 * lane + 1] = mx1;
                vec[V_EINT + 2 * lane] = expf(mp - mx0); vec[V_EINT + 2 * lane + 1] = expf(mp - mx1);
                vec[V_EEND + 2 * lane] = expf(u0 - umax); vec[V_EEND + 2 * lane + 1] = expf(u1 - umax);
                vec[V_EMO + 2 * lane] = expf(-(b0 + mx0)); vec[V_EMO + 2 * lane + 1] = expf(-(b1 + mx1));
                const float m_loc = g + umax, m_new = fmaxf(g + mp, m_loc);
                if (lane == 0) { vec[V_SCAL] = expf(g + mp - m_new); vec[V_SCAL + 1] = expf(m_loc - m_new); }
                m_state = m_new;
            }
            bf16x8 qa[4];
#pragma unroll
            for (int ks = 0; ks < 4; ++ks) qa[ks] = *(const LAS bf16x8*)(lds + OFF_Q + (32 * rb + r) * QP + (16 * ks + 8 * hh) * 2);
            f32x16 Sv[2] = {}, Ov[2] = {};
#pragma unroll
            for (int t = 0; t < 2; ++t) {
                if (2 * ch + t <= rb) {
#pragma unroll
                    for (int ks = 0; ks < 4; ++ks) { const bf16x8 kb = *(const LAS bf16x8*)(lds + OFF_K + (64 * ch + 32 * t + r) * QP + (16 * ks + 8 * hh) * 2);
                        Sv[t] = __builtin_amdgcn_mfma_f32_32x32x16_bf16(qa[ks], kb, Sv[t], 0, 0, 0); } }
#pragma unroll
                for (int ks = 0; ks < 4; ++ks) { const unsigned a0 = lbase + OFF_C + (16 * ks + 8 * hh + q4) * CP + (64 * ch + 32 * t + 16 * blk + 4 * p4) * 2;
                    s16x4 lo = trr(a0), hi4 = trr(a0 + 4 * CP); TRWAIT2(lo, hi4);
                    Ov[t] = __builtin_amdgcn_mfma_f32_32x32x16_bf16(qa[ks], CAT(lo, hi4), Ov[t], 0, 0, 0); }
            }
            { const int j = tid >> 2, part = tid & 3; float s = 0.f;
#pragma unroll
              for (int k2 = 0; k2 < 2; ++k2) { const bf16x8 qv = *(const LAS bf16x8*)(lds + OFF_Q + j * QP + (16 * part + 8 * k2) * 2);
#pragma unroll
                  for (int e = 0; e < 8; ++e) s += bf2f((bf16_t)qv[e]) * vec[V_NST + 16 * part + 8 * k2 + e]; }
              s += __shfl_xor(s, 1); s += __shfl_xor(s, 2); if (part == 0) vec[V_QN + j] = s; }
            __syncthreads();
#pragma unroll
            for (int i = 0; i < 2; ++i) { const int chunk = tid + 512 * i, j = chunk >> 3, c8 = chunk & 7; const float ee = vec[V_EEND + j];
                const bf16x8 kv = *(const LAS bf16x8*)(lds + OFF_K + j * QP + c8 * 16); u32x4 w;
                w.x = cvt_pk_bf16(bf2f((bf16_t)kv[0]) * ee, bf2f((bf16_t)kv[1]) * ee); w.y = cvt_pk_bf16(bf2f((bf16_t)kv[2]) * ee, bf2f((bf16_t)kv[3]) * ee);
                w.z = cvt_pk_bf16(bf2f((bf16_t)kv[4]) * ee, bf2f((bf16_t)kv[5]) * ee); w.w = cvt_pk_bf16(bf2f((bf16_t)kv[6]) * ee, bf2f((bf16_t)kv[7]) * ee);
                *(LAS u32x4*)(lds + OFF_KE + j * QP + c8 * 16) = w; }
            {
                const float us0 = vec[V_U + 64 * ch + r] * L2E, us1 = vec[V_U + 64 * ch + 32 + r] * L2E;
#pragma unroll
                for (int i = 0; i < 16; ++i) { const int j = 32 * rb + crow(i, hh); const float mxj = vec[V_MX + j] * L2E, ei = vec[V_EINT + j];
                    const int s0 = 64 * ch + r, s1 = s0 + 32;
                    Sv[0][i] = (s0 <= j) ? Sv[0][i] * __builtin_amdgcn_exp2f(us0 - mxj) : 0.f;
                    Sv[1][i] = (s1 <= j) ? Sv[1][i] * __builtin_amdgcn_exp2f(us1 - mxj) : 0.f;
                    Ov[0][i] *= ei; Ov[1][i] *= ei; }
            }
            __syncthreads();
#pragma unroll
            for (int t = 0; t < 2; ++t)
#pragma unroll
                for (int i = 0; i < 16; ++i) *(LAS bf16_t*)(lds + OFF_Q + (32 * rb + crow(i, hh)) * SP + (64 * ch + 32 * t + r) * 2) = f2bf(Sv[t][i]);
            __syncthreads();
#pragma unroll 1
            for (int ks = 0; ks < 2 * (rb + 1); ++ks) {
                const bf16x8 a = *(const LAS bf16x8*)(lds + OFF_Q + (32 * rb + r) * SP + (16 * ks + 8 * hh) * 2);
                const unsigned a0 = lbase + OFF_V + (16 * ks + 8 * hh + q4) * VP + (64 * ch + 16 * blk + 4 * p4) * 2;
                s16x4 l0 = trr(a0), h0 = trr(a0 + 4 * VP), l1 = trr(a0 + 64), h1 = trr(a0 + 4 * VP + 64); TRWAIT4(l0, h0, l1, h1);
                Ov[0] = __builtin_amdgcn_mfma_f32_32x32x16_bf16(a, CAT(l0, h0), Ov[0], 0, 0, 0);
                Ov[1] = __builtin_amdgcn_mfma_f32_32x32x16_bf16(a, CAT(l1, h1), Ov[1], 0, 0, 0);
            }
            { const int j = tid >> 2, part = tid & 3; float s = 0.f;
#pragma unroll
              for (int k4 = 0; k4 < 4; ++k4) { const bf16x8 sv = *(const LAS bf16x8*)(lds + OFF_Q + j * SP + (32 * part + 8 * k4) * 2);
#pragma unroll
                  for (int e = 0; e < 8; ++e) s += bf2f((bf16_t)sv[e]); }
              s += __shfl_xor(s, 1); s += __shfl_xor(s, 2); if (part == 0) vec[V_RS + j] = s; }
            f32x16 Cl = {};
#pragma unroll 2
            for (int ks = 0; ks < 8; ++ks) {
                const unsigned aa = lbase + OFF_KE + (16 * ks + 8 * hh + q4) * QP + (32 * db + 16 * blk + 4 * p4) * 2;
                const unsigned ab = lbase + OFF_V + (16 * ks + 8 * hh + q4) * VP + (32 * eb + 16 * blk + 4 * p4) * 2;
                s16x4 la = trr(aa), ha = trr(aa + 4 * QP), lb = trr(ab), hb = trr(ab + 4 * VP); TRWAIT4(la, ha, lb, hb);
                Cl = __builtin_amdgcn_mfma_f32_32x32x16_bf16(CAT(la, ha), CAT(lb, hb), Cl, 0, 0, 0);
            }
            const float sa = vec[V_SCAL], sb = vec[V_SCAL + 1];
#pragma unroll
            for (int i = 0; i < 16; ++i) Cst[i] = sa * Cst[i] + sb * Cl[i];
            { const int d = tid & 63, part = tid >> 6; float s = 0.f;
#pragma unroll
              for (int k = 0; k < 16; ++k) s += bf2f(*(const LAS bf16_t*)(lds + OFF_KE + (16 * part + k) * QP + d * 2));
              vec[V_NPART + part * 64 + d] = s; }
            __syncthreads();
            if (tid < 64) { float nl = 0.f;
#pragma unroll
                for (int p = 0; p < 8; ++p) nl += vec[V_NPART + p * 64 + tid];
                vec[V_NST + tid] = sa * vec[V_NST + tid] + sb * nl; }
            LAS float* HS = (LAS float*)lds;
#pragma unroll
            for (int i = 0; i < 16; ++i) { const int j = 32 * rb + crow(i, hh);
                const float den = vec[V_EINT + j] * vec[V_QN + j] + vec[V_RS + j];
                const float scl = 1.0f / fmaxf(fabsf(den), vec[V_EMO + j]);
                bf16_t* op = mixed + (size_t)POS(j) * DM + 512 + h * 128 + 64 * ch + r;
                if (dir == 0) { op[0] = f2bf(Ov[0][i] * scl); op[32] = f2bf(Ov[1][i] * scl); }
                else { HS[j * HS_PITCH + 64 * ch + r] = Ov[0][i] * scl + bf2f(op[0]); HS[j * HS_PITCH + 64 * ch + 32 + r] = Ov[1][i] * scl + bf2f(op[32]); } }
            if (dir == 1) {
                __syncthreads();
                const int j = tid >> 2, part = tid & 3; float ss = 0.f;
#pragma unroll
                for (int k = 0; k < 8; ++k) { const f32x4 x = *(const LAS f32x4*)(HS + j * HS_PITCH + 32 * part + 4 * k);
                    ss += (x[0] * x[0] + x[1] * x[1]) + (x[2] * x[2] + x[3] * x[3]); }
                ss += __shfl_xor(ss, 1); ss += __shfl_xor(ss, 2);
                const float rs = rsqrtf(ss * (1.f / 128.f) + EPS);
                const bf16_t* lop = proj + (size_t)POS(j) * NPROJ + 2560 + h * 128 + 32 * part;
                bf16_t* op = mixed + (size_t)POS(j) * DM + 512 + h * 128 + 32 * part;
                const float* gp = lstm_g + h * 128 + 32 * part;
#pragma unroll
                for (int k = 0; k < 4; ++k) { const bf16x8 lo8 = *(const bf16x8*)(lop + 8 * k); float ov[8];
                    const f32x4 xa = *(const LAS f32x4*)(HS + j * HS_PITCH + 32 * part + 8 * k), xb4 = *(const LAS f32x4*)(HS + j * HS_PITCH + 32 * part + 8 * k + 4);
                    const float hv8[8] = {xa[0], xa[1], xa[2], xa[3], xb4[0], xb4[1], xb4[2], xb4[3]};
#pragma unroll
                    for (int e = 0; e < 8; ++e) { const float lg = bf2f((bf16_t)lo8[e]); const float sg = 1.0f / (1.0f + expf(-lg)); ov[e] = sg * hv8[e] * rs * gp[8 * k + e]; }
                    u32x4 w; w.x = cvt_pk_bf16(ov[0], ov[1]); w.y = cvt_pk_bf16(ov[2], ov[3]); w.z = cvt_pk_bf16(ov[4], ov[5]); w.w = cvt_pk_bf16(ov[6], ov[7]);
                    *(u32x4*)(op + 8 * k) = w; }
            }
            __syncthreads();
#undef POS
        }
        __threadfence(); __syncthreads();
    }
}
}

struct Args {
    const float* xin[2]; const float* w_in; const float* gate_bias; const float* lam_q1; const float* lam_k1; const float* lam_q2; const float* lam_k2;
    const float* att_g; const float* lstm_g; const float* w_out; const float* ln1_g; const float* ln1_b; const float* w_gu; const float* conv_w; const float* conv_b;
    const float* w_down; const float* ln2_g; const float* ln2_b; float* out; unsigned char* ws; int ph_lo, ph_hi;
};
constexpr int NPHASE = 27;

__device__ __forceinline__ void transpose_item(const float* W, int K, int N, bf16_t* WT, int gu_map, const float* g, const float* b, float* c1, float* c2, LAS float* scr, int item, int lane) {
    const int nblk = (N + 31) / 32, kb = item / nblk, nb = item % nblk, k0 = 64 * kb, n0 = 32 * nb;
    const int ncol = n0 + (lane & 31); const bool okc = ncol < N;
    float a1 = 0.f, a2 = 0.f;
#pragma unroll 8
    for (int i = 0; i < 32; ++i) { const int kk = 2 * i + (lane >> 5); float w = okc ? W[(size_t)(k0 + kk) * N + ncol] : 0.f;
        if (g) { a2 += w * b[k0 + kk]; w *= g[k0 + kk]; a1 += bf2f(f2bf(w)); }
        scr[kk * 33 + (lane & 31)] = w; }
    asm volatile("s_waitcnt lgkmcnt(0)" ::: "memory");
    if (g) { a1 += __shfl_xor(a1, 32); a2 += __shfl_xor(a2, 32); }
    const int c = lane & 7;
#pragma unroll
    for (int j = 0; j < 4; ++j) { const int nl = (lane >> 3) + 8 * j; const int n = n0 + nl; const LAS float* s = scr + (8 * c) * 33 + nl;
        u32x4 o; o.x = cvt_pk_bf16(s[0 * 33], s[1 * 33]); o.y = cvt_pk_bf16(s[2 * 33], s[3 * 33]); o.z = cvt_pk_bf16(s[4 * 33], s[5 * 33]); o.w = cvt_pk_bf16(s[6 * 33], s[7 * 33]);
        if (n < N) { int rowm = n; if (gu_map) { const int n2 = n < DFF ? n : n - DFF; rowm = 256 * (n2 >> 7) + (n < DFF ? 0 : 128) + (n2 & 127); }
            *(u32x4*)(WT + (size_t)rowm * K + k0 + 8 * c) = o; } }
    if (g && lane < 32 && okc) { int rowm = ncol; if (gu_map) { const int n2 = ncol < DFF ? ncol : ncol - DFF; rowm = 256 * (n2 >> 7) + (ncol < DFF ? 0 : 128) + (n2 & 127); }
        atomicAdd(c1 + rowm, a1); atomicAdd(c2 + rowm, a2); }
    asm volatile("s_waitcnt lgkmcnt(0)" ::: "memory");
}

__device__ __forceinline__ void cvt_rows(const float* x, bf16_t* xb, int gtid, int nthr) {
    for (size_t i = gtid; i < (size_t)MT * DM / 8; i += nthr) {
        const f32x4 a = *(const f32x4*)(x + i * 8), b = *(const f32x4*)(x + i * 8 + 4);
        u32x4 w; w.x = cvt_pk_bf16(a[0], a[1]); w.y = cvt_pk_bf16(a[2], a[3]); w.z = cvt_pk_bf16(b[0], b[1]); w.w = cvt_pk_bf16(b[2], b[3]);
        *(u32x4*)(xb + i * 8) = w; }
}

__global__ void __launch_bounds__(512, 2) fwd(Args args) {
    extern __shared__ __attribute__((aligned(16))) unsigned char lds_raw[];
    LAS unsigned char* lds = (LAS unsigned char*)lds_raw;
    for (int ph = args.ph_lo; ph < args.ph_hi; ++ph) {
        if (ph > args.ph_lo) cg::this_grid().sync();
        const int tid = opaque_tid(), lane = tid & 63, wave = __builtin_amdgcn_readfirstlane(tid >> 6);
        const int G = gridDim.x, gtid = blockIdx.x * 512 + tid, nthr = G * 512;
        unsigned char* ws = args.ws; asm volatile("" : "+s"(ws));
        bf16_t* XB = (bf16_t*)(ws + WS_XB); bf16_t* MIXED = (bf16_t*)(ws + WS_MIXED); bf16_t* PROJ = (bf16_t*)(ws + WS_PROJ); bf16_t* HMID = PROJ;
        float* GATES = (float*)(ws + WS_GATES); float* EDGE = (float*)(ws + WS_EDGE);
        f32x2* ST1 = (f32x2*)(ws + WS_ST1); f32x2* ST2 = (f32x2*)(ws + WS_ST2);
        float* LAMV = (float*)(ws + WS_LAM);
        float* C1IN = (float*)(ws + CTL_C1IN); float* C2IN = (float*)(ws + CTL_C2IN); float* C1GU = (float*)(ws + CTL_C1GU); float* C2GU = (float*)(ws + CTL_C2GU);
        unsigned* QCNT = (unsigned*)(ws + WS_CTL);
        if ((PHMASK & 1) && ph == 0) {
            LAS float* scr = (LAS float*)(lds + wave * 8448);
            const int gw = blockIdx.x * 8 + wave, NGW = G * 8;
            constexpr int I_IN = 16 * 97, I_OUT = 16 * 32, I_GU = 16 * 176, I_DN = 44 * 32, I_L = I_IN + I_OUT + I_GU + I_DN;
            for (int it = gw; it < 2 * I_L; it += NGW) {
                const int l = it / I_L; int r = it % I_L;
                if (r < I_IN) { transpose_item(args.w_in + (size_t)l * DM * NIN, DM, NIN, (bf16_t*)(ws + WS_WIN) + (size_t)l * NPROJ_PAD * DM, 0,
                                               l ? args.ln2_g : nullptr, l ? args.ln2_b : nullptr, C1IN, C2IN, scr, r, lane); continue; } r -= I_IN;
                if (r < I_OUT) { transpose_item(args.w_out + (size_t)l * DM * DM, DM, DM, (bf16_t*)(ws + WS_WOUT) + (size_t)l * DM * DM, 0, nullptr, nullptr, nullptr, nullptr, scr, r, lane); continue; } r -= I_OUT;
                if (r < I_GU) { transpose_item(args.w_gu + (size_t)l * DM * NGU, DM, NGU, (bf16_t*)(ws + WS_WGU) + (size_t)l * NGU * DM, 1,
                                               args.ln1_g + l * DM, args.ln1_b + l * DM, C1GU + l * NGU, C2GU + l * NGU, scr, r, lane); continue; } r -= I_GU;
                transpose_item(args.w_down + (size_t)l * DFF * DM, DFF, DM, (bf16_t*)(ws + WS_WDN) + (size_t)l * DM * DFF, 0, nullptr, nullptr, nullptr, nullptr, scr, r, lane);
            }
            for (int i = gtid; i < 2 * (NPROJ_PAD - NIN) * DM / 8; i += nthr) { const int l = i / ((NPROJ_PAD - NIN) * DM / 8), o = i % ((NPROJ_PAD - NIN) * DM / 8);
                *(u32x4*)((bf16_t*)(ws + WS_WIN) + (size_t)l * NPROJ_PAD * DM + (size_t)NIN * DM + (size_t)o * 8) = (u32x4){0u, 0u, 0u, 0u}; }
            if (blockIdx.x == 0 && wave == 0) {
                for (int l = 0; l < 2; ++l) {
                    float s1 = args.lam_q1[l * 64 + lane] * args.lam_k1[l * 64 + lane], s2 = args.lam_q2[l * 64 + lane] * args.lam_k2[l * 64 + lane];
#pragma unroll
                    for (int o = 1; o < 64; o <<= 1) { s1 += __shfl_xor(s1, o); s2 += __shfl_xor(s2, o); }
                    const float lam_init = 0.8f - 0.6f * expf(-0.3f * (float)l);
                    if (lane == 0) LAMV[l] = expf(s1) - expf(s2) + lam_init;
                }
            }
            cvt_rows(args.xin[0], XB, gtid, nthr);
            continue;
        }
        const int trunk = (ph - 1) / 13, pp = (ph - 1) % 13;
        const int seq = trunk ? 2048 : 4096, nseq = trunk ? 32 : 16;
        float* V = args.out + (size_t)trunk * MT * DM;
        if ((PHMASK & 256) && pp == 12) {
            const float* g = args.ln2_g + DM; const float* b = args.ln2_b + DM;
            for (size_t i = gtid; i < (size_t)MT * DM / 4; i += nthr) { const int row = (int)(i >> 8), col = (int)(i & 255) * 4;
                float mu, rstd; row_stats(ST2, row, mu, rstd);
                const f32x4 x = *(const f32x4*)(V + i * 4), gv = *(const f32x4*)(g + col), bv = *(const f32x4*)(b + col);
                *(f32x4*)(V + i * 4) = (x - mu) * rstd * gv + bv; }
            if (trunk == 0) cvt_rows(args.xin[1], XB, gtid, nthr);
            continue;
        }
        const int l = pp / 6, sp = pp % 6;
        if ((PHMASK & 2) && sp == 0) {
            pg8::Gemm g{XB, (const bf16_t*)(ws + WS_WIN) + (size_t)l * NPROJ_PAD * DM, MT, NPROJ_PAD, DM};
            pg8::StaticOrder S; S.init(MT, NPROJ_PAD, G, (int)blockIdx.x);
            EpiProj E{PROJ, GATES, args.gate_bias + l * 16, l ? ST2 : nullptr, C1IN, C2IN, (LAS f32x2*)(lds + EPI_LDS + 8192)};
            pg8::gemm_phase<EpiProj, pg8::StaticOrder>(lds, g, S, E);
        } else if ((PHMASK & 12) && sp == 1) {
            unsigned* qc = QCNT + (size_t)((trunk * 2 + l) * 8) * 64;
            const int myx = (int)(__builtin_amdgcn_s_getreg((3 << 11) | 20) & 7);
            const int npair = nseq / 2, nqb = seq / 128, nitems = npair * (1 + nqb);
            const float lam = LAMV[l]; const float lam_init = 0.8f - 0.6f * expf(-0.3f * (float)l);
            LAS int* sitem = (LAS int*)(lds + LDS_BYTES - 64);
            for (int qq = 0; qq < 8; ++qq) {
                const int x = (myx + qq) & 7;
                for (;;) {
                    if (tid == 0) sitem[0] = (int)atomicAdd(qc + 64 * x, 1u);
                    __syncthreads();
                    const int item = sitem[0];
                    __syncthreads();
                    if (item >= nitems) break;
                    if ((PHMASK & 4) && item < npair) {
                        const int p = x + 8 * item, b = p >> 2, h = p & 3;
                        ml::mlstm_item(PROJ, GATES, MIXED, args.lstm_g + l * 512, seq, (long)b * seq, h, lds);
                    } else if (PHMASK & 8) {
                        const int a = item - npair, pi = a / nqb, qb = a % nqb, p = x + 8 * pi, b = p >> 2, h = p & 3;
                        const float slope = exp2f(-2.0f * (float)(h + 1));
                        att::attn_unit(PROJ, MIXED, args.att_g + l * 512, seq, (long)b * seq, h, qb, lam, -slope, 1.0f - lam_init, (LAS char*)lds);
                    }
                }
            }
        } else if ((PHMASK & 16) && sp == 2) {
            pg8::Gemm g{MIXED, (const bf16_t*)(ws + WS_WOUT) + (size_t)l * DM * DM, MT, DM, DM};
            pg8::StaticOrder S; S.init(MT, DM, G, (int)blockIdx.x);
            EpiRes E{l ? nullptr : args.xin[trunk], V, ST2, args.ln2_g, args.ln2_b, ST1, XB, (LAS f32x2*)(lds + EPI_LDS), (LAS f32x2*)(lds + EPI_LDS + 8192)};
            pg8::gemm_phase<EpiRes, pg8::StaticOrder>(lds, g, S, E);
        } else if ((PHMASK & 32) && sp == 3) {
            pg8::Gemm g{XB, (const bf16_t*)(ws + WS_WGU) + (size_t)l * NGU * DM, MT, NGU, DM};
            pg8::StaticOrder S; S.init(MT, NGU, G, (int)blockIdx.x);
            EpiGU E{HMID, EDGE, ST1, C1GU + l * NGU, C2GU + l * NGU, args.conv_w + (size_t)l * 3 * DFF, args.conv_b + (size_t)l * DFF, (LAS float*)(lds + EPI_LDS), (LAS f32x2*)(lds + EPI_LDS + 8192)};
            pg8::gemm_phase<EpiGU, pg8::StaticOrder>(lds, g, S, E);
        } else if ((PHMASK & 64) && sp == 4) {
            const float* cw = args.conv_w + (size_t)l * 3 * DFF; const float* cb = args.conv_b + (size_t)l * DFF; const int st = seq / 256;
            for (int i = gtid; i < 256 * 2 * (DFF / 4); i += nthr) {
                const int grp = i % (DFF / 4), e2 = (i / (DFF / 4)) & 1, pm = i / (2 * (DFF / 4)), j = grp * 4;
                const float* Ep = EDGE + (size_t)pm * 6 * DFF + j;
                const f32x4 w0 = *(const f32x4*)(cw + j), w1 = *(const f32x4*)(cw + DFF + j), w2 = *(const f32x4*)(cw + 2 * DFF + j), cbv = *(const f32x4*)(cb + j);
                f32x4 ga, gb, gc, up; const f32x4 z = (f32x4){0.f, 0.f, 0.f, 0.f}; int row;
                if (e2 == 0) { ga = (pm % st == 0) ? z : *(const f32x4*)(Ep - 6 * DFF + 3 * DFF); gb = *(const f32x4*)(Ep); gc = *(const f32x4*)(Ep + DFF); up = *(const f32x4*)(Ep + 4 * DFF); row = pm * 256; }
                else { ga = *(const f32x4*)(Ep + 2 * DFF); gb = *(const f32x4*)(Ep + 3 * DFF); gc = (pm % st == st - 1) ? z : *(const f32x4*)(Ep + 6 * DFF); up = *(const f32x4*)(Ep + 5 * DFF); row = pm * 256 + 255; }
                const f32x4 cv = cbv + w0 * ga + w1 * gb + w2 * gc;
                u32x2 w; w.x = cvt_pk_bf16(gelu_erf(cv[0]) * up[0], gelu_erf(cv[1]) * up[1]); w.y = cvt_pk_bf16(gelu_erf(cv[2]) * up[2], gelu_erf(cv[3]) * up[3]);
                *(u32x2*)(HMID + (size_t)row * DFF + j) = w; }
        } else if (PHMASK & 128) {
            pg8::Gemm g{HMID, (const bf16_t*)(ws + WS_WDN) + (size_t)l * DM * DFF, MT, DM, DFF};
            pg8::StaticOrder S; S.init(MT, DM, G, (int)blockIdx.x);
            EpiRes E{nullptr, V, ST1, args.ln1_g + l * DM, args.ln1_b + l * DM, ST2, l == 0 ? XB : nullptr, (LAS f32x2*)(lds + EPI_LDS), (LAS f32x2*)(lds + EPI_LDS + 8192)};
            pg8::gemm_phase<EpiRes, pg8::StaticOrder>(lds, g, S, E);
        }
    }
}

extern "C" void kernel_launch(void* const* d_in, const int* in_sizes, int n_in, void* d_out, int out_size, void* d_ws, size_t ws_size, hipStream_t stream) {
    static int grid = 0;
    if (grid == 0) {
        if (n_in != 19 || ws_size < WS_END) { fprintf(stderr, "kernel_launch: unexpected n_in %d / ws %zu\n", n_in, ws_size); grid = -1; return; }
        int dev = 0, cus = 0, per_cu = 0;
        hipGetDevice(&dev); hipDeviceGetAttribute(&cus, hipDeviceAttributeMultiprocessorCount, dev);
        if (hipFuncSetAttribute((const void*)fwd, hipFuncAttributeMaxDynamicSharedMemorySize, LDS_BYTES) != hipSuccess) { fprintf(stderr, "kernel_launch: hipFuncSetAttribute failed\n"); grid = -1; return; }
        hipOccupancyMaxActiveBlocksPerMultiprocessor(&per_cu, (const void*)fwd, 512, LDS_BYTES);
        (void)hipGetLastError();
        if (per_cu < 1) per_cu = 1;
        grid = cus;
    }
    if (grid < 0) return;
    hipMemsetAsync((char*)d_ws + WS_CTL, 0, CTL_BYTES, stream);
    Args a{};
    a.xin[0] = (const float*)d_in[0]; a.xin[1] = (const float*)d_in[1]; a.w_in = (const float*)d_in[2]; a.gate_bias = (const float*)d_in[3];
    a.lam_q1 = (const float*)d_in[4]; a.lam_k1 = (const float*)d_in[5]; a.lam_q2 = (const float*)d_in[6]; a.lam_k2 = (const float*)d_in[7];
    a.att_g = (const float*)d_in[8]; a.lstm_g = (const float*)d_in[9]; a.w_out = (const float*)d_in[10]; a.ln1_g = (const float*)d_in[11]; a.ln1_b = (const float*)d_in[12];
    a.w_gu = (const float*)d_in[13]; a.conv_w = (const float*)d_in[14]; a.conv_b = (const float*)d_in[15]; a.w_down = (const float*)d_in[16]; a.ln2_g = (const float*)d_in[17]; a.ln2_b = (const float*)d_in[18];
    a.out = (float*)d_out; a.ws = (unsigned char*)d_ws;
#if MK_MULTI
    for (int ph = 0; ph < NPHASE; ++ph) { a.ph_lo = ph; a.ph_hi = ph + 1; hipLaunchKernelGGL(fwd, dim3(grid), dim3(512), LDS_BYTES, stream, a); }
#else
    a.ph_lo = 0; a.ph_hi = NPHASE;
    void* kargs[] = {&a};
    hipError_t e = hipLaunchCooperativeKernel((const void*)fwd, dim3(grid), dim3(512), kargs, LDS_BYTES, stream);
    if (e != hipSuccess) fprintf(stderr, "kernel_launch: cooperative launch failed: %s (grid %d)\n", hipGetErrorString(e), grid);
#endif
}
```

```cpp
#include <hip/hip_runtime.h>
#include <hip/hip_cooperative_groups.h>
#include <cstdio>
#include <cstdint>
namespace cg = cooperative_groups;

#ifndef PHMASK
#define PHMASK 0xffff
#endif
#ifndef MK_MULTI
#define MK_MULTI 0
#endif

#define LAS __attribute__((address_space(3)))
typedef unsigned short bf16_t;
typedef short bf16x8 __attribute__((ext_vector_type(8)));
typedef short s16x4 __attribute__((ext_vector_type(4)));
typedef float f32x2 __attribute__((ext_vector_type(2)));
typedef float f32x4 __attribute__((ext_vector_type(4)));
typedef float f32x8 __attribute__((ext_vector_type(8)));
typedef float f32x16 __attribute__((ext_vector_type(16)));
typedef unsigned u32x2 __attribute__((ext_vector_type(2)));
typedef unsigned u32x4 __attribute__((ext_vector_type(4)));

constexpr int DM = 1024, NPROJ = 3072, NPROJ_PAD = 3328, NIN = 3088, DFF = 2816, NGU = 5632;
constexpr int MT = 65536;
constexpr float ALPHA = 1.4142135623730951f, EPS = 1e-5f;
constexpr int LDS_BYTES = 147456;
constexpr int EPI_LDS = 131072;

constexpr size_t MiB = 1u << 20;
constexpr size_t WS_CTL = 0, CTL_BYTES = 1 * MiB;
constexpr size_t CTL_C1IN = 65536, CTL_C2IN = 81920, CTL_C1GU = 98304, CTL_C2GU = 147456;
constexpr size_t WS_LAM = 1 * MiB;
constexpr size_t WS_WIN = 2 * MiB, WS_WOUT = 15 * MiB, WS_WGU = 19 * MiB, WS_WDN = 41 * MiB;
constexpr size_t WS_ST1 = 52 * MiB, WS_ST2 = 54 * MiB, WS_GATES = 56 * MiB, WS_EDGE = 60 * MiB;
constexpr size_t WS_XB = 80 * MiB, WS_MIXED = 208 * MiB, WS_PROJ = 336 * MiB, WS_END = 720 * MiB;

__device__ __forceinline__ unsigned cvt_pk_bf16(float lo, float hi) { unsigned r; asm volatile("v_cvt_pk_bf16_f32 %0, %1, %2" : "=v"(r) : "v"(lo), "v"(hi)); return r; }
__device__ __forceinline__ float bf2f(bf16_t b) { return __uint_as_float(((unsigned)b) << 16); }
__device__ __forceinline__ bf16_t f2bf(float f) { return (bf16_t)(cvt_pk_bf16(f, 0.f) & 0xffffu); }
__device__ __forceinline__ float gelu_erf(float v) {
    const float av = fabsf(v), t = __builtin_amdgcn_rcpf(av * 0.2316418882f + 1.0f);
    float q = t * 0.5307027145f + (-0.7265760135f); q = q * t + 0.7107068705f; q = q * t + (-0.142248368f); q = q * t + 0.127414796f; q = q * t;
    const float e = __builtin_amdgcn_exp2f((v * v) * (-0.72134752044f));
    const float m = v * (q * e);
    return v < 0.f ? m : v - m;
}
__device__ __forceinline__ int crow(int r, int hi) { return (r & 3) + 8 * (r >> 2) + 4 * hi; }
#define EPI_BAR() do { asm volatile("s_waitcnt lgkmcnt(0)" ::: "memory"); __builtin_amdgcn_s_barrier(); asm volatile("" ::: "memory"); } while (0)
#define SBAR() __builtin_amdgcn_sched_barrier(0)
__device__ __forceinline__ int opaque_tid() { int t = threadIdx.x; asm volatile("" : "+v"(t)); return t; }

namespace pg8 {
constexpr int BM = 256, BK = 64, HALF = 128, HTB = HALF * BK * 2, STAGE_BYTES = 8 * HTB, NXCD = 8, WGM = 8;
__host__ __device__ __forceinline__ int lds_byte(int r, int c) { const int st = (r >> 4) * 2 + (c >> 5), rr = r & 15, cc = c & 31, ob = rr * 64 + cc * 2; return st * 1024 + (ob ^ (((ob >> 9) & 1) << 5)); }
__host__ __device__ __forceinline__ void stage_rc(int b, int& R, int& C) { const int st = b / 1024, sb = b % 1024, swz = sb ^ (((sb >> 9) & 1) << 5); R = (st >> 1) * 16 + swz / 64; C = (st & 1) * 32 + (swz % 64) / 2; }
__host__ __device__ __forceinline__ int perm32(int rho) { const int n = rho >> 4, i = rho & 15; return 8 * (i >> 2) + 4 * n + (i & 3); }
struct Unit { int pm, pn; };
struct Gemm { const bf16_t* A; const bf16_t* Bt; int M, N, K; };
struct StaticOrder {
    int nM, nN, nwg, G, c;
    __host__ __device__ void init(int M, int N, int G_, int c_) { nM = M / BM; nN = N / BM; nwg = nM * nN; G = G_; c = c_; }
    __host__ __device__ bool next(int i, Unit& u) const {
        const long L = (long)i * G + c; if (L >= nwg) return false;
        int wgid = (int)L; { const int q = nwg / NXCD, r = nwg % NXCD, xcd = wgid % NXCD, off = wgid / NXCD; wgid = (xcd < r ? xcd * (q + 1) : r * (q + 1) + (xcd - r) * q) + off; }
        const int nig = WGM * nN, gid = wgid / nig, fm = gid * WGM, gsz = (nM - fm) < WGM ? (nM - fm) : WGM;
        u.pm = fm + ((wgid % nig) % gsz); u.pn = (wgid % nig) / gsz; return true;
    }
    __device__ __forceinline__ void a_ready(const Unit&) const {}
    __device__ __forceinline__ void done(const Unit&) const {}
};

template <class Epi, class Sched>
__device__ __forceinline__ void gemm_phase(LAS unsigned char* lds, const Gemm g, const Sched& S, const Epi& E) {
    const int tid = opaque_tid(), wid = __builtin_amdgcn_readfirstlane(tid >> 6), lane = tid & 63, wr = wid >> 2, wc = wid & 3, fr = lane & 15, fq = lane >> 4;
    const int K = g.K, nt = K / BK;
    unsigned voffA[2], voffB[2];
#pragma unroll
    for (int i = 0; i < 2; ++i) { int R, C; stage_rc(tid * 16 + i * 8192, R, C); const int Rb = Epi::PERM ? ((R & ~31) + perm32(R & 31)) : R;
        voffA[i] = (unsigned)(R * K + C) * 2u; voffB[i] = (unsigned)(Rb * K + C) * 2u; }
    const size_t kstep = (size_t)(BK * 2);
    const size_t hstep = (size_t)HALF * K * 2;
    const size_t tstep = 2 * hstep;
    const unsigned ldsw = (unsigned)wid * 1024u;
    const int aoff = lds_byte(wr * 64 + fr, fq * 8), boff = lds_byte(wc * 32 + fr, fq * 8);
#define PG8_SA(b, h) (((b) * 2 + (h)) * HTB)
#define PG8_SB(b, h) ((4 + (b) * 2 + (h)) * HTB)
#define PG8_STAGE(bufoff, gbase, voff) do { _Pragma("unroll") for (int _i = 0; _i < 2; ++_i) \
        __builtin_amdgcn_global_load_lds((const unsigned*)((const char*)(gbase) + (voff)[_i]), (LAS unsigned*)(lds + (bufoff) + ldsw + _i * 8192), 16, 0, 0); } while (0)
#define PG8_LDA(dst, b, h) do { _Pragma("unroll") for (int m = 0; m < 4; ++m) _Pragma("unroll") for (int k = 0; k < 2; ++k) dst[m][k] = *(const LAS bf16x8*)(lds + PG8_SA(b, h) + aoff + m * 2048 + k * 1024); } while (0)
#define PG8_LDB(dst, b, h) do { _Pragma("unroll") for (int n = 0; n < 2; ++n) _Pragma("unroll") for (int k = 0; k < 2; ++k) dst[n][k] = *(const LAS bf16x8*)(lds + PG8_SB(b, h) + boff + n * 2048 + k * 1024); } while (0)
#define PG8_MMA(ai, bj, At, Bt) do { __builtin_amdgcn_s_setprio(1); _Pragma("unroll") for (int m = 0; m < 4; ++m) _Pragma("unroll") for (int n = 0; n < 2; ++n) _Pragma("unroll") for (int k = 0; k < 2; ++k) \
        acc[ai][bj][m][n] = __builtin_amdgcn_mfma_f32_16x16x32_bf16(Bt[n][k], At[m][k], acc[ai][bj][m][n], 0, 0, 0); __builtin_amdgcn_s_setprio(0); } while (0)
#define PG8_WAIT_V(n) asm volatile("s_waitcnt vmcnt(" #n ")" ::: "memory")
#define PG8_WAIT_L(n) asm volatile("s_waitcnt lgkmcnt(" #n ")" ::: "memory")
#define PG8_BAR __builtin_amdgcn_s_barrier()
#define PG8_SCHED __builtin_amdgcn_sched_barrier(0)
    Unit cur, nxt; int ui = 0;
    if (!S.next(0, cur)) return;
    f32x4 acc[2][2][4][2];
#pragma unroll
    for (int a = 0; a < 2; ++a)
#pragma unroll
        for (int b = 0; b < 2; ++b)
#pragma unroll
            for (int m = 0; m < 4; ++m)
#pragma unroll
                for (int n = 0; n < 2; ++n) acc[a][b][m][n] = (f32x4){0.f, 0.f, 0.f, 0.f};
    bf16x8 At[4][2], B0[2][2], B1[2][2];
    const char* cA = (const char*)g.A + (size_t)cur.pm * tstep; const char* cB = (const char*)g.Bt + (size_t)cur.pn * tstep;
    PG8_STAGE(PG8_SB(0, 0), cB, voffB); PG8_STAGE(PG8_SB(0, 1), cB + hstep, voffB); PG8_STAGE(PG8_SA(0, 0), cA, voffA); PG8_STAGE(PG8_SA(0, 1), cA + hstep, voffA);
    if (wr == 1) PG8_BAR;
    PG8_WAIT_V(2); PG8_BAR;
    PG8_STAGE(PG8_SB(1, 0), cB + kstep, voffB); PG8_STAGE(PG8_SA(1, 0), cA + kstep, voffA); PG8_STAGE(PG8_SB(1, 1), cB + hstep + kstep, voffB);
    PG8_WAIT_V(6); PG8_BAR;
    for (;;) {
        const bool has_next = S.next(ui + 1, nxt);
        const char* nA = has_next ? (const char*)g.A + (size_t)nxt.pm * tstep : cA; const char* nB = has_next ? (const char*)g.Bt + (size_t)nxt.pn * tstep : cB;
        for (int t = 0; t < nt; t += 2) {
            const bool last = (t == nt - 2);
            const char* a1 = cA + (size_t)(t + 1) * kstep;
            const char* a2 = last ? nA : cA + (size_t)(t + 2) * kstep; const char* b2 = last ? nB : cB + (size_t)(t + 2) * kstep;
            const char* a3 = a2 + kstep; const char* b3 = b2 + kstep;
            PG8_LDB(B0, 0, 0); PG8_LDB(B1, 0, 1); PG8_SCHED; PG8_LDA(At, 0, 0); PG8_STAGE(PG8_SA(1, 1), a1 + hstep, voffA);
            PG8_WAIT_V(8); PG8_WAIT_L(0); PG8_BAR; PG8_MMA(0, 0, At, B0); PG8_MMA(0, 1, At, B1); PG8_BAR; PG8_SCHED;
            PG8_LDA(At, 0, 1); PG8_STAGE(PG8_SB(0, 0), b2, voffB); PG8_STAGE(PG8_SB(0, 1), b2 + hstep, voffB); PG8_STAGE(PG8_SA(0, 0), a2, voffA);
            PG8_WAIT_V(8); PG8_WAIT_L(0); PG8_BAR; PG8_MMA(1, 0, At, B0); PG8_MMA(1, 1, At, B1); PG8_BAR; PG8_SCHED;
            PG8_LDB(B0, 1, 0); PG8_LDB(B1, 1, 1); PG8_SCHED; PG8_LDA(At, 1, 0); PG8_STAGE(PG8_SA(0, 1), a2 + hstep, voffA);
            PG8_WAIT_V(8); PG8_WAIT_L(0); PG8_BAR; PG8_MMA(0, 0, At, B0); PG8_MMA(0, 1, At, B1); PG8_BAR; PG8_SCHED;
            PG8_LDA(At, 1, 1); PG8_STAGE(PG8_SB(1, 0), b3, voffB); PG8_STAGE(PG8_SB(1, 1), b3 + hstep, voffB); PG8_STAGE(PG8_SA(1, 0), a3, voffA);
            PG8_WAIT_V(8); PG8_WAIT_L(0); PG8_BAR; PG8_MMA(1, 0, At, B0); PG8_MMA(1, 1, At, B1); PG8_BAR; PG8_SCHED;
        }
        if (wr == 0) PG8_BAR;
        E(acc, cur, wr, wc, fr, fq);
        if (!has_next) break;
#pragma unroll
        for (int a = 0; a < 2; ++a)
#pragma unroll
            for (int b = 0; b < 2; ++b)
#pragma unroll
                for (int m = 0; m < 4; ++m)
#pragma unroll
                    for (int n = 0; n < 2; ++n) acc[a][b][m][n] = (f32x4){0.f, 0.f, 0.f, 0.f};
        cur = nxt; cA = nA; cB = nB; ++ui;
        if (wr == 1) PG8_BAR;
    }
    PG8_WAIT_V(0);
    PG8_BAR;
#undef PG8_SA
#undef PG8_SB
#undef PG8_STAGE
#undef PG8_LDA
#undef PG8_LDB
#undef PG8_MMA
#undef PG8_WAIT_V
#undef PG8_WAIT_L
#undef PG8_BAR
#undef PG8_SCHED
}
}

__device__ __forceinline__ void row_stats(const f32x2* st, int row, float& mu, float& rstd) {
    const f32x4 a = *(const f32x4*)(st + (size_t)row * 4), b = *(const f32x4*)(st + (size_t)row * 4 + 2);
    const float s = (a[0] + a[2]) + (b[0] + b[2]), q = (a[1] + a[3]) + (b[1] + b[3]);
    mu = s * (1.f / 1024.f); const float var = fmaxf(q * (1.f / 1024.f) - mu * mu, 0.f); rstd = rsqrtf(var + EPS);
}

__device__ __forceinline__ void tile_stats_to_lds(const f32x2* st, int row0, LAS f32x2* S, int tid) {
    if (tid < 256) { float mu, rstd; row_stats(st, row0 + tid, mu, rstd); S[tid] = (f32x2){mu, rstd}; }
    EPI_BAR();
}
struct EpiProj {
    static constexpr bool PERM = true;
    bf16_t* O; float* gates; const float* gate_bias; const f32x2* stats; const float* c1; const float* c2; LAS f32x2* S;
    __device__ __forceinline__ void operator()(f32x4 (&acc)[2][2][4][2], const pg8::Unit& u, int wr, int wc, int fr, int fq) const {
        asm volatile("" : "+v"(fr), "+v"(fq));
        const int colt = u.pn * 256 + wc * 32 + 8 * fq;
        if (stats) tile_stats_to_lds(stats, u.pm * 256, S, (wr * 4 + wc) * 64 + fq * 16 + fr);
        f32x4 c1v[2][2], c2v[2][2];
#pragma unroll
        for (int bj = 0; bj < 2; ++bj)
#pragma unroll
            for (int n = 0; n < 2; ++n) {
                if (stats) { c1v[bj][n] = *(const f32x4*)(c1 + colt + bj * 128 + 4 * n); c2v[bj][n] = *(const f32x4*)(c2 + colt + bj * 128 + 4 * n); }
                else { c1v[bj][n] = (f32x4){0.f, 0.f, 0.f, 0.f}; c2v[bj][n] = (f32x4){0.f, 0.f, 0.f, 0.f}; } }
        const float sc = (u.pn < 2 || u.pn == 7) ? 0.125f : 1.0f;
#pragma unroll
        for (int ai = 0; ai < 2; ++ai)
#pragma unroll
            for (int m = 0; m < 4; ++m) {
                const int row = u.pm * 256 + ai * 128 + wr * 64 + m * 16 + fr;
                float mu = 0.f, rstd = 1.f; if (stats) { const f32x2 sr = S[ai * 128 + wr * 64 + m * 16 + fr]; mu = sr.x; rstd = sr.y; }
                if (u.pn < 12) {
#pragma unroll
                    for (int bj = 0; bj < 2; ++bj) {
                        const f32x4 v0 = ((acc[ai][bj][m][0] - mu * c1v[bj][0]) * rstd + c2v[bj][0]) * sc, v1 = ((acc[ai][bj][m][1] - mu * c1v[bj][1]) * rstd + c2v[bj][1]) * sc;
                        u32x4 w; w.x = cvt_pk_bf16(v0[0], v0[1]); w.y = cvt_pk_bf16(v0[2], v0[3]); w.z = cvt_pk_bf16(v1[0], v1[1]); w.w = cvt_pk_bf16(v1[2], v1[3]);
                        *(u32x4*)(O + (size_t)row * NPROJ + colt + bj * 128) = w; }
                } else if (wc == 0 && fq < 2) {
#pragma unroll
                    for (int n = 0; n < 2; ++n) {
                        const f32x4 gb = *(const f32x4*)(gate_bias + 8 * fq + 4 * n);
                        *(f32x4*)(gates + (size_t)row * 16 + 8 * fq + 4 * n) = (acc[ai][0][m][n] - mu * c1v[0][n]) * rstd + c2v[0][n] + gb; }
                }
            }
    }
};

struct EpiRes {
    static constexpr bool PERM = false;
    const float* xin; float* v; const f32x2* st_in; const float* g_in; const float* b_in; f32x2* st_out; bf16_t* xb; LAS f32x2* P; LAS f32x2* S;
    __device__ __forceinline__ void operator()(f32x4 (&acc)[2][2][4][2], const pg8::Unit& u, int wr, int wc, int fr, int fq) const {
        asm volatile("" : "+v"(fr), "+v"(fq));
        const int colb = u.pn * 256 + wc * 32 + 4 * fq;
        if (!xin) tile_stats_to_lds(st_in, u.pm * 256, S, (wr * 4 + wc) * 64 + fq * 16 + fr);
        f32x4 gv[2][2], bv[2][2];
#pragma unroll
        for (int bj = 0; bj < 2; ++bj)
#pragma unroll
            for (int n = 0; n < 2; ++n) {
                if (!xin) { gv[bj][n] = *(const f32x4*)(g_in + colb + bj * 128 + n * 16); bv[bj][n] = *(const f32x4*)(b_in + colb + bj * 128 + n * 16); }
                else { gv[bj][n] = (f32x4){1.f, 1.f, 1.f, 1.f}; bv[bj][n] = (f32x4){0.f, 0.f, 0.f, 0.f}; } }
#pragma unroll
        for (int ai = 0; ai < 2; ++ai)
#pragma unroll
            for (int m = 0; m < 4; ++m) {
                const int rl = ai * 128 + wr * 64 + m * 16 + fr; const int row = u.pm * 256 + rl;
                float mu = 0.f, rstd = 1.f; if (!xin) { const f32x2 sr = S[rl]; mu = sr.x; rstd = sr.y; }
                const float* src = xin ? xin : v;
                float s = 0.f, q = 0.f;
#pragma unroll
                for (int bj = 0; bj < 2; ++bj)
#pragma unroll
                    for (int n = 0; n < 2; ++n) {
                        const size_t off = (size_t)row * DM + colb + bj * 128 + n * 16;
                        const f32x4 xv = *(const f32x4*)(src + off);
                        const f32x4 xp = (xv - mu) * rstd * gv[bj][n] + bv[bj][n];
                        const f32x4 o = xp * ALPHA + acc[ai][bj][m][n];
                        *(f32x4*)(v + off) = o;
                        if (xb) { u32x2 w; w.x = cvt_pk_bf16(o[0], o[1]); w.y = cvt_pk_bf16(o[2], o[3]); *(u32x2*)(xb + off) = w; }
                        s += (o[0] + o[1]) + (o[2] + o[3]); q += (o[0] * o[0] + o[1] * o[1]) + (o[2] * o[2] + o[3] * o[3]);
                    }
                s += __shfl_xor(s, 16); s += __shfl_xor(s, 32); q += __shfl_xor(q, 16); q += __shfl_xor(q, 32);
                if (fq == 0) P[rl * 4 + wc] = (f32x2){s, q};
            }
        EPI_BAR();
        const int tid = (wr * 4 + wc) * 64 + fq * 16 + fr;
        if (tid < 256) {
            const f32x2 a = P[tid * 4 + 0], b = P[tid * 4 + 1], c = P[tid * 4 + 2], d = P[tid * 4 + 3];
            st_out[(size_t)(u.pm * 256 + tid) * 4 + u.pn] = (f32x2){(a.x + b.x) + (c.x + d.x), (a.y + b.y) + (c.y + d.y)};
        }
    }
};

struct EpiGU {
    static constexpr bool PERM = false;
    bf16_t* hmid; float* edge; const f32x2* stats; const float* c1; const float* c2; const float* cw; const float* cb; LAS float* halo; LAS f32x2* S;
    __device__ __forceinline__ void operator()(f32x4 (&acc)[2][2][4][2], const pg8::Unit& u, int wr, int wc, int fr, int fq) const {
        asm volatile("" : "+v"(fr), "+v"(fq));
        const int colb = wc * 32 + 4 * fq; const int lane = fq * 16 + fr;
        const int jch0 = u.pn * 128 + colb;
        tile_stats_to_lds(stats, u.pm * 256, S, (wr * 4 + wc) * 64 + lane);
        u32x2 gk[2][4][2], uk[2][4][2];
        {
            f32x4 c1v[2][2], c2v[2][2];
#pragma unroll
            for (int bj = 0; bj < 2; ++bj)
#pragma unroll
                for (int n = 0; n < 2; ++n) { c1v[bj][n] = *(const f32x4*)(c1 + u.pn * 256 + bj * 128 + colb + 16 * n); c2v[bj][n] = *(const f32x4*)(c2 + u.pn * 256 + bj * 128 + colb + 16 * n); }
#pragma unroll
            for (int ai = 0; ai < 2; ++ai)
#pragma unroll
                for (int m = 0; m < 4; ++m) {
                    const f32x2 sr = S[ai * 128 + wr * 64 + m * 16 + fr]; const float mu = sr.x, rstd = sr.y;
                    const int blk = ai * 2 + wr;
#pragma unroll
                    for (int n = 0; n < 2; ++n) {
                        const f32x4 gv = (acc[ai][0][m][n] - mu * c1v[0][n]) * rstd + c2v[0][n];
                        const f32x4 uv = (acc[ai][1][m][n] - mu * c1v[1][n]) * rstd + c2v[1][n];
                        gk[ai][m][n].x = cvt_pk_bf16(gv[0], gv[1]); gk[ai][m][n].y = cvt_pk_bf16(gv[2], gv[3]);
                        uk[ai][m][n].x = cvt_pk_bf16(uv[0], uv[1]); uk[ai][m][n].y = cvt_pk_bf16(uv[2], uv[3]);
                        if (m == 0) {
                            if (fr == 0) *(LAS u32x2*)(halo + (blk * 2 + 0) * 128 + (colb + 16 * n) / 2) = gk[ai][m][n];
                            if (ai == 0 && wr == 0 && fr <= 1) *(f32x4*)(edge + ((size_t)u.pm * 6 + fr) * DFF + jch0 + 16 * n) = gv;
                            if (ai == 0 && wr == 0 && fr == 0) *(f32x4*)(edge + ((size_t)u.pm * 6 + 4) * DFF + jch0 + 16 * n) = uv;
                        }
                        if (m == 3) {
                            if (fr == 15) *(LAS u32x2*)(halo + (blk * 2 + 1) * 128 + (colb + 16 * n) / 2) = gk[ai][m][n];
                            if (ai == 1 && wr == 1 && fr >= 14) *(f32x4*)(edge + ((size_t)u.pm * 6 + 2 + (fr - 14)) * DFF + jch0 + 16 * n) = gv;
                            if (ai == 1 && wr == 1 && fr == 15) *(f32x4*)(edge + ((size_t)u.pm * 6 + 5) * DFF + jch0 + 16 * n) = uv;
                        }
                    }
                    SBAR();
                }
        }
        EPI_BAR(); SBAR();
#define BLO(x) __uint_as_float((x) << 16)
#define BHI(x) __uint_as_float((x) & 0xffff0000u)
#pragma unroll
        for (int n = 0; n < 2; ++n) {
            const f32x4 w0 = *(const f32x4*)(cw + jch0 + 16 * n), w1 = *(const f32x4*)(cw + DFF + jch0 + 16 * n), w2 = *(const f32x4*)(cw + 2 * DFF + jch0 + 16 * n), cbv = *(const f32x4*)(cb + jch0 + 16 * n);
#pragma unroll
            for (int ai = 0; ai < 2; ++ai) {
                const int blk = ai * 2 + wr;
                u32x2 top = (u32x2){0u, 0u}, bot = (u32x2){0u, 0u};
                if (blk > 0) top = *(const LAS u32x2*)(halo + ((blk - 1) * 2 + 1) * 128 + (colb + 16 * n) / 2);
                if (blk < 3) bot = *(const LAS u32x2*)(halo + ((blk + 1) * 2 + 0) * 128 + (colb + 16 * n) / 2);
                u32x2 hk[4];
#pragma unroll
                for (int w = 0; w < 2; ++w) {
                    unsigned a_[4], b_[4], c_[4], d_[4];
#pragma unroll
                    for (int m = 0; m < 4; ++m) { const unsigned gv = gk[ai][m][n][w];
                        a_[m] = (unsigned)__shfl((int)gv, (lane - 1) & 63); b_[m] = (unsigned)__shfl((int)gv, (lane + 15) & 63);
                        c_[m] = (unsigned)__shfl((int)gv, (lane + 1) & 63); d_[m] = (unsigned)__shfl((int)gv, (lane - 15) & 63); }
#pragma unroll
                    for (int m = 0; m < 4; ++m) {
                        const unsigned prev = (fr > 0) ? a_[m] : (m > 0 ? b_[m > 0 ? m - 1 : 0] : top[w]);
                        const unsigned next = (fr < 15) ? c_[m] : (m < 3 ? d_[m < 3 ? m + 1 : 3] : bot[w]);
                        const unsigned cur = gk[ai][m][n][w], upw = uk[ai][m][n][w];
                        const float cv0 = cbv[2 * w] + w0[2 * w] * BLO(prev) + w1[2 * w] * BLO(cur) + w2[2 * w] * BLO(next);
                        const float cv1 = cbv[2 * w + 1] + w0[2 * w + 1] * BHI(prev) + w1[2 * w + 1] * BHI(cur) + w2[2 * w + 1] * BHI(next);
                        hk[m][w] = cvt_pk_bf16(gelu_erf(cv0) * BLO(upw), gelu_erf(cv1) * BHI(upw));
                    }
                    SBAR();
                }
#pragma unroll
                for (int m = 0; m < 4; ++m) {
                    const int rl = ai * 128 + wr * 64 + m * 16 + fr;
                    if (rl != 0 && rl != 255) *(u32x2*)(hmid + (size_t)(u.pm * 256 + rl) * DFF + jch0 + 16 * n) = hk[m];
                }
                SBAR();
            }
        }
#undef BLO
#undef BHI
    }
};

namespace att {
constexpr int KVBLK = 64, SHM_V = 16384, SHM_K = 16384, WS_OFF = 73728, OB_PITCH = 132;
constexpr float THR = 8.f;
#define KSWZ(row, colB) ((row) * 256 + ((colB) ^ (((row) & 7) << 4)))
__device__ __forceinline__ void alibi(f32x16& p0, f32x16& p1, float t0, float nslope) {
#pragma unroll
    for (int r = 0; r < 16; ++r) { const float kr = (float)((r & 3) + 8 * (r >> 2));
        p0[r] = fmaf(nslope, fabsf(t0 - kr), p0[r]); p1[r] = fmaf(nslope, fabsf(t0 - kr - 32.f), p1[r]); }
}
__device__ __forceinline__ void partialSM(f32x16& p0, f32x16& p1, float& m_reg, float& mn, float& alpha) {
    constexpr float C = 1.4426950408889634f;
    float pmax = p0[0];
#pragma unroll
    for (int r = 1; r < 16; ++r) pmax = fmaxf(pmax, p0[r]);
#pragma unroll
    for (int r = 0; r < 16; ++r) pmax = fmaxf(pmax, p1[r]);
    { auto rr = __builtin_amdgcn_permlane32_swap(__float_as_uint(pmax), __float_as_uint(pmax), false, false);
      pmax = fmaxf(__uint_as_float(rr[0]), __uint_as_float(rr[1])); }
    if (__builtin_expect(__all(pmax - m_reg <= THR), 1)) { mn = m_reg; alpha = 1.f; }
    else { mn = fmaxf(m_reg, pmax); alpha = __builtin_amdgcn_exp2f((m_reg - mn) * C); m_reg = mn; }
    const float mnC = -mn * C;
#pragma unroll
    for (int r = 0; r < 16; ++r) p0[r] = fmaf(p0[r], C, mnC);
#pragma unroll
    for (int r = 0; r < 16; ++r) p1[r] = fmaf(p1[r], C, mnC);
#pragma unroll
    for (int r = 0; r < 16; ++r) p0[r] = __builtin_amdgcn_exp2f(p0[r]);
}
__device__ __forceinline__ void finishSM(f32x16& p0, f32x16& p1, float alpha, float& l_reg, bf16x8& pa0, bf16x8& pa1, bf16x8& pa2, bf16x8& pa3) {
#pragma unroll
    for (int r = 0; r < 16; ++r) p1[r] = __builtin_amdgcn_exp2f(p1[r]);
    float ps = 0;
#pragma unroll
    for (int r = 0; r < 16; ++r) ps += p0[r];
#pragma unroll
    for (int r = 0; r < 16; ++r) ps += p1[r];
    { auto rr = __builtin_amdgcn_permlane32_swap(__float_as_uint(ps), __float_as_uint(ps), false, false);
      ps = __uint_as_float(rr[0]) + __uint_as_float(rr[1]); }
    l_reg = l_reg * alpha + ps;
#define PK4(P, BASE, OUT) do { unsigned a0 = cvt_pk_bf16(P[BASE + 0], P[BASE + 1]), a1 = cvt_pk_bf16(P[BASE + 2], P[BASE + 3]);   \
    unsigned b0 = cvt_pk_bf16(P[BASE + 4], P[BASE + 5]), b1 = cvt_pk_bf16(P[BASE + 6], P[BASE + 7]);                              \
    auto r0 = __builtin_amdgcn_permlane32_swap(a0, b0, false, false); auto r1 = __builtin_amdgcn_permlane32_swap(a1, b1, false, false); \
    u32x4 w = {r0[0], r1[0], r0[1], r1[1]}; OUT = *reinterpret_cast<bf16x8*>(&w); } while (0)
    PK4(p0, 0, pa0); PK4(p0, 8, pa1); PK4(p1, 0, pa2); PK4(p1, 8, pa3);
#undef PK4
}
__device__ __forceinline__ void qkt(f32x16& p0, f32x16& p1, const LAS char* Ks, const bf16x8* qr, int r32, int hi, int c) {
    p0 = f32x16{}; p1 = f32x16{};
#pragma unroll
    for (int d0 = 0; d0 < 4; ++d0) { const int cb = ((c * 4 + d0) * 16 + hi * 8) * 2;
        const bf16x8 b0 = *reinterpret_cast<const LAS bf16x8*>(Ks + KSWZ(r32, cb));
        const bf16x8 b1 = *reinterpret_cast<const LAS bf16x8*>(Ks + KSWZ(32 + r32, cb));
        p0 = __builtin_amdgcn_mfma_f32_32x32x16_bf16(b0, qr[d0], p0, 0, 0, 0);
        p1 = __builtin_amdgcn_mfma_f32_32x32x16_bf16(b1, qr[d0], p1, 0, 0, 0); }
}
__device__ __forceinline__ int v_st(int k, int c) { const int kk = (k & ~0xC) | ((k & 4) << 1) | ((k & 8) >> 1); return ((kk >> 3) * 4 + (c >> 5)) * 512 + ((kk & 7) * 32 + (c & 31)) * 2; }
__device__ __forceinline__ int v_rd_base(int lane) { return ((lane & 3) << 3) | (((lane >> 2) & 3) << 6) | (((lane >> 4) & 1) << 5) | (((lane >> 5) & 1) << 8); }
constexpr int v_rd_off(int d0, int ks, int half) { return d0 * 512 + ks * 4096 + half * 2048; }
template <int OFF> __device__ __forceinline__ s16x4 tr_read(int vb) {
    s16x4 r; asm volatile("ds_read_b64_tr_b16 %0, %1 offset:%2" : "=&v"(r) : "v"(vb), "i"(OFF) : "memory"); return r;
}
template <int D0> __device__ __forceinline__ void pv_one(f32x16& od, int vb, bf16x8 pa0, bf16x8 pa1, bf16x8 pa2, bf16x8 pa3) {
    const s16x4 l0 = tr_read<v_rd_off(D0, 0, 0)>(vb), h0 = tr_read<v_rd_off(D0, 0, 1)>(vb), l1 = tr_read<v_rd_off(D0, 1, 0)>(vb), h1 = tr_read<v_rd_off(D0, 1, 1)>(vb);
    const s16x4 l2 = tr_read<v_rd_off(D0, 2, 0)>(vb), h2 = tr_read<v_rd_off(D0, 2, 1)>(vb), l3 = tr_read<v_rd_off(D0, 3, 0)>(vb), h3 = tr_read<v_rd_off(D0, 3, 1)>(vb);
    asm volatile("s_waitcnt lgkmcnt(0)" ::: "memory"); SBAR();
#define PK(L, H) (bf16x8){L[0], L[1], L[2], L[3], H[0], H[1], H[2], H[3]}
    od = __builtin_amdgcn_mfma_f32_32x32x16_bf16(pa0, PK(l0, h0), od, 0, 0, 0);
    od = __builtin_amdgcn_mfma_f32_32x32x16_bf16(pa1, PK(l1, h1), od, 0, 0, 0);
    od = __builtin_amdgcn_mfma_f32_32x32x16_bf16(pa2, PK(l2, h2), od, 0, 0, 0);
    od = __builtin_amdgcn_mfma_f32_32x32x16_bf16(pa3, PK(l3, h3), od, 0, 0, 0);
#undef PK
}
__device__ __forceinline__ void pv_d0(f32x16* o, int vb, bf16x8 pa0, bf16x8 pa1, bf16x8 pa2, bf16x8 pa3) {
    pv_one<0>(o[0], vb, pa0, pa1, pa2, pa3); pv_one<1>(o[1], vb, pa0, pa1, pa2, pa3); pv_one<2>(o[2], vb, pa0, pa1, pa2, pa3); pv_one<3>(o[3], vb, pa0, pa1, pa2, pa3);
}

__device__ __forceinline__ void attn_unit(const bf16_t* __restrict__ proj, bf16_t* __restrict__ mixed, const float* __restrict__ att_g,
                                          int seq, long row0, int h, int qb, float lam, float nslope, float oscale, LAS char* lds) {
    const int tid = opaque_tid(), wid = tid >> 6, lane = tid & 63, r32 = lane & 31, hi = lane >> 5, c = wid >> 2, wq = wid & 3;
    LAS char* V_lds = lds; LAS char* K_lds = lds + 2 * SHM_V;
    LAS float* ws = (LAS float*)(lds + WS_OFF) + wid * 64; LAS float* li_l = ws; LAS float* al_l = ws + 32;
    float m_reg = -1e30f, l_reg = 0; f32x16 o[4] = {}; bf16x8 qr[4];
    const int qrow = qb * 128 + wq * 32 + r32;
    const bf16_t* Qw = proj + (size_t)(row0 + qrow) * NPROJ + h * 128 + c * 64 + hi * 8;
#pragma unroll
    for (int d0 = 0; d0 < 4; ++d0) qr[d0] = *reinterpret_cast<const bf16x8*>(Qw + d0 * 16);
    const bf16_t* Kh = proj + (size_t)row0 * NPROJ + 512 + h * 128; const bf16_t* Vh = proj + (size_t)row0 * NPROJ + 1024 + h * 128;
    const int sr = tid >> 4, sc = (tid & 15) * 8, vst0 = v_st(sr, sc), vst1 = v_st(32 + sr, sc);
    const int vb0 = (int)(uintptr_t)V_lds + v_rd_base(lane);
    const float qposf = (float)(qrow - 4 * hi);
    struct { bf16x8 vs0, vs1, ks0, ks1; } sr_[2];
#define SLOAD(i, k0) do { sr_[i].vs0 = *reinterpret_cast<const bf16x8*>(&Vh[(size_t)((k0) + sr) * NPROJ + sc]); sr_[i].vs1 = *reinterpret_cast<const bf16x8*>(&Vh[(size_t)((k0) + 32 + sr) * NPROJ + sc]); \
    sr_[i].ks0 = *reinterpret_cast<const bf16x8*>(&Kh[(size_t)((k0) + sr) * NPROJ + sc]); sr_[i].ks1 = *reinterpret_cast<const bf16x8*>(&Kh[(size_t)((k0) + 32 + sr) * NPROJ + sc]); } while (0)
#define SWRITE(b, i) do { *(LAS bf16x8*)(V_lds + (b) * SHM_V + vst0) = sr_[i].vs0;          \
    *(LAS bf16x8*)(V_lds + (b) * SHM_V + vst1) = sr_[i].vs1; const int kc = sc * 2;               \
    *(LAS bf16x8*)(K_lds + (b) * SHM_K + KSWZ(sr, kc)) = sr_[i].ks0;                       \
    *(LAS bf16x8*)(K_lds + (b) * SHM_K + KSWZ(32 + sr, kc)) = sr_[i].ks1; } while (0)
#define SWAIT() asm volatile("s_waitcnt vmcnt(4)" ::: "memory")
#define RESC(a) do { if (__any((a) < 1.f)) { if (hi == 0) al_l[r32] = (a); asm volatile("s_waitcnt lgkmcnt(0)" ::: "memory"); \
    for (int d = 0; d < 4; ++d) for (int r = 0; r < 16; ++r) o[d][r] *= al_l[crow(r, hi)]; } } while (0)
    f32x16 pA0, pA1, pB0, pB1; float mnA, mnB, alA, alB; bf16x8 pa0, pa1, pa2, pa3; const int NT = seq / KVBLK;
    constexpr int SE = 0, SO = 1;
    SLOAD(SE, 0); asm volatile("s_waitcnt vmcnt(0)" ::: "memory"); SWRITE(0, SE); __syncthreads();
    qkt(pA0, pA1, K_lds, qr, r32, hi, c); alibi(pA0, pA1, qposf, nslope); partialSM(pA0, pA1, m_reg, mnA, alA);
    SLOAD(SO, KVBLK); if (2 < NT) SLOAD(SE, 2 * KVBLK);
    SWAIT(); SWRITE(1, SO); __syncthreads();
    for (int j = 1; j + 1 < NT; j += 2) {
        SBAR(); qkt(pB0, pB1, K_lds + SHM_K, qr, r32, hi, c);
        finishSM(pA0, pA1, alA, l_reg, pa0, pa1, pa2, pa3); SBAR();
        SLOAD(SO, (j + 2) * KVBLK); SBAR();
        pv_d0(o, vb0, pa0, pa1, pa2, pa3); alibi(pB0, pB1, qposf - (float)(j * KVBLK), nslope); partialSM(pB0, pB1, m_reg, mnB, alB);
        __syncthreads(); SWAIT(); SWRITE(0, SE);
        RESC(alB); __syncthreads();
        SBAR(); qkt(pA0, pA1, K_lds, qr, r32, hi, c);
        finishSM(pB0, pB1, alB, l_reg, pa0, pa1, pa2, pa3); SBAR();
        if (j + 3 < NT) SLOAD(SE, (j + 3) * KVBLK); SBAR();
        pv_d0(o, vb0 + SHM_V, pa0, pa1, pa2, pa3); alibi(pA0, pA1, qposf - (float)((j + 1) * KVBLK), nslope); partialSM(pA0, pA1, m_reg, mnA, alA);
        __syncthreads(); SWAIT(); SWRITE(1, SO);
        RESC(alA); __syncthreads();
    }
    SBAR(); qkt(pB0, pB1, K_lds + SHM_K, qr, r32, hi, c);
    finishSM(pA0, pA1, alA, l_reg, pa0, pa1, pa2, pa3); SBAR();
    pv_d0(o, vb0, pa0, pa1, pa2, pa3); alibi(pB0, pB1, qposf - (float)((NT - 1) * KVBLK), nslope); partialSM(pB0, pB1, m_reg, mnB, alB);
    __syncthreads(); RESC(alB);
    finishSM(pB0, pB1, alB, l_reg, pa0, pa1, pa2, pa3); SBAR();
    pv_d0(o, vb0 + SHM_V, pa0, pa1, pa2, pa3);
    if (hi == 0) li_l[r32] = l_reg; asm volatile("s_waitcnt lgkmcnt(0)" ::: "memory");
    float rli[16];
#pragma unroll
    for (int r = 0; r < 16; ++r) rli[r] = __builtin_amdgcn_rcpf(li_l[crow(r, hi)]);
    __syncthreads();
    LAS float* OB = (LAS float*)lds;
    if (c == 1) {
#pragma unroll
        for (int r = 0; r < 16; ++r) { const int orow = wq * 32 + crow(r, hi);
#pragma unroll
            for (int d0 = 0; d0 < 4; ++d0) OB[orow * OB_PITCH + d0 * 32 + r32] = o[d0][r] * rli[r]; }
    }
    __syncthreads();
    if (c == 0) {
        float gcol[4];
#pragma unroll
        for (int d0 = 0; d0 < 4; ++d0) gcol[d0] = att_g[h * 128 + d0 * 32 + r32] * oscale;
#pragma unroll
        for (int r = 0; r < 16; ++r) { const int orow = wq * 32 + crow(r, hi);
            float dv[4]; float ss = 0.f;
#pragma unroll
            for (int d0 = 0; d0 < 4; ++d0) { dv[d0] = o[d0][r] * rli[r] - lam * OB[orow * OB_PITCH + d0 * 32 + r32]; ss += dv[d0] * dv[d0]; }
            ss += __shfl_xor(ss, 1); ss += __shfl_xor(ss, 2); ss += __shfl_xor(ss, 4); ss += __shfl_xor(ss, 8); ss += __shfl_xor(ss, 16);
            const float rs = rsqrtf(ss * (1.f / 128.f) + EPS);
            bf16_t* orp = mixed + (size_t)(row0 + qb * 128 + orow) * DM + h * 128 + r32;
#pragma unroll
            for (int d0 = 0; d0 < 4; ++d0) orp[d0 * 32] = f2bf(dv[d0] * rs * gcol[d0]); }
    }
    __syncthreads();
#undef SLOAD
#undef SWRITE
#undef SWAIT
#undef RESC
}
}

namespace ml {
constexpr int QP = 192, VP = 320, SP = 272, CP = 320;
constexpr int OFF_Q = 0, OFF_K = 24576, OFF_KE = 49152, OFF_V = 73728, OFF_C = 114688, OFF_VEC = 135168;
constexpr int V_U = 0, V_MX = 128, V_EINT = 256, V_EEND = 384, V_EMO = 512, V_QN = 640, V_RS = 768, V_GI = 896, V_GF = 1024, V_NST = 1152, V_NPART = 1216, V_SCAL = 1728;
constexpr int HS_PITCH = 132;
__device__ __forceinline__ s16x4 trr(unsigned addr) { s16x4 r; asm volatile("ds_read_b64_tr_b16 %0, %1" : "=&v"(r) : "v"(addr) : "memory"); return r; }
#define TRWAIT2(a, b) asm volatile("s_waitcnt lgkmcnt(0)" : "+v"(a), "+v"(b) :: "memory")
#define TRWAIT4(a, b, c, d) asm volatile("s_waitcnt lgkmcnt(0)" : "+v"(a), "+v"(b), "+v"(c), "+v"(d) :: "memory")
#define CAT(L, H) (bf16x8){L[0], L[1], L[2], L[3], H[0], H[1], H[2], H[3]}
__device__ __forceinline__ float logsig(float x) { return fminf(x, 0.f) - log1pf(expf(-fabsf(x))); }

__device__ __forceinline__ void mlstm_item(const bf16_t* __restrict__ proj, const float* __restrict__ gates, bf16_t* mixed, const float* __restrict__ lstm_g,
                                           int seq, long row0, int h, LAS unsigned char* lds) {
    const int tid0 = opaque_tid();
    LAS float* vec = (LAS float*)(lds + OFF_VEC);
    const unsigned lbase = (unsigned)(uintptr_t)lds;
    const int nc = seq / 128;
    constexpr float L2E = 1.4426950408889634f;
    for (int dir = 0; dir < 2; ++dir) {
        f32x16 Cst = {};
        if (tid0 < 64) vec[V_NST + tid0] = 0.f;
        float m_state = 0.f;
        __syncthreads();
        for (int cc = 0; cc < nc; ++cc) {
            int tid = tid0; asm volatile("" : "+v"(tid));
            const int wid = tid >> 6, lane = tid & 63, r = lane & 31, hh = lane >> 5, i16 = lane & 15, q4 = i16 >> 2, p4 = i16 & 3, blk = (lane >> 4) & 1;
            const int rb = wid >> 1, ch = wid & 1, db = wid >> 2, eb = wid & 3;
            const int c = dir ? nc - 1 - cc : cc;
            const long cbase = row0 + (long)c * 128;
#define POS(j) (cbase + (dir ? 127 - (j) : (j)))
#pragma unroll
            for (int i = 0; i < 2; ++i) { const int chunk = tid + 512 * i, j = chunk >> 3, c8 = chunk & 7; const bf16_t* src = proj + (size_t)POS(j) * NPROJ + h * 64 + c8 * 8;
                *(LAS bf16x8*)(lds + OFF_Q + j * QP + c8 * 16) = *(const bf16x8*)(src + 1536);
                *(LAS bf16x8*)(lds + OFF_K + j * QP + c8 * 16) = *(const bf16x8*)(src + 1792); }
#pragma unroll
            for (int i = 0; i < 4; ++i) { const int chunk = tid + 512 * i, j = chunk >> 4, c16 = chunk & 15;
                *(LAS bf16x8*)(lds + OFF_V + j * VP + c16 * 16) = *(const bf16x8*)(proj + (size_t)POS(j) * NPROJ + 2048 + h * 128 + c16 * 8); }
            if (tid < 128) { const float* gp = gates + (size_t)POS(tid) * 16; vec[V_GI + tid] = gp[(dir ? 8 : 0) + h]; vec[V_GF + tid] = gp[(dir ? 12 : 4) + h]; }
#pragma unroll
            for (int i = 0; i < 16; ++i) *(LAS bf16_t*)(lds + OFF_C + (32 * db + crow(i, hh)) * CP + (32 * eb + r) * 2) = f2bf(Cst[i]);
            __syncthreads();
            if (wid == 0) {
                const float gf0 = vec[V_GF + 2 * lane], gf1 = vec[V_GF + 2 * lane + 1], gi0 = vec[V_GI + 2 * lane], gi1 = vec[V_GI + 2 * lane + 1];
                const float lf0 = logsig(gf0), lf1 = logsig(gf1);
                float incl = lf0 + lf1;
#pragma unroll
                for (int d = 1; d < 64; d <<= 1) { const float t = __shfl_up(incl, d); if (lane >= d) incl += t; }
                const float b1 = incl, b0 = incl - lf1, g = __shfl(incl, 63);
                const float u0 = gi0 - b0, u1 = gi1 - b1;
                float cm = fmaxf(u0, u1);
#pragma unroll
                for (int d = 1; d < 64; d <<= 1) { const float t = __shfl_up(cm, d); if (lane >= d) cm = fmaxf(cm, t); }
                float excl = __shfl_up(cm, 1); if (lane == 0) excl = -INFINITY;
                const float cmx0 = fmaxf(excl, u0), cmx1 = cm, umax = __shfl(cm, 63);
                const float mp = m_state, mx0 = fmaxf(mp, cmx0), mx1 = fmaxf(mp, cmx1);
                vec[V_U + 2 * lane] = u0; vec[V_U + 2 * lane + 1] = u1; vec[V_MX + 2 * lane] = mx0; vec[V_MX + 2 * lane + 1] = mx1;
                vec[V_EINT + 2 * lane] = expf(mp - mx0); vec[V_EINT + 2 * lane + 1] = expf(mp - mx1);
                vec[V_EEND + 2 * lane] = expf(u0 - umax); vec[V_EEND + 2 * lane + 1] = expf(u1 - umax);
                vec[V_EMO + 2 * lane] = expf(-(b0 + mx0)); vec[V_EMO + 2 * lane + 1] = expf(-(b1 + mx1));
                const float m_loc = g + umax, m_new = fmaxf(g + mp, m_loc);
                if (lane == 0) { vec[V_SCAL] = expf(g + mp - m_new); vec[V_SCAL + 1] = expf(m_loc - m_new); }
                m_state = m_new;
            }
            bf16x8 qa[4];
#pragma unroll
            for (int ks = 0; ks < 4; ++ks) qa[ks] = *(const LAS bf16x8*)(lds + OFF_Q + (32 * rb + r) * QP + (16 * ks + 8 * hh) * 2);
            f32x16 Sv[2] = {}, Ov[2] = {};
#pragma unroll
            for (int t = 0; t < 2; ++t) {
                if (2 * ch + t <= rb) {
#pragma unroll
                    for (int ks = 0; ks < 4; ++ks) { const bf16x8 kb = *(const LAS bf16x8*)(lds + OFF_K + (64 * ch + 32 * t + r) * QP + (16 * ks + 8 * hh) * 2);
                        Sv[t] = __builtin_amdgcn_mfma_f32_32x32x16_bf16(qa[ks], kb, Sv[t], 0, 0, 0); } }
#pragma unroll
                for (int ks = 0; ks < 4; ++ks) { const unsigned a0 = lbase + OFF_C + (16 * ks + 8 * hh + q4) * CP + (64 * ch + 32 * t + 16 * blk + 4 * p4) * 2;
                    s16x4 lo = trr(a0), hi4 = trr(a0 + 4 * CP); TRWAIT2(lo, hi4);
                    Ov[t] = __builtin_amdgcn_mfma_f32_32x32x16_bf16(qa[ks], CAT(lo, hi4), Ov[t], 0, 0, 0); }
            }
            { const int j = tid >> 2, part = tid & 3; float s = 0.f;
#pragma unroll
              for (int k2 = 0; k2 < 2; ++k2) { const bf16x8 qv = *(const LAS bf16x8*)(lds + OFF_Q + j * QP + (16 * part + 8 * k2) * 2);
#pragma unroll
                  for (int e = 0; e < 8; ++e) s += bf2f((bf16_t)qv[e]) * vec[V_NST + 16 * part + 8 * k2 + e]; }
              s += __shfl_xor(s, 1); s += __shfl_xor(s, 2); if (part == 0) vec[V_QN + j] = s; }
            __syncthreads();
#pragma unroll
            for (int i = 0; i < 2; ++i) { const int chunk = tid + 512 * i, j = chunk >> 3, c8 = chunk & 7; const float ee = vec[V_EEND + j];
                const bf16x8 kv = *(const LAS bf16x8*)(lds + OFF_K + j * QP + c8 * 16); u32x4 w;
                w.x = cvt_pk_bf16(bf2f((bf16_t)kv[0]) * ee, bf2f((bf16_t)kv[1]) * ee); w.y = cvt_pk_bf16(bf2f((bf16_t)kv[2]) * ee, bf2f((bf16_t)kv[3]) * ee);
                w.z = cvt_pk_bf16(bf2f((bf16_t)kv[4]) * ee, bf2f((bf16_t)kv[5]) * ee); w.w = cvt_pk_bf16(bf2f((bf16_t)kv[6]) * ee, bf2f((bf16_t)kv[7]) * ee);
                *(LAS u32x4*)(lds + OFF_KE + j * QP + c8 * 16) = w; }
            {
                const float us0 = vec[V_U + 64 * ch + r] * L2E, us1 = vec[V_U + 64 * ch + 32 + r] * L2E;
#pragma unroll
                for (int i = 0; i < 16; ++i) { const int j = 32 * rb + crow(i, hh); const float mxj = vec[V_MX + j] * L2E, ei = vec[V_EINT + j];
                    const int s0 = 64 * ch + r, s1 = s0 + 32;
                    Sv[0][i] = (s0 <= j) ? Sv[0][i] * __builtin_amdgcn_exp2f(us0 - mxj) : 0.f;
                    Sv[1][i] = (s1 <= j) ? Sv[1][i] * __builtin_amdgcn_exp2f(us1 - mxj) : 0.f;
                    Ov[0][i] *= ei; Ov[1][i] *= ei; }
            }
            __syncthreads();
#pragma unroll
            for (int t = 0; t < 2; ++t)
#pragma unroll
                for (int i = 0; i < 16; ++i) *(LAS bf16_t*)(lds + OFF_Q + (32 * rb + crow(i, hh)) * SP + (64 * ch + 32 * t + r) * 2) = f2bf(Sv[t][i]);
            __syncthreads();
#pragma unroll 1
            for (int ks = 0; ks < 2 * (rb + 1); ++ks) {
                const bf16x8 a = *(const LAS bf16x8*)(lds + OFF_Q + (32 * rb + r) * SP + (16 * ks + 8 * hh) * 2);
                const unsigned a0 = lbase + OFF_V + (16 * ks + 8 * hh + q4) * VP + (64 * ch + 16 * blk + 4 * p4) * 2;
                s16x4 l0 = trr(a0), h0 = trr(a0 + 4 * VP), l1 = trr(a0 + 64), h1 = trr(a0 + 4 * VP + 64); TRWAIT4(l0, h0, l1, h1);
                Ov[0] = __builtin_amdgcn_mfma_f32_32x32x16_bf16(a, CAT(l0, h0), Ov[0], 0, 0, 0);
                Ov[1] = __builtin_amdgcn_mfma_f32_32x32x16_bf16(a, CAT(l1, h1), Ov[1], 0, 0, 0);
            }
            { const int j = tid >> 2, part = tid & 3; float s = 0.f;
#pragma unroll
              for (int k4 = 0; k4 < 4; ++k4) { const bf16x8 sv = *(const LAS bf16x8*)(lds + OFF_Q + j * SP + (32 * part + 8 * k4) * 2);
#pragma unroll
                  for (int e = 0; e < 8; ++e) s += bf2f((bf16_t)sv[e]); }
              s += __shfl_xor(s, 1); s += __shfl_xor(s, 2); if (part == 0) vec[V_RS + j] = s; }
            f32x16 Cl = {};
#pragma unroll 2
            for (int ks = 0; ks < 8; ++ks) {
                const unsigned aa = lbase + OFF_KE + (16 * ks + 8 * hh + q4) * QP + (32 * db + 16 * blk + 4 * p4) * 2;
                const unsigned ab = lbase + OFF_V + (16 * ks + 8 * hh + q4) * VP + (32 * eb + 16 * blk + 4 * p4) * 2;
                s16x4 la = trr(aa), ha = trr(aa + 4 * QP), lb = trr(ab), hb = trr(ab + 4 * VP); TRWAIT4(la, ha, lb, hb);
                Cl = __builtin_amdgcn_mfma_f32_32x32x16_bf16(CAT(la, ha), CAT(lb, hb), Cl, 0, 0, 0);
            }
            const float sa = vec[V_SCAL], sb = vec[V_SCAL + 1];
#pragma unroll
            for (int i = 0; i < 16; ++i) Cst[i] = sa * Cst[i] + sb * Cl[i];
            { const int d = tid & 63, part = tid >> 6; float s = 0.f;
#pragma unroll
              for (int k = 0; k < 16; ++k) s += bf2f(*(const LAS bf16_t*)(lds + OFF_KE + (16 * part + k) * QP + d * 2));
              vec[V_NPART + part * 64 + d] = s; }
            __syncthreads();
            if (tid < 64) { float nl = 0.f;
#pragma unroll
                for (int p = 0; p < 8; ++p) nl += vec[V_NPART + p * 64 + tid];
                vec[V_NST + tid] = sa * vec[V_NST + tid] + sb * nl; }
            LAS float* HS = (LAS float*)lds;
#pragma unroll
            for (int i = 0; i < 16; ++i) { const int j = 32 * rb + crow(i, hh);
                const float den = vec[V_EINT + j] * vec[V_QN + j] + vec[V_RS + j];
                const float scl = 1.0f / fmaxf(fabsf(den), vec[V_EMO + j]);
                bf16_t* op = mixed + (size_t)POS(j) * DM + 512 + h * 128 + 64 * ch + r;
                if (dir == 0) { op[0] = f2bf(Ov[0][i] * scl); op[32] = f2bf(Ov[1][i] * scl); }
                else { HS[j * HS_PITCH + 64 * ch + r] = Ov[0][i] * scl + bf2f(op[0]); HS[j * HS_PITCH + 64 * ch + 32 + r] = Ov[1][i] * scl + bf2f(op[32]); } }
            if (dir == 1) {
                __syncthreads();
                const int j = tid >> 2, part = tid & 3; float ss = 0.f;
#pragma unroll
                for (int k = 0; k < 8; ++k) { const f32x4 x = *(const LAS f32x4*)(HS + j * HS_PITCH + 32 * part + 4 * k);
                    ss += (x[0] * x[0] + x[1] * x[1]) + (x[2] * x[2] + x[3] * x[3]); }
                ss += __shfl_xor(ss, 1); ss += __shfl_xor(ss, 2);
                const float rs = rsqrtf(ss * (1.f / 128.f) + EPS);
                const bf16_t* lop = proj + (size_t)POS(j) * NPROJ + 2560 + h * 128 + 32 * part;
                bf16_t* op = mixed + (size_t)POS(j) * DM + 512 + h * 128 + 32 * part;
                const float* gp = lstm_g + h * 128 + 32 * part;
#pragma unroll
                for (int k = 0; k < 4; ++k) { const bf16x8 lo8 = *(const bf16x8*)(lop + 8 * k); float ov[8];
                    const f32x4 xa = *(const LAS f32x4*)(HS + j * HS_PITCH + 32 * part + 8 * k), xb4 = *(const LAS f32x4*)(HS + j * HS_PITCH + 32 * part + 8 * k + 4);
                    const float hv8[8] = {xa[0], xa[1], xa[2], xa[3], xb4[0], xb4[1], xb4[2], xb4[3]};
#pragma unroll
                    for (int e = 0; e < 8; ++e) { const float lg = bf2f((bf16_t)lo8[e]); const float sg = 1.0f / (1.0f + expf(-lg)); ov[e] = sg * hv8[e] * rs * gp[8 * k + e]; }
                    u32x4 w; w.x = cvt_pk_bf16(ov[0], ov[1]); w.y = cvt_pk_bf16(ov[2], ov[3]); w.z = cvt_pk_bf16(ov[4], ov[5]); w.w = cvt_pk_bf16(ov[6], ov[7]);
                    *(u32x4*)(op + 8 * k) = w; }
            }
            __syncthreads();
#undef POS
        }
        __threadfence(); __syncthreads();
    }
}
}

struct Args {
    const float* xin[2]; const float* w_in; const float* gate_bias; const float* lam_q1; const float* lam_k1; const float* lam_q2; const float* lam_k2;
    const float* att_g; const float* lstm_g; const float* w_out; const float* ln1_g; const float* ln1_b; const float* w_gu; const float* conv_w; const float* conv_b;
    const float* w_down; const float* ln2_g; const float* ln2_b; float* out; unsigned char* ws; int ph_lo, ph_hi;
};
constexpr int NPHASE = 27;

__device__ __forceinline__ void transpose_item(const float* W, int K, int N, bf16_t* WT, int gu_map, const float* g, const float* b, float* c1, float* c2, LAS float* scr, int item, int lane) {
    const int nblk = (N + 31) / 32, kb = item / nblk, nb = item % nblk, k0 = 64 * kb, n0 = 32 * nb;
    const int ncol = n0 + (lane & 31); const bool okc = ncol < N;
    float a1 = 0.f, a2 = 0.f;
#pragma unroll 8
    for (int i = 0; i < 32; ++i) { const int kk = 2 * i + (lane >> 5); float w = okc ? W[(size_t)(k0 + kk) * N + ncol] : 0.f;
        if (g) { a2 += w * b[k0 + kk]; w *= g[k0 + kk]; a1 += bf2f(f2bf(w)); }
        scr[kk * 33 + (lane & 31)] = w; }
    asm volatile("s_waitcnt lgkmcnt(0)" ::: "memory");
    if (g) { a1 += __shfl_xor(a1, 32); a2 += __shfl_xor(a2, 32); }
    const int c = lane & 7;
#pragma unroll
    for (int j = 0; j < 4; ++j) { const int nl = (lane >> 3) + 8 * j; const int n = n0 + nl; const LAS float* s = scr + (8 * c) * 33 + nl;
        u32x4 o; o.x = cvt_pk_bf16(s[0 * 33], s[1 * 33]); o.y = cvt_pk_bf16(s[2 * 33], s[3 * 33]); o.z = cvt_pk_bf16(s[4 * 33], s[5 * 33]); o.w = cvt_pk_bf16(s[6 * 33], s[7 * 33]);
        if (n < N) { int rowm = n; if (gu_map) { const int n2 = n < DFF ? n : n - DFF; rowm = 256 * (n2 >> 7) + (n < DFF ? 0 : 128) + (n2 & 127); }
            *(u32x4*)(WT + (size_t)rowm * K + k0 + 8 * c) = o; } }
    if (g && lane < 32 && okc) { int rowm = ncol; if (gu_map) { const int n2 = ncol < DFF ? ncol : ncol - DFF; rowm = 256 * (n2 >> 7) + (ncol < DFF ? 0 : 128) + (n2 & 127); }
        atomicAdd(c1 + rowm, a1); atomicAdd(c2 + rowm, a2); }
    asm volatile("s_waitcnt lgkmcnt(0)" ::: "memory");
}

__device__ __forceinline__ void cvt_rows(const float* x, bf16_t* xb, int gtid, int nthr) {
    for (size_t i = gtid; i < (size_t)MT * DM / 8; i += nthr) {
        const f32x4 a = *(const f32x4*)(x + i * 8), b = *(const f32x4*)(x + i * 8 + 4);
        u32x4 w; w.x = cvt_pk_bf16(a[0], a[1]); w.y = cvt_pk_bf16(a[2], a[3]); w.z = cvt_pk_bf16(b[0], b[1]); w.w = cvt_pk_bf16(b[2], b[3]);
        *(u32x4*)(xb + i * 8) = w; }
}

__global__ void __launch_bounds__(512, 2) fwd(Args args) {
    extern __shared__ __attribute__((aligned(16))) unsigned char lds_raw[];
    LAS unsigned char* lds = (LAS unsigned char*)lds_raw;
    for (int ph = args.ph_lo; ph < args.ph_hi; ++ph) {
        if (ph > args.ph_lo) cg::this_grid().sync();
        const int tid = opaque_tid(), lane = tid & 63, wave = __builtin_amdgcn_readfirstlane(tid >> 6);
        const int G = gridDim.x, gtid = blockIdx.x * 512 + tid, nthr = G * 512;
        unsigned char* ws = args.ws; asm volatile("" : "+s"(ws));
        bf16_t* XB = (bf16_t*)(ws + WS_XB); bf16_t* MIXED = (bf16_t*)(ws + WS_MIXED); bf16_t* PROJ = (bf16_t*)(ws + WS_PROJ); bf16_t* HMID = PROJ;
        float* GATES = (float*)(ws + WS_GATES); float* EDGE = (float*)(ws + WS_EDGE);
        f32x2* ST1 = (f32x2*)(ws + WS_ST1); f32x2* ST2 = (f32x2*)(ws + WS_ST2);
        float* LAMV = (float*)(ws + WS_LAM);
        float* C1IN = (float*)(ws + CTL_C1IN); float* C2IN = (float*)(ws + CTL_C2IN); float* C1GU = (float*)(ws + CTL_C1GU); float* C2GU = (float*)(ws + CTL_C2GU);
        unsigned* QCNT = (unsigned*)(ws + WS_CTL);
        if ((PHMASK & 1) && ph == 0) {
            LAS float* scr = (LAS float*)(lds + wave * 8448);
            const int gw = blockIdx.x * 8 + wave, NGW = G * 8;
            constexpr int I_IN = 16 * 97, I_OUT = 16 * 32, I_GU = 16 * 176, I_DN = 44 * 32, I_L = I_IN + I_OUT + I_GU + I_DN;
            for (int it = gw; it < 2 * I_L; it += NGW) {
                const int l = it / I_L; int r = it % I_L;
                if (r < I_IN) { transpose_item(args.w_in + (size_t)l * DM * NIN, DM, NIN, (bf16_t*)(ws + WS_WIN) + (size_t)l * NPROJ_PAD * DM, 0,
                                               l ? args.ln2_g : nullptr, l ? args.ln2_b : nullptr, C1IN, C2IN, scr, r, lane); continue; } r -= I_IN;
                if (r < I_OUT) { transpose_item(args.w_out + (size_t)l * DM * DM, DM, DM, (bf16_t*)(ws + WS_WOUT) + (size_t)l * DM * DM, 0, nullptr, nullptr, nullptr, nullptr, scr, r, lane); continue; } r -= I_OUT;
                if (r < I_GU) { transpose_item(args.w_gu + (size_t)l * DM * NGU, DM, NGU, (bf16_t*)(ws + WS_WGU) + (size_t)l * NGU * DM, 1,
                                               args.ln1_g + l * DM, args.ln1_b + l * DM, C1GU + l * NGU, C2GU + l * NGU, scr, r, lane); continue; } r -= I_GU;
                transpose_item(args.w_down + (size_t)l * DFF * DM, DFF, DM, (bf16_t*)(ws + WS_WDN) + (size_t)l * DM * DFF, 0, nullptr, nullptr, nullptr, nullptr, scr, r, lane);
            }
            for (int i = gtid; i < 2 * (NPROJ_PAD - NIN) * DM / 8; i += nthr) { const int l = i / ((NPROJ_PAD - NIN) * DM / 8), o = i % ((NPROJ_PAD - NIN) * DM / 8);
                *(u32x4*)((bf16_t*)(ws + WS_WIN) + (size_t)l * NPROJ_PAD * DM + (size_t)NIN * DM + (size_t)o * 8) = (u32x4){0u, 0u, 0u, 0u}; }
            if (blockIdx.x == 0 && wave == 0) {
                for (int l = 0; l < 2; ++l) {
                    float s1 = args.lam_q1[l * 64 + lane] * args.lam_k1[l * 64 + lane], s2 = args.lam_q2[l * 64 + lane] * args.lam_k2[l * 64 + lane];
#pragma unroll
                    for (int o = 1; o < 64; o <<= 1) { s1 += __shfl_xor(s1, o); s2 += __shfl_xor(s2, o); }
                    const float lam_init = 0.8f - 0.6f * expf(-0.3f * (float)l);
                    if (lane == 0) LAMV[l] = expf(s1) - expf(s2) + lam_init;
                }
            }
            cvt_rows(args.xin[0], XB, gtid, nthr);
            continue;
        }
        const int trunk = (ph - 1) / 13, pp = (ph - 1) % 13;
        const int seq = trunk ? 2048 : 4096, nseq = trunk ? 32 : 16;
        float* V = args.out + (size_t)trunk * MT * DM;
        if ((PHMASK & 256) && pp == 12) {
            const float* g = args.ln2_g + DM; const float* b = args.ln2_b + DM;
            for (size_t i = gtid; i < (size_t)MT * DM / 4; i += nthr) { const int row = (int)(i >> 8), col = (int)(i & 255) * 4;
                float mu, rstd; row_stats(ST2, row, mu, rstd);
                const f32x4 x = *(const f32x4*)(V + i * 4), gv = *(const f32x4*)(g + col), bv = *(const f32x4*)(b + col);
                *(f32x4*)(V + i * 4) = (x - mu) * rstd * gv + bv; }
            if (trunk == 0) cvt_rows(args.xin[1], XB, gtid, nthr);
            continue;
        }
        const int l = pp / 6, sp = pp % 6;
        if ((PHMASK & 2) && sp == 0) {
            pg8::Gemm g{XB, (const bf16_t*)(ws + WS_WIN) + (size_t)l * NPROJ_PAD * DM, MT, NPROJ_PAD, DM};
            pg8::StaticOrder S; S.init(MT, NPROJ_PAD, G, (int)blockIdx.x);
            EpiProj E{PROJ, GATES, args.gate_bias + l * 16, l ? ST2 : nullptr, C1IN, C2IN, (LAS f32x2*)(lds + EPI_LDS + 8192)};
            pg8::gemm_phase<EpiProj, pg8::StaticOrder>(lds, g, S, E);
        } else if ((PHMASK & 12) && sp == 1) {
            unsigned* qc = QCNT + (size_t)((trunk * 2 + l) * 8) * 64;
            const int myx = (int)(__builtin_amdgcn_s_getreg((3 << 11) | 20) & 7);
            const int npair = nseq / 2, nqb = seq / 128, nitems = npair * (1 + nqb);
            const float lam = LAMV[l]; const float lam_init = 0.8f - 0.6f * expf(-0.3f * (float)l);
            LAS int* sitem = (LAS int*)(lds + LDS_BYTES - 64);
            for (int qq = 0; qq < 8; ++qq) {
                const int x = (myx + qq) & 7;
                for (;;) {
                    if (tid == 0) sitem[0] = (int)atomicAdd(qc + 64 * x, 1u);
                    __syncthreads();
                    const int item = sitem[0];
                    __syncthreads();
                    if (item >= nitems) break;
                    if ((PHMASK & 4) && item < npair) {
                        const int p = x + 8 * item, b = p >> 2, h = p & 3;
                        ml::mlstm_item(PROJ, GATES, MIXED, args.lstm_g + l * 512, seq, (long)b * seq, h, lds);
                    } else if (PHMASK & 8) {
                        const int a = item - npair, pi = a / nqb, qb = a % nqb, p = x + 8 * pi, b = p >> 2, h = p & 3;
                        const float slope = exp2f(-2.0f * (float)(h + 1));
                        att::attn_unit(PROJ, MIXED, args.att_g + l * 512, seq, (long)b * seq, h, qb, lam, -slope, 1.0f - lam_init, (LAS char*)lds);
                    }
                }
            }
        } else if ((PHMASK & 16) && sp == 2) {
            pg8::Gemm g{MIXED, (const bf16_t*)(ws + WS_WOUT) + (size_t)l * DM * DM, MT, DM, DM};
            pg8::StaticOrder S; S.init(MT, DM, G, (int)blockIdx.x);
            EpiRes E{l ? nullptr : args.xin[trunk], V, ST2, args.ln2_g, args.ln2_b, ST1, XB, (LAS f32x2*)(lds + EPI_LDS), (LAS f32x2*)(lds + EPI_LDS + 8192)};
            pg8::gemm_phase<EpiRes, pg8::StaticOrder>(lds, g, S, E);
        } else if ((PHMASK & 32) && sp == 3) {
            pg8::Gemm g{XB, (const bf16_t*)(ws + WS_WGU) + (size_t)l * NGU * DM, MT, NGU, DM};
            pg8::StaticOrder S; S.init(MT, NGU, G, (int)blockIdx.x);
            EpiGU E{HMID, EDGE, ST1, C1GU + l * NGU, C2GU + l * NGU, args.conv_w + (size_t)l * 3 * DFF, args.conv_b + (size_t)l * DFF, (LAS float*)(lds + EPI_LDS), (LAS f32x2*)(lds + EPI_LDS + 8192)};
            pg8::gemm_phase<EpiGU, pg8::StaticOrder>(lds, g, S, E);
        } else if ((PHMASK & 64) && sp == 4) {
            const float* cw = args.conv_w + (size_t)l * 3 * DFF; const float* cb = args.conv_b + (size_t)l * DFF; const int st = seq / 256;
            for (int i = gtid; i < 256 * 2 * (DFF / 4); i += nthr) {
                const int grp = i % (DFF / 4), e2 = (i / (DFF / 4)) & 1, pm = i / (2 * (DFF / 4)), j = grp * 4;
                const float* Ep = EDGE + (size_t)pm * 6 * DFF + j;
                const f32x4 w0 = *(const f32x4*)(cw + j), w1 = *(const f32x4*)(cw + DFF + j), w2 = *(const f32x4*)(cw + 2 * DFF + j), cbv = *(const f32x4*)(cb + j);
                f32x4 ga, gb, gc, up; const f32x4 z = (f32x4){0.f, 0.f, 0.f, 0.f}; int row;
                if (e2 == 0) { ga = (pm % st == 0) ? z : *(const f32x4*)(Ep - 6 * DFF + 3 * DFF); gb = *(const f32x4*)(Ep); gc = *(const f32x4*)(Ep + DFF); up = *(const f32x4*)(Ep + 4 * DFF); row = pm * 256; }
                else { ga = *(const f32x4*)(Ep + 2 * DFF); gb = *(const f32x4*)(Ep + 3 * DFF); gc = (pm % st == st - 1) ? z : *(const f32x4*)(Ep + 6 * DFF); up = *(const f32x4*)(Ep + 5 * DFF); row = pm * 256 + 255; }
                const f32x4 cv = cbv + w0 * ga + w1 * gb + w2 * gc;
                u32x2 w; w.x = cvt_pk_bf16(gelu_erf(cv[0]) * up[0], gelu_erf(cv[1]) * up[1]); w.y = cvt_pk_bf16(gelu_erf(cv[2]) * up[2], gelu_erf(cv[3]) * up[3]);
                *(u32x2*)(HMID + (size_t)row * DFF + j) = w; }
        } else if (PHMASK & 128) {
            pg8::Gemm g{HMID, (const bf16_t*)(ws + WS_WDN) + (size_t)l * DM * DFF, MT, DM, DFF};
            pg8::StaticOrder S; S.init(MT, DM, G, (int)blockIdx.x);
            EpiRes E{nullptr, V, ST1, args.ln1_g + l * DM, args.ln1_b + l * DM, ST2, l == 0 ? XB : nullptr, (LAS f32x2*)(lds + EPI_LDS), (LAS f32x2*)(lds + EPI_LDS + 8192)};
            pg8::gemm_phase<EpiRes, pg8::StaticOrder>(lds, g, S, E);
        }
    }
}

extern "C" void kernel_launch(void* const* d_in, const int* in_sizes, int n_in, void* d_out, int out_size, void* d_ws, size_t ws_size, hipStream_t stream) {
    static int grid = 0;
    if (grid == 0) {
        if (n_in != 19 || ws_size < WS_END) { fprintf(stderr, "kernel_launch: unexpected n_in %d / ws %zu\n", n_in, ws_size); grid = -1; return; }
        int dev = 0, cus = 0, per_cu = 0;
        hipGetDevice(&dev); hipDeviceGetAttribute(&cus, hipDeviceAttributeMultiprocessorCount, dev);
        if (hipFuncSetAttribute((const void*)fwd, hipFuncAttributeMaxDynamicSharedMemorySize, LDS_BYTES) != hipSuccess) { fprintf(stderr, "kernel_launch: hipFuncSetAttribute failed\n"); grid = -1; return; }
        hipOccupancyMaxActiveBlocksPerMultiprocessor(&per_cu, (const void*)fwd, 512, LDS_BYTES);
        (void)hipGetLastError();
        if (per_cu < 1) per_cu = 1;
        grid = cus;
    }
    if (grid < 0) return;
    hipMemsetAsync((char*)d_ws + WS_CTL, 0, CTL_BYTES, stream);
    Args a{};
    a.xin[0] = (const float*)d_in[0]; a.xin[1] = (const float*)d_in[1]; a.w_in = (const float*)d_in[2]; a.gate_bias = (const float*)d_in[3];
    a.lam_q1 = (const float*)d_in[4]; a.lam_k1 = (const float*)d_in[5]; a.lam_q2 = (const float*)d_in[6]; a.lam_k2 = (const float*)d_in[7];
    a.att_g = (const float*)d_in[8]; a.lstm_g = (const float*)d_in[9]; a.w_out = (const float*)d_in[10]; a.ln1_g = (const float*)d_in[11]; a.ln1_b = (const float*)d_in[12];
    a.w_gu = (const float*)d_in[13]; a.conv_w = (const float*)d_in[14]; a.conv_b = (const float*)d_in[15]; a.w_down = (const float*)d_in[16]; a.ln2_g = (const float*)d_in[17]; a.ln2_b = (const float*)d_in[18];
    a.out = (float*)d_out; a.ws = (unsigned char*)d_ws;
#if MK_MULTI
    for (int ph = 0; ph < NPHASE; ++ph) { a.ph_lo = ph; a.ph_hi = ph + 1; hipLaunchKernelGGL(fwd, dim3(grid), dim3(512), LDS_BYTES, stream, a); }
#else
    a.ph_lo = 0; a.ph_hi = NPHASE;
    void* kargs[] = {&a};
    hipError_t e = hipLaunchCooperativeKernel((const void*)fwd, dim3(grid), dim3(512), kargs, LDS_BYTES, stream);
    if (e != hipSuccess) fprintf(stderr, "kernel_launch: cooperative launch failed: %s (grid %d)\n", hipGetErrorString(e), grid);
#endif
}
```

```cpp
#include <hip/hip_runtime.h>
#include <hip/hip_cooperative_groups.h>
#include <cstdio>
#include <cstdint>
namespace cg = cooperative_groups;

#ifndef PHMASK
#define PHMASK 0xffff
#endif
#ifndef MK_MULTI
#define MK_MULTI 0
#endif

#define LAS __attribute__((address_space(3)))
typedef unsigned short bf16_t;
typedef short bf16x8 __attribute__((ext_vector_type(8)));
typedef short s16x4 __attribute__((ext_vector_type(4)));
typedef float f32x2 __attribute__((ext_vector_type(2)));
typedef float f32x4 __attribute__((ext_vector_type(4)));
typedef float f32x8 __attribute__((ext_vector_type(8)));
typedef float f32x16 __attribute__((ext_vector_type(16)));
typedef unsigned u32x2 __attribute__((ext_vector_type(2)));
typedef unsigned u32x4 __attribute__((ext_vector_type(4)));

constexpr int DM = 1024, NPROJ = 3072, NPROJ_PAD = 3328, NIN = 3088, DFF = 2816, NGU = 5632;
constexpr int MT = 65536;
constexpr float ALPHA = 1.4142135623730951f, EPS = 1e-5f;
constexpr int LDS_BYTES = 147456;
constexpr int EPI_LDS = 131072;

constexpr size_t MiB = 1u << 20;
constexpr size_t WS_CTL = 0, CTL_BYTES = 1 * MiB;
constexpr size_t CTL_KMAX = 32768;
constexpr size_t CTL_C1IN = 65536, CTL_C2IN = 81920, CTL_C1GU = 98304, CTL_C2GU = 147456;
constexpr size_t WS_LAM = 1 * MiB;
constexpr size_t WS_WIN = 2 * MiB, WS_WOUT = 15 * MiB, WS_WGU = 19 * MiB, WS_WDN = 41 * MiB;
constexpr size_t WS_ST1 = 52 * MiB, WS_ST2 = 54 * MiB, WS_GATES = 56 * MiB, WS_EDGE = 60 * MiB;
constexpr size_t WS_XB = 80 * MiB, WS_MIXED = 208 * MiB, WS_PROJ = 336 * MiB, WS_END = 720 * MiB;

__device__ __forceinline__ unsigned cvt_pk_bf16(float lo, float hi) { unsigned r; asm volatile("v_cvt_pk_bf16_f32 %0, %1, %2" : "=v"(r) : "v"(lo), "v"(hi)); return r; }
__device__ __forceinline__ float bf2f(bf16_t b) { return __uint_as_float(((unsigned)b) << 16); }
__device__ __forceinline__ bf16_t f2bf(float f) { return (bf16_t)(cvt_pk_bf16(f, 0.f) & 0xffffu); }
__device__ __forceinline__ float gelu_erf(float v) {
    const float av = fabsf(v), t = __builtin_amdgcn_rcpf(av * 0.2316418882f + 1.0f);
    float q = t * 0.5307027145f + (-0.7265760135f); q = q * t + 0.7107068705f; q = q * t + (-0.142248368f); q = q * t + 0.127414796f; q = q * t;
    const float e = __builtin_amdgcn_exp2f((v * v) * (-0.72134752044f));
    const float m = v * (q * e);
    return v < 0.f ? m : v - m;
}
__device__ __forceinline__ int crow(int r, int hi) { return (r & 3) + 8 * (r >> 2) + 4 * hi; }
#define EPI_BAR() do { asm volatile("s_waitcnt lgkmcnt(0)" ::: "memory"); __builtin_amdgcn_s_barrier(); asm volatile("" ::: "memory"); } while (0)
#define SBAR() __builtin_amdgcn_sched_barrier(0)
__device__ __forceinline__ int opaque_tid() { int t = threadIdx.x; asm volatile("" : "+v"(t)); return t; }

namespace pg8 {
constexpr int BM = 256, BK = 64, HALF = 128, HTB = HALF * BK * 2, STAGE_BYTES = 8 * HTB, NXCD = 8, WGM = 8;
__host__ __device__ __forceinline__ int lds_byte(int r, int c) { const int st = (r >> 4) * 2 + (c >> 5), rr = r & 15, cc = c & 31, ob = rr * 64 + cc * 2; return st * 1024 + (ob ^ (((ob >> 9) & 1) << 5)); }
__host__ __device__ __forceinline__ void stage_rc(int b, int& R, int& C) { const int st = b / 1024, sb = b % 1024, swz = sb ^ (((sb >> 9) & 1) << 5); R = (st >> 1) * 16 + swz / 64; C = (st & 1) * 32 + (swz % 64) / 2; }
__host__ __device__ __forceinline__ int perm32(int rho) { const int n = rho >> 4, i = rho & 15; return 8 * (i >> 2) + 4 * n + (i & 3); }
struct Unit { int pm, pn; };
struct Gemm { const bf16_t* A; const bf16_t* Bt; int M, N, K; };
struct StaticOrder {
    int nM, nN, nwg, G, c;
    __host__ __device__ void init(int M, int N, int G_, int c_) { nM = M / BM; nN = N / BM; nwg = nM * nN; G = G_; c = c_; }
    __host__ __device__ bool next(int i, Unit& u) const {
        const long L = (long)i * G + c; if (L >= nwg) return false;
        int wgid = (int)L; { const int q = nwg / NXCD, r = nwg % NXCD, xcd = wgid % NXCD, off = wgid / NXCD; wgid = (xcd < r ? xcd * (q + 1) : r * (q + 1) + (xcd - r) * q) + off; }
        const int nig = WGM * nN, gid = wgid / nig, fm = gid * WGM, gsz = (nM - fm) < WGM ? (nM - fm) : WGM;
        u.pm = fm + ((wgid % nig) % gsz); u.pn = (wgid % nig) / gsz; return true;
    }
    __device__ __forceinline__ void a_ready(const Unit&) const {}
    __device__ __forceinline__ void done(const Unit&) const {}
};

template <class Epi, class Sched>
__device__ __forceinline__ void gemm_phase(LAS unsigned char* lds, const Gemm g, const Sched& S, const Epi& E) {
    const int tid = opaque_tid(), wid = __builtin_amdgcn_readfirstlane(tid >> 6), lane = tid & 63, wr = wid >> 2, wc = wid & 3, fr = lane & 15, fq = lane >> 4;
    const int K = g.K, nt = K / BK;
    unsigned voffA[2], voffB[2];
#pragma unroll
    for (int i = 0; i < 2; ++i) { int R, C; stage_rc(tid * 16 + i * 8192, R, C); const int Rb = Epi::PERM ? ((R & ~31) + perm32(R & 31)) : R;
        voffA[i] = (unsigned)(R * K + C) * 2u; voffB[i] = (unsigned)(Rb * K + C) * 2u; }
    const size_t kstep = (size_t)(BK * 2);
    const size_t hstep = (size_t)HALF * K * 2;
    const size_t tstep = 2 * hstep;
    const unsigned ldsw = (unsigned)wid * 1024u;
    const int aoff = lds_byte(wr * 64 + fr, fq * 8), boff = lds_byte(wc * 32 + fr, fq * 8);
#define PG8_SA(b, h) (((b) * 2 + (h)) * HTB)
#define PG8_SB(b, h) ((4 + (b) * 2 + (h)) * HTB)
#define PG8_STAGE(bufoff, gbase, voff) do { _Pragma("unroll") for (int _i = 0; _i < 2; ++_i) \
        __builtin_amdgcn_global_load_lds((const unsigned*)((const char*)(gbase) + (voff)[_i]), (LAS unsigned*)(lds + (bufoff) + ldsw + _i * 8192), 16, 0, 0); } while (0)
#define PG8_LDA(dst, b, h) do { _Pragma("unroll") for (int m = 0; m < 4; ++m) _Pragma("unroll") for (int k = 0; k < 2; ++k) dst[m][k] = *(const LAS bf16x8*)(lds + PG8_SA(b, h) + aoff + m * 2048 + k * 1024); } while (0)
#define PG8_LDB(dst, b, h) do { _Pragma("unroll") for (int n = 0; n < 2; ++n) _Pragma("unroll") for (int k = 0; k < 2; ++k) dst[n][k] = *(const LAS bf16x8*)(lds + PG8_SB(b, h) + boff + n * 2048 + k * 1024); } while (0)
#define PG8_MMA(ai, bj, At, Bt) do { __builtin_amdgcn_s_setprio(1); _Pragma("unroll") for (int m = 0; m < 4; ++m) _Pragma("unroll") for (int n = 0; n < 2; ++n) _Pragma("unroll") for (int k = 0; k < 2; ++k) \
        acc[ai][bj][m][n] = __builtin_amdgcn_mfma_f32_16x16x32_bf16(Bt[n][k], At[m][k], acc[ai][bj][m][n], 0, 0, 0); __builtin_amdgcn_s_setprio(0); } while (0)
#define PG8_WAIT_V(n) asm volatile("s_waitcnt vmcnt(" #n ")" ::: "memory")
#define PG8_WAIT_L(n) asm volatile("s_waitcnt lgkmcnt(" #n ")" ::: "memory")
#define PG8_BAR __builtin_amdgcn_s_barrier()
#define PG8_SCHED __builtin_amdgcn_sched_barrier(0)
    Unit cur, nxt; int ui = 0;
    if (!S.next(0, cur)) return;
    f32x4 acc[2][2][4][2];
#pragma unroll
    for (int a = 0; a < 2; ++a)
#pragma unroll
        for (int b = 0; b < 2; ++b)
#pragma unroll
            for (int m = 0; m < 4; ++m)
#pragma unroll
                for (int n = 0; n < 2; ++n) acc[a][b][m][n] = (f32x4){0.f, 0.f, 0.f, 0.f};
    bf16x8 At[4][2], B0[2][2], B1[2][2];
    const char* cA = (const char*)g.A + (size_t)cur.pm * tstep; const char* cB = (const char*)g.Bt + (size_t)cur.pn * tstep;
    PG8_STAGE(PG8_SB(0, 0), cB, voffB); PG8_STAGE(PG8_SB(0, 1), cB + hstep, voffB); PG8_STAGE(PG8_SA(0, 0), cA, voffA); PG8_STAGE(PG8_SA(0, 1), cA + hstep, voffA);
    if (wr == 1) PG8_BAR;
    PG8_WAIT_V(2); PG8_BAR;
    PG8_STAGE(PG8_SB(1, 0), cB + kstep, voffB); PG8_STAGE(PG8_SA(1, 0), cA + kstep, voffA); PG8_STAGE(PG8_SB(1, 1), cB + hstep + kstep, voffB);
    PG8_WAIT_V(6); PG8_BAR;
    for (;;) {
        const bool has_next = S.next(ui + 1, nxt);
        const char* nA = has_next ? (const char*)g.A + (size_t)nxt.pm * tstep : cA; const char* nB = has_next ? (const char*)g.Bt + (size_t)nxt.pn * tstep : cB;
        for (int t = 0; t < nt; t += 2) {
            const bool last = (t == nt - 2);
            const char* a1 = cA + (size_t)(t + 1) * kstep;
            const char* a2 = last ? nA : cA + (size_t)(t + 2) * kstep; const char* b2 = last ? nB : cB + (size_t)(t + 2) * kstep;
            const char* a3 = a2 + kstep; const char* b3 = b2 + kstep;
            PG8_LDB(B0, 0, 0); PG8_LDB(B1, 0, 1); PG8_SCHED; PG8_LDA(At, 0, 0); PG8_STAGE(PG8_SA(1, 1), a1 + hstep, voffA);
            PG8_WAIT_V(8); PG8_WAIT_L(0); PG8_BAR; PG8_MMA(0, 0, At, B0); PG8_MMA(0, 1, At, B1); PG8_BAR; PG8_SCHED;
            PG8_LDA(At, 0, 1); PG8_STAGE(PG8_SB(0, 0), b2, voffB); PG8_STAGE(PG8_SB(0, 1), b2 + hstep, voffB); PG8_STAGE(PG8_SA(0, 0), a2, voffA);
            PG8_WAIT_V(8); PG8_WAIT_L(0); PG8_BAR; PG8_MMA(1, 0, At, B0); PG8_MMA(1, 1, At, B1); PG8_BAR; PG8_SCHED;
            PG8_LDB(B0, 1, 0); PG8_LDB(B1, 1, 1); PG8_SCHED; PG8_LDA(At, 1, 0); PG8_STAGE(PG8_SA(0, 1), a2 + hstep, voffA);
            PG8_WAIT_V(8); PG8_WAIT_L(0); PG8_BAR; PG8_MMA(0, 0, At, B0); PG8_MMA(0, 1, At, B1); PG8_BAR; PG8_SCHED;
            PG8_LDA(At, 1, 1); PG8_STAGE(PG8_SB(1, 0), b3, voffB); PG8_STAGE(PG8_SB(1, 1), b3 + hstep, voffB); PG8_STAGE(PG8_SA(1, 0), a3, voffA);
            PG8_WAIT_V(8); PG8_WAIT_L(0); PG8_BAR; PG8_MMA(1, 0, At, B0); PG8_MMA(1, 1, At, B1); PG8_BAR; PG8_SCHED;
        }
        if (wr == 0) PG8_BAR;
        E(acc, cur, wr, wc, fr, fq);
        if (!has_next) break;
#pragma unroll
        for (int a = 0; a < 2; ++a)
#pragma unroll
            for (int b = 0; b < 2; ++b)
#pragma unroll
                for (int m = 0; m < 4; ++m)
#pragma unroll
                    for (int n = 0; n < 2; ++n) acc[a][b][m][n] = (f32x4){0.f, 0.f, 0.f, 0.f};
        cur = nxt; cA = nA; cB = nB; ++ui;
        if (wr == 1) PG8_BAR;
    }
    PG8_WAIT_V(0);
    PG8_BAR;
#undef PG8_SA
#undef PG8_SB
#undef PG8_STAGE
#undef PG8_LDA
#undef PG8_LDB
#undef PG8_MMA
#undef PG8_WAIT_V
#undef PG8_WAIT_L
#undef PG8_BAR
#undef PG8_SCHED
}
}

__device__ __forceinline__ void row_stats(const f32x2* st, int row, float& mu, float& rstd) {
    const f32x4 a = *(const f32x4*)(st + (size_t)row * 4), b = *(const f32x4*)(st + (size_t)row * 4 + 2);
    const float s = (a[0] + a[2]) + (b[0] + b[2]), q = (a[1] + a[3]) + (b[1] + b[3]);
    mu = s * (1.f / 1024.f); const float var = fmaxf(q * (1.f / 1024.f) - mu * mu, 0.f); rstd = rsqrtf(var + EPS);
}

__device__ __forceinline__ void tile_stats_to_lds(const f32x2* st, int row0, LAS f32x2* S, int tid) {
    if (tid < 256) { float mu, rstd; row_stats(st, row0 + tid, mu, rstd); S[tid] = (f32x2){mu, rstd}; }
    EPI_BAR();
}
struct EpiProj {
    static constexpr bool PERM = true;
    bf16_t* O; float* gates; const float* gate_bias; const f32x2* stats; const float* c1; const float* c2; LAS f32x2* S;
    __device__ __forceinline__ void operator()(f32x4 (&acc)[2][2][4][2], const pg8::Unit& u, int wr, int wc, int fr, int fq) const {
        asm volatile("" : "+v"(fr), "+v"(fq));
        const int colt = u.pn * 256 + wc * 32 + 8 * fq;
        if (stats) tile_stats_to_lds(stats, u.pm * 256, S, (wr * 4 + wc) * 64 + fq * 16 + fr);
        f32x4 c1v[2][2], c2v[2][2];
#pragma unroll
        for (int bj = 0; bj < 2; ++bj)
#pragma unroll
            for (int n = 0; n < 2; ++n) {
                if (stats) { c1v[bj][n] = *(const f32x4*)(c1 + colt + bj * 128 + 4 * n); c2v[bj][n] = *(const f32x4*)(c2 + colt + bj * 128 + 4 * n); }
                else { c1v[bj][n] = (f32x4){0.f, 0.f, 0.f, 0.f}; c2v[bj][n] = (f32x4){0.f, 0.f, 0.f, 0.f}; } }
        const float sc = (u.pn < 2 || u.pn == 7) ? 0.125f : 1.0f;
#pragma unroll
        for (int ai = 0; ai < 2; ++ai)
#pragma unroll
            for (int m = 0; m < 4; ++m) {
                const int row = u.pm * 256 + ai * 128 + wr * 64 + m * 16 + fr;
                float mu = 0.f, rstd = 1.f; if (stats) { const f32x2 sr = S[ai * 128 + wr * 64 + m * 16 + fr]; mu = sr.x; rstd = sr.y; }
                if (u.pn < 12) {
#pragma unroll
                    for (int bj = 0; bj < 2; ++bj) {
                        const f32x4 v0 = ((acc[ai][bj][m][0] - mu * c1v[bj][0]) * rstd + c2v[bj][0]) * sc, v1 = ((acc[ai][bj][m][1] - mu * c1v[bj][1]) * rstd + c2v[bj][1]) * sc;
                        u32x4 w; w.x = cvt_pk_bf16(v0[0], v0[1]); w.y = cvt_pk_bf16(v0[2], v0[3]); w.z = cvt_pk_bf16(v1[0], v1[1]); w.w = cvt_pk_bf16(v1[2], v1[3]);
                        *(u32x4*)(O + (size_t)row * NPROJ + colt + bj * 128) = w; }
                } else if (wc == 0 && fq < 2) {
#pragma unroll
                    for (int n = 0; n < 2; ++n) {
                        const f32x4 gb = *(const f32x4*)(gate_bias + 8 * fq + 4 * n);
                        *(f32x4*)(gates + (size_t)row * 16 + 8 * fq + 4 * n) = (acc[ai][0][m][n] - mu * c1v[0][n]) * rstd + c2v[0][n] + gb; }
                }
            }
    }
};

struct EpiRes {
    static constexpr bool PERM = false;
    const float* xin; float* v; const f32x2* st_in; const float* g_in; const float* b_in; f32x2* st_out; bf16_t* xb; LAS f32x2* P; LAS f32x2* S;
    __device__ __forceinline__ void operator()(f32x4 (&acc)[2][2][4][2], const pg8::Unit& u, int wr, int wc, int fr, int fq) const {
        asm volatile("" : "+v"(fr), "+v"(fq));
        const int colb = u.pn * 256 + wc * 32 + 4 * fq;
        if (!xin) tile_stats_to_lds(st_in, u.pm * 256, S, (wr * 4 + wc) * 64 + fq * 16 + fr);
        f32x4 gv[2][2], bv[2][2];
#pragma unroll
        for (int bj = 0; bj < 2; ++bj)
#pragma unroll
            for (int n = 0; n < 2; ++n) {
                if (!xin) { gv[bj][n] = *(const f32x4*)(g_in + colb + bj * 128 + n * 16); bv[bj][n] = *(const f32x4*)(b_in + colb + bj * 128 + n * 16); }
                else { gv[bj][n] = (f32x4){1.f, 1.f, 1.f, 1.f}; bv[bj][n] = (f32x4){0.f, 0.f, 0.f, 0.f}; } }
#pragma unroll
        for (int ai = 0; ai < 2; ++ai)
#pragma unroll
            for (int m = 0; m < 4; ++m) {
                const int rl = ai * 128 + wr * 64 + m * 16 + fr; const int row = u.pm * 256 + rl;
                float mu = 0.f, rstd = 1.f; if (!xin) { const f32x2 sr = S[rl]; mu = sr.x; rstd = sr.y; }
                const float* src = xin ? xin : v;
                float s = 0.f, q = 0.f;
#pragma unroll
                for (int bj = 0; bj < 2; ++bj)
#pragma unroll
                    for (int n = 0; n < 2; ++n) {
                        const size_t off = (size_t)row * DM + colb + bj * 128 + n * 16;
                        const f32x4 xv = *(const f32x4*)(src + off);
                        const f32x4 xp = (xv - mu) * rstd * gv[bj][n] + bv[bj][n];
                        const f32x4 o = xp * ALPHA + acc[ai][bj][m][n];
                        *(f32x4*)(v + off) = o;
                        if (xb) { u32x2 w; w.x = cvt_pk_bf16(o[0], o[1]); w.y = cvt_pk_bf16(o[2], o[3]); *(u32x2*)(xb + off) = w; }
                        s += (o[0] + o[1]) + (o[2] + o[3]); q += (o[0] * o[0] + o[1] * o[1]) + (o[2] * o[2] + o[3] * o[3]);
                    }
                s += __shfl_xor(s, 16); s += __shfl_xor(s, 32); q += __shfl_xor(q, 16); q += __shfl_xor(q, 32);
                if (fq == 0) P[rl * 4 + wc] = (f32x2){s, q};
            }
        EPI_BAR();
        const int tid = (wr * 4 + wc) * 64 + fq * 16 + fr;
        if (tid < 256) {
            const f32x2 a = P[tid * 4 + 0], b = P[tid * 4 + 1], c = P[tid * 4 + 2], d = P[tid * 4 + 3];
            st_out[(size_t)(u.pm * 256 + tid) * 4 + u.pn] = (f32x2){(a.x + b.x) + (c.x + d.x), (a.y + b.y) + (c.y + d.y)};
        }
    }
};

struct EpiGU {
    static constexpr bool PERM = false;
    bf16_t* hmid; float* edge; const f32x2* stats; const float* c1; const float* c2; const float* cw; const float* cb; LAS float* halo; LAS f32x2* S;
    __device__ __forceinline__ void operator()(f32x4 (&acc)[2][2][4][2], const pg8::Unit& u, int wr, int wc, int fr, int fq) const {
        asm volatile("" : "+v"(fr), "+v"(fq));
        const int colb = wc * 32 + 4 * fq; const int lane = fq * 16 + fr;
        const int jch0 = u.pn * 128 + colb;
        tile_stats_to_lds(stats, u.pm * 256, S, (wr * 4 + wc) * 64 + lane);
        u32x2 gk[2][4][2], uk[2][4][2];
        {
            f32x4 c1v[2][2], c2v[2][2];
#pragma unroll
            for (int bj = 0; bj < 2; ++bj)
#pragma unroll
                for (int n = 0; n < 2; ++n) { c1v[bj][n] = *(const f32x4*)(c1 + u.pn * 256 + bj * 128 + colb + 16 * n); c2v[bj][n] = *(const f32x4*)(c2 + u.pn * 256 + bj * 128 + colb + 16 * n); }
#pragma unroll
            for (int ai = 0; ai < 2; ++ai)
#pragma unroll
                for (int m = 0; m < 4; ++m) {
                    const f32x2 sr = S[ai * 128 + wr * 64 + m * 16 + fr]; const float mu = sr.x, rstd = sr.y;
                    const int blk = ai * 2 + wr;
#pragma unroll
                    for (int n = 0; n < 2; ++n) {
                        const f32x4 gv = (acc[ai][0][m][n] - mu * c1v[0][n]) * rstd + c2v[0][n];
                        const f32x4 uv = (acc[ai][1][m][n] - mu * c1v[1][n]) * rstd + c2v[1][n];
                        gk[ai][m][n].x = cvt_pk_bf16(gv[0], gv[1]); gk[ai][m][n].y = cvt_pk_bf16(gv[2], gv[3]);
                        uk[ai][m][n].x = cvt_pk_bf16(uv[0], uv[1]); uk[ai][m][n].y = cvt_pk_bf16(uv[2], uv[3]);
                        if (m == 0) {
                            if (fr == 0) *(LAS u32x2*)(halo + (blk * 2 + 0) * 128 + (colb + 16 * n) / 2) = gk[ai][m][n];
                            if (ai == 0 && wr == 0 && fr <= 1) *(f32x4*)(edge + ((size_t)u.pm * 6 + fr) * DFF + jch0 + 16 * n) = gv;
                            if (ai == 0 && wr == 0 && fr == 0) *(f32x4*)(edge + ((size_t)u.pm * 6 + 4) * DFF + jch0 + 16 * n) = uv;
                        }
                        if (m == 3) {
                            if (fr == 15) *(LAS u32x2*)(halo + (blk * 2 + 1) * 128 + (colb + 16 * n) / 2) = gk[ai][m][n];
                            if (ai == 1 && wr == 1 && fr >= 14) *(f32x4*)(edge + ((size_t)u.pm * 6 + 2 + (fr - 14)) * DFF + jch0 + 16 * n) = gv;
                            if (ai == 1 && wr == 1 && fr == 15) *(f32x4*)(edge + ((size_t)u.pm * 6 + 5) * DFF + jch0 + 16 * n) = uv;
                        }
                    }
                    SBAR();
                }
        }
        EPI_BAR(); SBAR();
#define BLO(x) __uint_as_float((x) << 16)
#define BHI(x) __uint_as_float((x) & 0xffff0000u)
#pragma unroll
        for (int n = 0; n < 2; ++n) {
            const f32x4 w0 = *(const f32x4*)(cw + jch0 + 16 * n), w1 = *(const f32x4*)(cw + DFF + jch0 + 16 * n), w2 = *(const f32x4*)(cw + 2 * DFF + jch0 + 16 * n), cbv = *(const f32x4*)(cb + jch0 + 16 * n);
#pragma unroll
            for (int ai = 0; ai < 2; ++ai) {
                const int blk = ai * 2 + wr;
                u32x2 top = (u32x2){0u, 0u}, bot = (u32x2){0u, 0u};
                if (blk > 0) top = *(const LAS u32x2*)(halo + ((blk - 1) * 2 + 1) * 128 + (colb + 16 * n) / 2);
                if (blk < 3) bot = *(const LAS u32x2*)(halo + ((blk + 1) * 2 + 0) * 128 + (colb + 16 * n) / 2);
                u32x2 hk[4];
#pragma unroll
                for (int w = 0; w < 2; ++w) {
                    unsigned a_[4], b_[4], c_[4], d_[4];
#pragma unroll
                    for (int m = 0; m < 4; ++m) { const unsigned gv = gk[ai][m][n][w];
                        a_[m] = (unsigned)__shfl((int)gv, (lane - 1) & 63); b_[m] = (unsigned)__shfl((int)gv, (lane + 15) & 63);
                        c_[m] = (unsigned)__shfl((int)gv, (lane + 1) & 63); d_[m] = (unsigned)__shfl((int)gv, (lane - 15) & 63); }
#pragma unroll
                    for (int m = 0; m < 4; ++m) {
                        const unsigned prev = (fr > 0) ? a_[m] : (m > 0 ? b_[m > 0 ? m - 1 : 0] : top[w]);
                        const unsigned next = (fr < 15) ? c_[m] : (m < 3 ? d_[m < 3 ? m + 1 : 3] : bot[w]);
                        const unsigned cur = gk[ai][m][n][w], upw = uk[ai][m][n][w];
                        const float cv0 = cbv[2 * w] + w0[2 * w] * BLO(prev) + w1[2 * w] * BLO(cur) + w2[2 * w] * BLO(next);
                        const float cv1 = cbv[2 * w + 1] + w0[2 * w + 1] * BHI(prev) + w1[2 * w + 1] * BHI(cur) + w2[2 * w + 1] * BHI(next);
                        hk[m][w] = cvt_pk_bf16(gelu_erf(cv0) * BLO(upw), gelu_erf(cv1) * BHI(upw));
                    }
                    SBAR();
                }
#pragma unroll
                for (int m = 0; m < 4; ++m) {
                    const int rl = ai * 128 + wr * 64 + m * 16 + fr;
                    if (rl != 0 && rl != 255) *(u32x2*)(hmid + (size_t)(u.pm * 256 + rl) * DFF + jch0 + 16 * n) = hk[m];
                }
                SBAR();
            }
        }
#undef BLO
#undef BHI
    }
};

namespace att {
constexpr int KVBLK = 64, SHM_V = 16384, SHM_K = 16384, WS_OFF = 73728, OB_PITCH = 132;
constexpr float THR = 8.f;
#define KSWZ(row, colB) ((row) * 256 + ((colB) ^ (((row) & 7) << 4)))
__device__ __forceinline__ void alibi(f32x16& p0, f32x16& p1, float t0, float nslope) {
#pragma unroll
    for (int r = 0; r < 16; ++r) { const float kr = (float)((r & 3) + 8 * (r >> 2));
        p0[r] = fmaf(nslope, fabsf(t0 - kr), p0[r]); p1[r] = fmaf(nslope, fabsf(t0 - kr - 32.f), p1[r]); }
}
__device__ __forceinline__ void partialSM(f32x16& p0, f32x16& p1, float& m_reg, float& mn, float& alpha) {
    constexpr float C = 1.4426950408889634f;
    float pmax = p0[0];
#pragma unroll
    for (int r = 1; r < 16; ++r) pmax = fmaxf(pmax, p0[r]);
#pragma unroll
    for (int r = 0; r < 16; ++r) pmax = fmaxf(pmax, p1[r]);
    { auto rr = __builtin_amdgcn_permlane32_swap(__float_as_uint(pmax), __float_as_uint(pmax), false, false);
      pmax = fmaxf(__uint_as_float(rr[0]), __uint_as_float(rr[1])); }
    if (__builtin_expect(__all(pmax - m_reg <= THR), 1)) { mn = m_reg; alpha = 1.f; }
    else { mn = fmaxf(m_reg, pmax); alpha = __builtin_amdgcn_exp2f((m_reg - mn) * C); m_reg = mn; }
    const float mnC = -mn * C;
#pragma unroll
    for (int r = 0; r < 16; ++r) p0[r] = fmaf(p0[r], C, mnC);
#pragma unroll
    for (int r = 0; r < 16; ++r) p1[r] = fmaf(p1[r], C, mnC);
#pragma unroll
    for (int r = 0; r < 16; ++r) p0[r] = __builtin_amdgcn_exp2f(p0[r]);
}
__device__ __forceinline__ void finishSM(f32x16& p0, f32x16& p1, float alpha, float& l_reg, bf16x8& pa0, bf16x8& pa1, bf16x8& pa2, bf16x8& pa3) {
#pragma unroll
    for (int r = 0; r < 16; ++r) p1[r] = __builtin_amdgcn_exp2f(p1[r]);
    float ps = 0;
#pragma unroll
    for (int r = 0; r < 16; ++r) ps += p0[r];
#pragma unroll
    for (int r = 0; r < 16; ++r) ps += p1[r];
    { auto rr = __builtin_amdgcn_permlane32_swap(__float_as_uint(ps), __float_as_uint(ps), false, false);
      ps = __uint_as_float(rr[0]) + __uint_as_float(rr[1]); }
    l_reg = l_reg * alpha + ps;
#define PK4(P, BASE, OUT) do { unsigned a0 = cvt_pk_bf16(P[BASE + 0], P[BASE + 1]), a1 = cvt_pk_bf16(P[BASE + 2], P[BASE + 3]);   \
    unsigned b0 = cvt_pk_bf16(P[BASE + 4], P[BASE + 5]), b1 = cvt_pk_bf16(P[BASE + 6], P[BASE + 7]);                              \
    auto r0 = __builtin_amdgcn_permlane32_swap(a0, b0, false, false); auto r1 = __builtin_amdgcn_permlane32_swap(a1, b1, false, false); \
    u32x4 w = {r0[0], r1[0], r0[1], r1[1]}; OUT = *reinterpret_cast<bf16x8*>(&w); } while (0)
    PK4(p0, 0, pa0); PK4(p0, 8, pa1); PK4(p1, 0, pa2); PK4(p1, 8, pa3);
#undef PK4
}
__device__ __forceinline__ void qkt(f32x16& p0, f32x16& p1, const LAS char* Ks, const bf16x8* qr, int r32, int hi, int c) {
    p0 = f32x16{}; p1 = f32x16{};
#pragma unroll
    for (int d0 = 0; d0 < 4; ++d0) { const int cb = ((c * 4 + d0) * 16 + hi * 8) * 2;
        const bf16x8 b0 = *reinterpret_cast<const LAS bf16x8*>(Ks + KSWZ(r32, cb));
        const bf16x8 b1 = *reinterpret_cast<const LAS bf16x8*>(Ks + KSWZ(32 + r32, cb));
        p0 = __builtin_amdgcn_mfma_f32_32x32x16_bf16(b0, qr[d0], p0, 0, 0, 0);
        p1 = __builtin_amdgcn_mfma_f32_32x32x16_bf16(b1, qr[d0], p1, 0, 0, 0); }
}
__device__ __forceinline__ int v_st(int k, int c) { const int kk = (k & ~0xC) | ((k & 4) << 1) | ((k & 8) >> 1); return ((kk >> 3) * 4 + (c >> 5)) * 512 + ((kk & 7) * 32 + (c & 31)) * 2; }
__device__ __forceinline__ int v_rd_base(int lane) { return ((lane & 3) << 3) | (((lane >> 2) & 3) << 6) | (((lane >> 4) & 1) << 5) | (((lane >> 5) & 1) << 8); }
constexpr int v_rd_off(int d0, int ks, int half) { return d0 * 512 + ks * 4096 + half * 2048; }
template <int OFF> __device__ __forceinline__ s16x4 tr_read(int vb) {
    s16x4 r; asm volatile("ds_read_b64_tr_b16 %0, %1 offset:%2" : "=&v"(r) : "v"(vb), "i"(OFF) : "memory"); return r;
}
template <int D0> __device__ __forceinline__ void pv_one(f32x16& od, int vb, bf16x8 pa0, bf16x8 pa1, bf16x8 pa2, bf16x8 pa3) {
    const s16x4 l0 = tr_read<v_rd_off(D0, 0, 0)>(vb), h0 = tr_read<v_rd_off(D0, 0, 1)>(vb), l1 = tr_read<v_rd_off(D0, 1, 0)>(vb), h1 = tr_read<v_rd_off(D0, 1, 1)>(vb);
    const s16x4 l2 = tr_read<v_rd_off(D0, 2, 0)>(vb), h2 = tr_read<v_rd_off(D0, 2, 1)>(vb), l3 = tr_read<v_rd_off(D0, 3, 0)>(vb), h3 = tr_read<v_rd_off(D0, 3, 1)>(vb);
    asm volatile("s_waitcnt lgkmcnt(0)" ::: "memory"); SBAR();
#define PK(L, H) (bf16x8){L[0], L[1], L[2], L[3], H[0], H[1], H[2], H[3]}
    od = __builtin_amdgcn_mfma_f32_32x32x16_bf16(pa0, PK(l0, h0), od, 0, 0, 0);
    od = __builtin_amdgcn_mfma_f32_32x32x16_bf16(pa1, PK(l1, h1), od, 0, 0, 0);
    od = __builtin_amdgcn_mfma_f32_32x32x16_bf16(pa2, PK(l2, h2), od, 0, 0, 0);
    od = __builtin_amdgcn_mfma_f32_32x32x16_bf16(pa3, PK(l3, h3), od, 0, 0, 0);
#undef PK
}
__device__ __forceinline__ void pv_d0(f32x16* o, int vb, bf16x8 pa0, bf16x8 pa1, bf16x8 pa2, bf16x8 pa3) {
    pv_one<0>(o[0], vb, pa0, pa1, pa2, pa3); pv_one<1>(o[1], vb, pa0, pa1, pa2, pa3); pv_one<2>(o[2], vb, pa0, pa1, pa2, pa3); pv_one<3>(o[3], vb, pa0, pa1, pa2, pa3);
}

__device__ __forceinline__ void attn_unit(const bf16_t* __restrict__ proj, bf16_t* __restrict__ mixed, const float* __restrict__ att_g,
                                          int seq, long row0, int h, int qb, float lam, float nslope, float oscale, float kmax2, LAS char* lds) {
    const int tid = opaque_tid(), wid = tid >> 6, lane = tid & 63, r32 = lane & 31, hi = lane >> 5, c = wid >> 2, wq = wid & 3;
    LAS char* V_lds = lds; LAS char* K_lds = lds + 2 * SHM_V;
    LAS float* ws = (LAS float*)(lds + WS_OFF) + wid * 64; LAS float* li_l = ws; LAS float* al_l = ws + 32;
    float m_reg = -1e30f, l_reg = 0; f32x16 o[4] = {}; bf16x8 qr[4];
    const int qrow = qb * 128 + wq * 32 + r32;
    const bf16_t* Qw = proj + (size_t)(row0 + qrow) * NPROJ + h * 128 + c * 64 + hi * 8;
#pragma unroll
    for (int d0 = 0; d0 < 4; ++d0) qr[d0] = *reinterpret_cast<const bf16x8*>(Qw + d0 * 16);
    int tlo, NT;
    {
        float qs = 0.f;
#pragma unroll
        for (int d0 = 0; d0 < 4; ++d0)
#pragma unroll
            for (int e = 0; e < 8; ++e) { const float qv = bf2f((bf16_t)qr[d0][e]); qs += qv * qv; }
        qs += __shfl_xor(qs, 32);
#pragma unroll
        for (int o = 1; o < 32; o <<= 1) qs = fmaxf(qs, __shfl_xor(qs, o));
        if (lane == 0) ws[0] = qs;
        __syncthreads();
        float qm = 0.f;
#pragma unroll
        for (int w = 0; w < 8; ++w) qm = fmaxf(qm, ((LAS float*)(lds + WS_OFF))[w * 64]);
        const float smax = sqrtf(qm * kmax2) * 1.01f + 1e-3f;
        const float dstar = (36.0f + 2.0f * smax) / (-nslope);
        const int ntall = seq / KVBLK;
        int lo = (int)floorf(((float)(qb * 128) - dstar) * (1.0f / 64.0f)), hi_t = (int)floorf(((float)(qb * 128 + 127) + dstar) * (1.0f / 64.0f));
        lo = lo < 0 ? 0 : lo; hi_t = hi_t > ntall - 1 ? ntall - 1 : hi_t;
        if (((hi_t - lo + 1) & 1) != 0) { if (hi_t < ntall - 1) ++hi_t; else --lo; }
        tlo = lo; NT = hi_t - lo + 1;
    }
    const bf16_t* Kh = proj + (size_t)(row0 + tlo * KVBLK) * NPROJ + 512 + h * 128; const bf16_t* Vh = proj + (size_t)(row0 + tlo * KVBLK) * NPROJ + 1024 + h * 128;
    const int sr = tid >> 4, sc = (tid & 15) * 8, vst0 = v_st(sr, sc), vst1 = v_st(32 + sr, sc);
    const int vb0 = (int)(uintptr_t)V_lds + v_rd_base(lane);
    const float qposf = (float)(qrow - 4 * hi - tlo * KVBLK);
    struct { bf16x8 vs0, vs1, ks0, ks1; } sr_[2];
#define SLOAD(i, k0) do { sr_[i].vs0 = *reinterpret_cast<const bf16x8*>(&Vh[(size_t)((k0) + sr) * NPROJ + sc]); sr_[i].vs1 = *reinterpret_cast<const bf16x8*>(&Vh[(size_t)((k0) + 32 + sr) * NPROJ + sc]); \
    sr_[i].ks0 = *reinterpret_cast<const bf16x8*>(&Kh[(size_t)((k0) + sr) * NPROJ + sc]); sr_[i].ks1 = *reinterpret_cast<const bf16x8*>(&Kh[(size_t)((k0) + 32 + sr) * NPROJ + sc]); } while (0)
#define SWRITE(b, i) do { *(LAS bf16x8*)(V_lds + (b) * SHM_V + vst0) = sr_[i].vs0;          \
    *(LAS bf16x8*)(V_lds + (b) * SHM_V + vst1) = sr_[i].vs1; const int kc = sc * 2;               \
    *(LAS bf16x8*)(K_lds + (b) * SHM_K + KSWZ(sr, kc)) = sr_[i].ks0;                       \
    *(LAS bf16x8*)(K_lds + (b) * SHM_K + KSWZ(32 + sr, kc)) = sr_[i].ks1; } while (0)
#define SWAIT() asm volatile("s_waitcnt vmcnt(4)" ::: "memory")
#define RESC(a) do { if (__any((a) < 1.f)) { if (hi == 0) al_l[r32] = (a); asm volatile("s_waitcnt lgkmcnt(0)" ::: "memory"); \
    for (int d = 0; d < 4; ++d) for (int r = 0; r < 16; ++r) o[d][r] *= al_l[crow(r, hi)]; } } while (0)
    f32x16 pA0, pA1, pB0, pB1; float mnA, mnB, alA, alB; bf16x8 pa0, pa1, pa2, pa3;
    constexpr int SE = 0, SO = 1;
    SLOAD(SE, 0); asm volatile("s_waitcnt vmcnt(0)" ::: "memory"); SWRITE(0, SE); __syncthreads();
    qkt(pA0, pA1, K_lds, qr, r32, hi, c); alibi(pA0, pA1, qposf, nslope); partialSM(pA0, pA1, m_reg, mnA, alA);
    SLOAD(SO, KVBLK); if (2 < NT) SLOAD(SE, 2 * KVBLK);
    SWAIT(); SWRITE(1, SO); __syncthreads();
    for (int j = 1; j + 1 < NT; j += 2) {
        SBAR(); qkt(pB0, pB1, K_lds + SHM_K, qr, r32, hi, c);
        finishSM(pA0, pA1, alA, l_reg, pa0, pa1, pa2, pa3); SBAR();
        SLOAD(SO, (j + 2) * KVBLK); SBAR();
        pv_d0(o, vb0, pa0, pa1, pa2, pa3); alibi(pB0, pB1, qposf - (float)(j * KVBLK), nslope); partialSM(pB0, pB1, m_reg, mnB, alB);
        __syncthreads(); SWAIT(); SWRITE(0, SE);
        RESC(alB); __syncthreads();
        SBAR(); qkt(pA0, pA1, K_lds, qr, r32, hi, c);
        finishSM(pB0, pB1, alB, l_reg, pa0, pa1, pa2, pa3); SBAR();
        if (j + 3 < NT) SLOAD(SE, (j + 3) * KVBLK); SBAR();
        pv_d0(o, vb0 + SHM_V, pa0, pa1, pa2, pa3); alibi(pA0, pA1, qposf - (float)((j + 1) * KVBLK), nslope); partialSM(pA0, pA1, m_reg, mnA, alA);
        __syncthreads(); SWAIT(); SWRITE(1, SO);
        RESC(alA); __syncthreads();
    }
    SBAR(); qkt(pB0, pB1, K_lds + SHM_K, qr, r32, hi, c);
    finishSM(pA0, pA1, alA, l_reg, pa0, pa1, pa2, pa3); SBAR();
    pv_d0(o, vb0, pa0, pa1, pa2, pa3); alibi(pB0, pB1, qposf - (float)((NT - 1) * KVBLK), nslope); partialSM(pB0, pB1, m_reg, mnB, alB);
    __syncthreads(); RESC(alB);
    finishSM(pB0, pB1, alB, l_reg, pa0, pa1, pa2, pa3); SBAR();
    pv_d0(o, vb0 + SHM_V, pa0, pa1, pa2, pa3);
    if (hi == 0) li_l[r32] = l_reg; asm volatile("s_waitcnt lgkmcnt(0)" ::: "memory");
    float rli[16];
#pragma unroll
    for (int r = 0; r < 16; ++r) rli[r] = __builtin_amdgcn_rcpf(li_l[crow(r, hi)]);
    __syncthreads();
    LAS float* OB = (LAS float*)lds;
    if (c == 1) {
#pragma unroll
        for (int r = 0; r < 16; ++r) { const int orow = wq * 32 + crow(r, hi);
#pragma unroll
            for (int d0 = 0; d0 < 4; ++d0) OB[orow * OB_PITCH + d0 * 32 + r32] = o[d0][r] * rli[r]; }
    }
    __syncthreads();
    if (c == 0) {
        float gcol[4];
#pragma unroll
        for (int d0 = 0; d0 < 4; ++d0) gcol[d0] = att_g[h * 128 + d0 * 32 + r32] * oscale;
#pragma unroll
        for (int r = 0; r < 16; ++r) { const int orow = wq * 32 + crow(r, hi);
            float dv[4]; float ss = 0.f;
#pragma unroll
            for (int d0 = 0; d0 < 4; ++d0) { dv[d0] = o[d0][r] * rli[r] - lam * OB[orow * OB_PITCH + d0 * 32 + r32]; ss += dv[d0] * dv[d0]; }
            ss += __shfl_xor(ss, 1); ss += __shfl_xor(ss, 2); ss += __shfl_xor(ss, 4); ss += __shfl_xor(ss, 8); ss += __shfl_xor(ss, 16);
            const float rs = rsqrtf(ss * (1.f / 128.f) + EPS);
            bf16_t* orp = mixed + (size_t)(row0 + qb * 128 + orow) * DM + h * 128 + r32;
#pragma unroll
            for (int d0 = 0; d0 < 4; ++d0) orp[d0 * 32] = f2bf(dv[d0] * rs * gcol[d0]); }
    }
    __syncthreads();
#undef SLOAD
#undef SWRITE
#undef SWAIT
#undef RESC
}
}

namespace ml {
constexpr int QP = 192, VP = 320, SP = 272, CP = 320;
constexpr int OFF_Q = 0, OFF_K = 24576, OFF_KE = 49152, OFF_V = 73728, OFF_C = 114688, OFF_VEC = 135168;
constexpr int V_U = 0, V_MX = 128, V_EINT = 256, V_EEND = 384, V_EMO = 512, V_QN = 640, V_RS = 768, V_GI = 896, V_GF = 1024, V_NST = 1152, V_NPART = 1216, V_SCAL = 1728;
constexpr int HS_PITCH = 132;
__device__ __forceinline__ s16x4 trr(unsigned addr) { s16x4 r; asm volatile("ds_read_b64_tr_b16 %0, %1" : "=&v"(r) : "v"(addr) : "memory"); return r; }
#define TRWAIT2(a, b) asm volatile("s_waitcnt lgkmcnt(0)" : "+v"(a), "+v"(b) :: "memory")
#define TRWAIT4(a, b, c, d) asm volatile("s_waitcnt lgkmcnt(0)" : "+v"(a), "+v"(b), "+v"(c), "+v"(d) :: "memory")
#define CAT(L, H) (bf16x8){L[0], L[1], L[2], L[3], H[0], H[1], H[2], H[3]}
__device__ __forceinline__ float logsig(float x) { return fminf(x, 0.f) - log1pf(expf(-fabsf(x))); }

__device__ __forceinline__ void mlstm_item(const bf16_t* __restrict__ proj, const float* __restrict__ gates, bf16_t* mixed, const float* __restrict__ lstm_g,
                                           int seq, long row0, int h, LAS unsigned char* lds) {
    const int tid0 = opaque_tid();
    LAS float* vec = (LAS float*)(lds + OFF_VEC);
    const unsigned lbase = (unsigned)(uintptr_t)lds;
    const int nc = seq / 128;
    constexpr float L2E = 1.4426950408889634f;
    for (int dir = 0; dir < 2; ++dir) {
        f32x16 Cst = {};
        if (tid0 < 64) vec[V_NST + tid0] = 0.f;
        float m_state = 0.f;
        __syncthreads();
        for (int cc = 0; cc < nc; ++cc) {
            int tid = tid0; asm volatile("" : "+v"(tid));
            const int wid = tid >> 6, lane = tid & 63, r = lane & 31, hh = lane >> 5, i16 = lane & 15, q4 = i16 >> 2, p4 = i16 & 3, blk = (lane >> 4) & 1;
            const int rb = wid >> 1, ch = wid & 1, db = wid >> 2, eb = wid & 3;
            const int c = dir ? nc - 1 - cc : cc;
            const long cbase = row0 + (long)c * 128;
#define POS(j) (cbase + (dir ? 127 - (j) : (j)))
#pragma unroll
            for (int i = 0; i < 2; ++i) { const int chunk = tid + 512 * i, j = chunk >> 3, c8 = chunk & 7; const bf16_t* src = proj + (size_t)POS(j) * NPROJ + h * 64 + c8 * 8;
                *(LAS bf16x8*)(lds + OFF_Q + j * QP + c8 * 16) = *(const bf16x8*)(src + 1536);
                *(LAS bf16x8*)(lds + OFF_K + j * QP + c8 * 16) = *(const bf16x8*)(src + 1792); }
#pragma unroll
            for (int i = 0; i < 4; ++i) { const int chunk = tid + 512 * i, j = chunk >> 4, c16 = chunk & 15;
                *(LAS bf16x8*)(lds + OFF_V + j * VP + c16 * 16) = *(const bf16x8*)(proj + (size_t)POS(j) * NPROJ + 2048 + h * 128 + c16 * 8); }
            if (tid < 128) { const float* gp = gates + (size_t)POS(tid) * 16; vec[V_GI + tid] = gp[(dir ? 8 : 0) + h]; vec[V_GF + tid] = gp[(dir ? 12 : 4) + h]; }
#pragma unroll
            for (int i = 0; i < 16; ++i) *(LAS bf16_t*)(lds + OFF_C + (32 * db + crow(i, hh)) * CP + (32 * eb + r) * 2) = f2bf(Cst[i]);
            __syncthreads();
            if (wid == 0) {
                const float gf0 = vec[V_GF + 2 * lane], gf1 = vec[V_GF + 2 * lane + 1], gi0 = vec[V_GI + 2 * lane], gi1 = vec[V_GI + 2 * lane + 1];
                const float lf0 = logsig(gf0), lf1 = logsig(gf1);
                float incl = lf0 + lf1;
#pragma unroll
                for (int d = 1; d < 64; d <<= 1) { const float t = __shfl_up(incl, d); if (lane >= d) incl += t; }
                const float b1 = incl, b0 = incl - lf1, g = __shfl(incl, 63);
                const float u0 = gi0 - b0, u1 = gi1 - b1;
                float cm = fmaxf(u0, u1);
#pragma unroll
                for (int d = 1; d < 64; d <<= 1) { const float t = __shfl_up(cm, d); if (lane >= d) cm = fmaxf(cm, t); }
                float excl = __shfl_up(cm, 1); if (lane == 0) excl = -INFINITY;
                const float cmx0 = fmaxf(excl, u0), cmx1 = cm, umax = __shfl(cm, 63);
                const float mp = m_state, mx0 = fmaxf(mp, cmx0), mx1 = fmaxf(mp, cmx1);
                vec[V_U + 2 * lane] = u0; vec[V_U + 2 * lane + 1] = u1; vec[V_MX + 2 * lane] = mx0; vec[V_MX + 2 * lane + 1] = mx1;
                vec[V_EINT + 2 * lane] = expf(mp - mx0); vec[V_EINT + 2 * lane + 1] = expf(mp - mx1);
                vec[V_EEND + 2 * lane] = expf(u0 - umax); vec[V_EEND + 2 * lane + 1] = expf(u1 - umax);
                vec[V_EMO + 2 * lane] = expf(-(b0 + mx0)); vec[V_EMO + 2 * lane + 1] = expf(-(b1 + mx1));
                const float m_loc = g + umax, m_new = fmaxf(g + mp, m_loc);
                if (lane == 0) { vec[V_SCAL] = expf(g + mp - m_new); vec[V_SCAL + 1] = expf(m_loc - m_new); }
                m_state = m_new;
            }
            bf16x8 qa[4];
#pragma unroll
            for (int ks = 0; ks < 4; ++ks) qa[ks] = *(const LAS bf16x8*)(lds + OFF_Q + (32 * rb + r) * QP + (16 * ks + 8 * hh) * 2);
            f32x16 Sv[2] = {}, Ov[2] = {};
#pragma unroll
            for (int t = 0; t < 2; ++t) {
                if (2 * ch + t <= rb) {
#pragma unroll
                    for (int ks = 0; ks < 4; ++ks) { const bf16x8 kb = *(const LAS bf16x8*)(lds + OFF_K + (64 * ch + 32 * t + r) * QP + (16 * ks + 8 * hh) * 2);
                        Sv[t] = __builtin_amdgcn_mfma_f32_32x32x16_bf16(qa[ks], kb, Sv[t], 0, 0, 0); } }
#pragma unroll
                for (int ks = 0; ks < 4; ++ks) { const unsigned a0 = lbase + OFF_C + (16 * ks + 8 * hh + q4) * CP + (64 * ch + 32 * t + 16 * blk + 4 * p4) * 2;
                    s16x4 lo = trr(a0), hi4 = trr(a0 + 4 * CP); TRWAIT2(lo, hi4);
                    Ov[t] = __builtin_amdgcn_mfma_f32_32x32x16_bf16(qa[ks], CAT(lo, hi4), Ov[t], 0, 0, 0); }
            }
            { const int j = tid >> 2, part = tid & 3; float s = 0.f;
#pragma unroll
              for (int k2 = 0; k2 < 2; ++k2) { const bf16x8 qv = *(const LAS bf16x8*)(lds + OFF_Q + j * QP + (16 * part + 8 * k2) * 2);
#pragma unroll
                  for (int e = 0; e < 8; ++e) s += bf2f((bf16_t)qv[e]) * vec[V_NST + 16 * part + 8 * k2 + e]; }
              s += __shfl_xor(s, 1); s += __shfl_xor(s, 2); if (part == 0) vec[V_QN + j] = s; }
            __syncthreads();
#pragma unroll
            for (int i = 0; i < 2; ++i) { const int chunk = tid + 512 * i, j = chunk >> 3, c8 = chunk & 7; const float ee = vec[V_EEND + j];
                const bf16x8 kv = *(const LAS bf16x8*)(lds + OFF_K + j * QP + c8 * 16); u32x4 w;
                w.x = cvt_pk_bf16(bf2f((bf16_t)kv[0]) * ee, bf2f((bf16_t)kv[1]) * ee); w.y = cvt_pk_bf16(bf2f((bf16_t)kv[2]) * ee, bf2f((bf16_t)kv[3]) * ee);
                w.z = cvt_pk_bf16(bf2f((bf16_t)kv[4]) * ee, bf2f((bf16_t)kv[5]) * ee); w.w = cvt_pk_bf16(bf2f((bf16_t)kv[6]) * ee, bf2f((bf16_t)kv[7]) * ee);
                *(LAS u32x4*)(lds + OFF_KE + j * QP + c8 * 16) = w; }
            {
                const float us0 = vec[V_U + 64 * ch + r] * L2E, us1 = vec[V_U + 64 * ch + 32 + r] * L2E;
#pragma unroll
                for (int i = 0; i < 16; ++i) { const int j = 32 * rb + crow(i, hh); const float mxj = vec[V_MX + j] * L2E, ei = vec[V_EINT + j];
                    const int s0 = 64 * ch + r, s1 = s0 + 32;
                    Sv[0][i] = (s0 <= j) ? Sv[0][i] * __builtin_amdgcn_exp2f(us0 - mxj) : 0.f;
                    Sv[1][i] = (s1 <= j) ? Sv[1][i] * __builtin_amdgcn_exp2f(us1 - mxj) : 0.f;
                    Ov[0][i] *= ei; Ov[1][i] *= ei; }
            }
            __syncthreads();
#pragma unroll
            for (int t = 0; t < 2; ++t)
#pragma unroll
                for (int i = 0; i < 16; ++i) *(LAS bf16_t*)(lds + OFF_Q + (32 * rb + crow(i, hh)) * SP + (64 * ch + 32 * t + r) * 2) = f2bf(Sv[t][i]);
            __syncthreads();
#pragma unroll 1
            for (int ks = 0; ks < 2 * (rb + 1); ++ks) {
                const bf16x8 a = *(const LAS bf16x8*)(lds + OFF_Q + (32 * rb + r) * SP + (16 * ks + 8 * hh) * 2);
                const unsigned a0 = lbase + OFF_V + (16 * ks + 8 * hh + q4) * VP + (64 * ch + 16 * blk + 4 * p4) * 2;
                s16x4 l0 = trr(a0), h0 = trr(a0 + 4 * VP), l1 = trr(a0 + 64), h1 = trr(a0 + 4 * VP + 64); TRWAIT4(l0, h0, l1, h1);
                Ov[0] = __builtin_amdgcn_mfma_f32_32x32x16_bf16(a, CAT(l0, h0), Ov[0], 0, 0, 0);
                Ov[1] = __builtin_amdgcn_mfma_f32_32x32x16_bf16(a, CAT(l1, h1), Ov[1], 0, 0, 0);
            }
            { const int j = tid >> 2, part = tid & 3; float s = 0.f;
#pragma unroll
              for (int k4 = 0; k4 < 4; ++k4) { const bf16x8 sv = *(const LAS bf16x8*)(lds + OFF_Q + j * SP + (32 * part + 8 * k4) * 2);
#pragma unroll
                  for (int e = 0; e < 8; ++e) s += bf2f((bf16_t)sv[e]); }
              s += __shfl_xor(s, 1); s += __shfl_xor(s, 2); if (part == 0) vec[V_RS + j] = s; }
            f32x16 Cl = {};
#pragma unroll 2
            for (int ks = 0; ks < 8; ++ks) {
                const unsigned aa = lbase + OFF_KE + (16 * ks + 8 * hh + q4) * QP + (32 * db + 16 * blk + 4 * p4) * 2;
                const unsigned ab = lbase + OFF_V + (16 * ks + 8 * hh + q4) * VP + (32 * eb + 16 * blk + 4 * p4) * 2;
                s16x4 la = trr(aa), ha = trr(aa + 4 * QP), lb = trr(ab), hb = trr(ab + 4 * VP); TRWAIT4(la, ha, lb, hb);
                Cl = __builtin_amdgcn_mfma_f32_32x32x16_bf16(CAT(la, ha), CAT(lb, hb), Cl, 0, 0, 0);
            }
            const float sa = vec[V_SCAL], sb = vec[V_SCAL + 1];
#pragma unroll
            for (int i = 0; i < 16; ++i) Cst[i] = sa * Cst[i] + sb * Cl[i];
            { const int d = tid & 63, part = tid >> 6; float s = 0.f;
#pragma unroll
              for (int k = 0; k < 16; ++k) s += bf2f(*(const LAS bf16_t*)(lds + OFF_KE + (16 * part + k) * QP + d * 2));
              vec[V_NPART + part * 64 + d] = s; }
            __syncthreads();
            if (tid < 64) { float nl = 0.f;
#pragma unroll
                for (int p = 0; p < 8; ++p) nl += vec[V_NPART + p * 64 + tid];
                vec[V_NST + tid] = sa * vec[V_NST + tid] + sb * nl; }
            LAS float* HS = (LAS float*)lds;
#pragma unroll
            for (int i = 0; i < 16; ++i) { const int j = 32 * rb + crow(i, hh);
                const float den = vec[V_EINT + j] * vec[V_QN + j] + vec[V_RS + j];
                const float scl = 1.0f / fmaxf(fabsf(den), vec[V_EMO + j]);
                bf16_t* op = mixed + (size_t)POS(j) * DM + 512 + h * 128 + 64 * ch + r;
                if (dir == 0) { op[0] = f2bf(Ov[0][i] * scl); op[32] = f2bf(Ov[1][i] * scl); }
                else { HS[j * HS_PITCH + 64 * ch + r] = Ov[0][i] * scl + bf2f(op[0]); HS[j * HS_PITCH + 64 * ch + 32 + r] = Ov[1][i] * scl + bf2f(op[32]); } }
            if (dir == 1) {
                __syncthreads();
                const int j = tid >> 2, part = tid & 3; float ss = 0.f;
#pragma unroll
                for (int k = 0; k < 8; ++k) { const f32x4 x = *(const LAS f32x4*)(HS + j * HS_PITCH + 32 * part + 4 * k);
                    ss += (x[0] * x[0] + x[1] * x[1]) + (x[2] * x[2] + x[3] * x[3]); }
                ss += __shfl_xor(ss, 1); ss += __shfl_xor(ss, 2);
                const float rs = rsqrtf(ss * (1.f / 128.f) + EPS);
                const bf16_t* lop = proj + (size_t)POS(j) * NPROJ + 2560 + h * 128 + 32 * part;
                bf16_t* op = mixed + (size_t)POS(j) * DM + 512 + h * 128 + 32 * part;
                const float* gp = lstm_g + h * 128 + 32 * part;
#pragma unroll
                for (int k = 0; k < 4; ++k) { const bf16x8 lo8 = *(const bf16x8*)(lop + 8 * k); float ov[8];
                    const f32x4 xa = *(const LAS f32x4*)(HS + j * HS_PITCH + 32 * part + 8 * k), xb4 = *(const LAS f32x4*)(HS + j * HS_PITCH + 32 * part + 8 * k + 4);
                    const float hv8[8] = {xa[0], xa[1], xa[2], xa[3], xb4[0], xb4[1], xb4[2], xb4[3]};
#pragma unroll
                    for (int e = 0; e < 8; ++e) { const float lg = bf2f((bf16_t)lo8[e]); const float sg = 1.0f / (1.0f + expf(-lg)); ov[e] = sg * hv8[e] * rs * gp[8 * k + e]; }
                    u32x4 w; w.x = cvt_pk_bf16(ov[0], ov[1]); w.y = cvt_pk_bf16(ov[2], ov[3]); w.z = cvt_pk_bf16(ov[4], ov[5]); w.w = cvt_pk_bf16(ov[6], ov[7]);
                    *(u32x4*)(op + 8 * k) = w; }
            }
            __syncthreads();
#undef POS
        }
        __threadfence(); __syncthreads();
    }
}
}

struct Args {
    const float* xin[2]; const float* w_in; const float* gate_bias; const float* lam_q1; const float* lam_k1; const float* lam_q2; const float* lam_k2;
    const float* att_g; const float* lstm_g; const float* w_out; const float* ln1_g; const float* ln1_b; const float* w_gu; const float* conv_w; const float* conv_b;
    const float* w_down; const float* ln2_g; const float* ln2_b; float* out; unsigned char* ws; int ph_lo, ph_hi;
};
constexpr int NPHASE = 31;

__device__ __forceinline__ void transpose_item(const float* W, int K, int N, bf16_t* WT, int gu_map, const float* g, const float* b, float* c1, float* c2, LAS float* scr, int item, int lane) {
    const int nblk = (N + 31) / 32, kb = item / nblk, nb = item % nblk, k0 = 64 * kb, n0 = 32 * nb;
    const int ncol = n0 + (lane & 31); const bool okc = ncol < N;
    float a1 = 0.f, a2 = 0.f;
#pragma unroll 8
    for (int i = 0; i < 32; ++i) { const int kk = 2 * i + (lane >> 5); float w = okc ? W[(size_t)(k0 + kk) * N + ncol] : 0.f;
        if (g) { a2 += w * b[k0 + kk]; w *= g[k0 + kk]; a1 += bf2f(f2bf(w)); }
        scr[kk * 33 + (lane & 31)] = w; }
    asm volatile("s_waitcnt lgkmcnt(0)" ::: "memory");
    if (g) { a1 += __shfl_xor(a1, 32); a2 += __shfl_xor(a2, 32); }
    const int c = lane & 7;
#pragma unroll
    for (int j = 0; j < 4; ++j) { const int nl = (lane >> 3) + 8 * j; const int n = n0 + nl; const LAS float* s = scr + (8 * c) * 33 + nl;
        u32x4 o; o.x = cvt_pk_bf16(s[0 * 33], s[1 * 33]); o.y = cvt_pk_bf16(s[2 * 33], s[3 * 33]); o.z = cvt_pk_bf16(s[4 * 33], s[5 * 33]); o.w = cvt_pk_bf16(s[6 * 33], s[7 * 33]);
        if (n < N) { int rowm = n; if (gu_map) { const int n2 = n < DFF ? n : n - DFF; rowm = 256 * (n2 >> 7) + (n < DFF ? 0 : 128) + (n2 & 127); }
            *(u32x4*)(WT + (size_t)rowm * K + k0 + 8 * c) = o; } }
    if (g && lane < 32 && okc) { int rowm = ncol; if (gu_map) { const int n2 = ncol < DFF ? ncol : ncol - DFF; rowm = 256 * (n2 >> 7) + (ncol < DFF ? 0 : 128) + (n2 & 127); }
        atomicAdd(c1 + rowm, a1); atomicAdd(c2 + rowm, a2); }
    asm volatile("s_waitcnt lgkmcnt(0)" ::: "memory");
}

__device__ __forceinline__ void cvt_rows(const float* x, bf16_t* xb, int gtid, int nthr) {
    for (size_t i = gtid; i < (size_t)MT * DM / 8; i += nthr) {
        const f32x4 a = *(const f32x4*)(x + i * 8), b = *(const f32x4*)(x + i * 8 + 4);
        u32x4 w; w.x = cvt_pk_bf16(a[0], a[1]); w.y = cvt_pk_bf16(a[2], a[3]); w.z = cvt_pk_bf16(b[0], b[1]); w.w = cvt_pk_bf16(b[2], b[3]);
        *(u32x4*)(xb + i * 8) = w; }
}

__global__ void __launch_bounds__(512, 2) fwd(Args args) {
    extern __shared__ __attribute__((aligned(16))) unsigned char lds_raw[];
    LAS unsigned char* lds = (LAS unsigned char*)lds_raw;
    for (int ph = args.ph_lo; ph < args.ph_hi; ++ph) {
        if (ph > args.ph_lo) cg::this_grid().sync();
        const int tid = opaque_tid(), lane = tid & 63, wave = __builtin_amdgcn_readfirstlane(tid >> 6);
        const int G = gridDim.x, gtid = blockIdx.x * 512 + tid, nthr = G * 512;
        unsigned char* ws = args.ws; asm volatile("" : "+s"(ws));
        bf16_t* XB = (bf16_t*)(ws + WS_XB); bf16_t* MIXED = (bf16_t*)(ws + WS_MIXED); bf16_t* PROJ = (bf16_t*)(ws + WS_PROJ); bf16_t* HMID = PROJ;
        float* GATES = (float*)(ws + WS_GATES); float* EDGE = (float*)(ws + WS_EDGE);
        f32x2* ST1 = (f32x2*)(ws + WS_ST1); f32x2* ST2 = (f32x2*)(ws + WS_ST2);
        float* LAMV = (float*)(ws + WS_LAM);
        float* C1IN = (float*)(ws + CTL_C1IN); float* C2IN = (float*)(ws + CTL_C2IN); float* C1GU = (float*)(ws + CTL_C1GU); float* C2GU = (float*)(ws + CTL_C2GU);
        unsigned* QCNT = (unsigned*)(ws + WS_CTL);
        if ((PHMASK & 1) && ph == 0) {
            LAS float* scr = (LAS float*)(lds + wave * 8448);
            const int gw = blockIdx.x * 8 + wave, NGW = G * 8;
            constexpr int I_IN = 16 * 97, I_OUT = 16 * 32, I_GU = 16 * 176, I_DN = 44 * 32, I_L = I_IN + I_OUT + I_GU + I_DN;
            for (int it = gw; it < 2 * I_L; it += NGW) {
                const int l = it / I_L; int r = it % I_L;
                if (r < I_IN) { transpose_item(args.w_in + (size_t)l * DM * NIN, DM, NIN, (bf16_t*)(ws + WS_WIN) + (size_t)l * NPROJ_PAD * DM, 0,
                                               l ? args.ln2_g : nullptr, l ? args.ln2_b : nullptr, C1IN, C2IN, scr, r, lane); continue; } r -= I_IN;
                if (r < I_OUT) { transpose_item(args.w_out + (size_t)l * DM * DM, DM, DM, (bf16_t*)(ws + WS_WOUT) + (size_t)l * DM * DM, 0, nullptr, nullptr, nullptr, nullptr, scr, r, lane); continue; } r -= I_OUT;
                if (r < I_GU) { transpose_item(args.w_gu + (size_t)l * DM * NGU, DM, NGU, (bf16_t*)(ws + WS_WGU) + (size_t)l * NGU * DM, 1,
                                               args.ln1_g + l * DM, args.ln1_b + l * DM, C1GU + l * NGU, C2GU + l * NGU, scr, r, lane); continue; } r -= I_GU;
                transpose_item(args.w_down + (size_t)l * DFF * DM, DFF, DM, (bf16_t*)(ws + WS_WDN) + (size_t)l * DM * DFF, 0, nullptr, nullptr, nullptr, nullptr, scr, r, lane);
            }
            for (int i = gtid; i < 2 * (NPROJ_PAD - NIN) * DM / 8; i += nthr) { const int l = i / ((NPROJ_PAD - NIN) * DM / 8), o = i % ((NPROJ_PAD - NIN) * DM / 8);
                *(u32x4*)((bf16_t*)(ws + WS_WIN) + (size_t)l * NPROJ_PAD * DM + (size_t)NIN * DM + (size_t)o * 8) = (u32x4){0u, 0u, 0u, 0u}; }
            if (blockIdx.x == 0 && wave == 0) {
                for (int l = 0; l < 2; ++l) {
                    float s1 = args.lam_q1[l * 64 + lane] * args.lam_k1[l * 64 + lane], s2 = args.lam_q2[l * 64 + lane] * args.lam_k2[l * 64 + lane];
#pragma unroll
                    for (int o = 1; o < 64; o <<= 1) { s1 += __shfl_xor(s1, o); s2 += __shfl_xor(s2, o); }
                    const float lam_init = 0.8f - 0.6f * expf(-0.3f * (float)l);
                    if (lane == 0) LAMV[l] = expf(s1) - expf(s2) + lam_init;
                }
            }
            cvt_rows(args.xin[0], XB, gtid, nthr);
            continue;
        }
        const int trunk = (ph - 1) / 15, pp = (ph - 1) % 15;
        const int seq = trunk ? 2048 : 4096, nseq = trunk ? 32 : 16;
        float* V = args.out + (size_t)trunk * MT * DM;
        if ((PHMASK & 256) && pp == 14) {
            const float* g = args.ln2_g + DM; const float* b = args.ln2_b + DM;
            for (size_t i = gtid; i < (size_t)MT * DM / 4; i += nthr) { const int row = (int)(i >> 8), col = (int)(i & 255) * 4;
                float mu, rstd; row_stats(ST2, row, mu, rstd);
                const f32x4 x = *(const f32x4*)(V + i * 4), gv = *(const f32x4*)(g + col), bv = *(const f32x4*)(b + col);
                *(f32x4*)(V + i * 4) = (x - mu) * rstd * gv + bv; }
            if (trunk == 0) cvt_rows(args.xin[1], XB, gtid, nthr);
            continue;
        }
        const int l = pp / 7, sp0 = pp % 7, sp = sp0 == 0 ? 0 : sp0 - 1;
        unsigned* KMAX = (unsigned*)(ws + CTL_KMAX) + (trunk * 2 + l) * 128;
        if (sp0 == 1) {
            const int gw = blockIdx.x * 8 + wave, NGW = G * 8;
            for (int chunk = gw; chunk < MT / 32; chunk += NGW) {
                float mx = 0.f;
                for (int i = 0; i < 32; ++i) { const bf16x8 kv = *(const bf16x8*)(PROJ + (size_t)(chunk * 32 + i) * NPROJ + 512 + lane * 8); float ss = 0.f;
#pragma unroll
                    for (int e = 0; e < 8; ++e) { const float x = bf2f((bf16_t)kv[e]); ss += x * x; }
                    ss += __shfl_xor(ss, 1); ss += __shfl_xor(ss, 2); ss += __shfl_xor(ss, 4); mx = fmaxf(mx, ss); }
                if ((lane & 7) == 0) atomicMax(KMAX + ((chunk * 32) / seq) * 4 + (lane >> 4), __float_as_uint(mx));
            }
        } else if ((PHMASK & 2) && sp == 0) {
            pg8::Gemm g{XB, (const bf16_t*)(ws + WS_WIN) + (size_t)l * NPROJ_PAD * DM, MT, NPROJ_PAD, DM};
            pg8::StaticOrder S; S.init(MT, NPROJ_PAD, G, (int)blockIdx.x);
            EpiProj E{PROJ, GATES, args.gate_bias + l * 16, l ? ST2 : nullptr, C1IN, C2IN, (LAS f32x2*)(lds + EPI_LDS + 8192)};
            pg8::gemm_phase<EpiProj, pg8::StaticOrder>(lds, g, S, E);
        } else if ((PHMASK & 12) && sp == 1) {
            unsigned* qc = QCNT + (size_t)((trunk * 2 + l) * 8) * 64;
            const int myx = (int)(__builtin_amdgcn_s_getreg((3 << 11) | 20) & 7);
            const int npair = nseq / 2, nqb = seq / 128, nitems = npair * (1 + nqb);
            const float lam = LAMV[l]; const float lam_init = 0.8f - 0.6f * expf(-0.3f * (float)l);
            LAS int* sitem = (LAS int*)(lds + LDS_BYTES - 64);
            for (int qq = 0; qq < 8; ++qq) {
                const int x = (myx + qq) & 7;
                for (;;) {
                    if (tid == 0) sitem[0] = (int)atomicAdd(qc + 64 * x, 1u);
                    __syncthreads();
                    const int item = sitem[0];
                    __syncthreads();
                    if (item >= nitems) break;
                    const int nbh = nseq / 8;
                    if ((PHMASK & 4) && item < npair) {
                        const int h = 3 - item / nbh, b = ((x - 2 * h) & 7) + 8 * (item % nbh);
                        ml::mlstm_item(PROJ, GATES, MIXED, args.lstm_g + l * 512, seq, (long)b * seq, h, lds);
                    } else if (PHMASK & 8) {
                        const int a = item - npair, pi = a / nqb, qb = a % nqb, h = 3 - pi / nbh, b = ((x - 2 * h) & 7) + 8 * (pi % nbh);
                        const float slope = exp2f(-2.0f * (float)(h + 1));
                        att::attn_unit(PROJ, MIXED, args.att_g + l * 512, seq, (long)b * seq, h, qb, lam, -slope, 1.0f - lam_init, __uint_as_float(KMAX[b * 4 + h]), (LAS char*)lds);
                    }
                }
            }
        } else if ((PHMASK & 16) && sp == 2) {
            pg8::Gemm g{MIXED, (const bf16_t*)(ws + WS_WOUT) + (size_t)l * DM * DM, MT, DM, DM};
            pg8::StaticOrder S; S.init(MT, DM, G, (int)blockIdx.x);
            EpiRes E{l ? nullptr : args.xin[trunk], V, ST2, args.ln2_g, args.ln2_b, ST1, XB, (LAS f32x2*)(lds + EPI_LDS), (LAS f32x2*)(lds + EPI_LDS + 8192)};
            pg8::gemm_phase<EpiRes, pg8::StaticOrder>(lds, g, S, E);
        } else if ((PHMASK & 32) && sp == 3) {
            pg8::Gemm g{XB, (const bf16_t*)(ws + WS_WGU) + (size_t)l * NGU * DM, MT, NGU, DM};
            pg8::StaticOrder S; S.init(MT, NGU, G, (int)blockIdx.x);
            EpiGU E{HMID, EDGE, ST1, C1GU + l * NGU, C2GU + l * NGU, args.conv_w + (size_t)l * 3 * DFF, args.conv_b + (size_t)l * DFF, (LAS float*)(lds + EPI_LDS), (LAS f32x2*)(lds + EPI_LDS + 8192)};
            pg8::gemm_phase<EpiGU, pg8::StaticOrder>(lds, g, S, E);
        } else if ((PHMASK & 64) && sp == 4) {
            const float* cw = args.conv_w + (size_t)l * 3 * DFF; const float* cb = args.conv_b + (size_t)l * DFF; const int st = seq / 256;
            for (int i = gtid; i < 256 * 2 * (DFF / 4); i += nthr) {
                const int grp = i % (DFF / 4), e2 = (i / (DFF / 4)) & 1, pm = i / (2 * (DFF / 4)), j = grp * 4;
                const float* Ep = EDGE + (size_t)pm * 6 * DFF + j;
                const f32x4 w0 = *(const f32x4*)(cw + j), w1 = *(const f32x4*)(cw + DFF + j), w2 = *(const f32x4*)(cw + 2 * DFF + j), cbv = *(const f32x4*)(cb + j);
                f32x4 ga, gb, gc, up; const f32x4 z = (f32x4){0.f, 0.f, 0.f, 0.f}; int row;
                if (e2 == 0) { ga = (pm % st == 0) ? z : *(const f32x4*)(Ep - 6 * DFF + 3 * DFF); gb = *(const f32x4*)(Ep); gc = *(const f32x4*)(Ep + DFF); up = *(const f32x4*)(Ep + 4 * DFF); row = pm * 256; }
                else { ga = *(const f32x4*)(Ep + 2 * DFF); gb = *(const f32x4*)(Ep + 3 * DFF); gc = (pm % st == st - 1) ? z : *(const f32x4*)(Ep + 6 * DFF); up = *(const f32x4*)(Ep + 5 * DFF); row = pm * 256 + 255; }
                const f32x4 cv = cbv + w0 * ga + w1 * gb + w2 * gc;
                u32x2 w; w.x = cvt_pk_bf16(gelu_erf(cv[0]) * up[0], gelu_erf(cv[1]) * up[1]); w.y = cvt_pk_bf16(gelu_erf(cv[2]) * up[2], gelu_erf(cv[3]) * up[3]);
                *(u32x2*)(HMID + (size_t)row * DFF + j) = w; }
        } else if (PHMASK & 128) {
            pg8::Gemm g{HMID, (const bf16_t*)(ws + WS_WDN) + (size_t)l * DM * DFF, MT, DM, DFF};
            pg8::StaticOrder S; S.init(MT, DM, G, (int)blockIdx.x);
            EpiRes E{nullptr, V, ST1, args.ln1_g + l * DM, args.ln1_b + l * DM, ST2, l == 0 ? XB : nullptr, (LAS f32x2*)(lds + EPI_LDS), (LAS f32x2*)(lds + EPI_LDS + 8192)};
            pg8::gemm_phase<EpiRes, pg8::StaticOrder>(lds, g, S, E);
        }
    }
}

extern "C" void kernel_launch(void* const* d_in, const int* in_sizes, int n_in, void* d_out, int out_size, void* d_ws, size_t ws_size, hipStream_t stream) {
    static int grid = 0;
    if (grid == 0) {
        if (n_in != 19 || ws_size < WS_END) { fprintf(stderr, "kernel_launch: unexpected n_in %d / ws %zu\n", n_in, ws_size); grid = -1; return; }
        int dev = 0, cus = 0, per_cu = 0;
        hipGetDevice(&dev); hipDeviceGetAttribute(&cus, hipDeviceAttributeMultiprocessorCount, dev);
        if (hipFuncSetAttribute((const void*)fwd, hipFuncAttributeMaxDynamicSharedMemorySize, LDS_BYTES) != hipSuccess) { fprintf(stderr, "kernel_launch: hipFuncSetAttribute failed\n"); grid = -1; return; }
        hipOccupancyMaxActiveBlocksPerMultiprocessor(&per_cu, (const void*)fwd, 512, LDS_BYTES);
        (void)hipGetLastError();
        if (per_cu < 1) per_cu = 1;
        grid = cus;
    }
    if (grid < 0) return;
    hipMemsetAsync((char*)d_ws + WS_CTL, 0, CTL_BYTES, stream);
    Args a{};
    a.xin[0] = (const float*)d_in[0]; a.xin[1] = (const float*)d_in[1]; a.w_in = (const float*)d_in[2]; a.gate_bias = (const float*)d_in[3];
    a.lam_q1 = (const float*)d_in[4]; a.lam_k1 = (const float*)d_in[5]; a.lam_q2 = (const float*)d_in[6]; a.lam_k2 = (const float*)d_in[7];
    a.att_g = (const float*)d_in[8]; a.lstm_g = (const float*)d_in[9]; a.w_out = (const float*)d_in[10]; a.ln1_g = (const float*)d_in[11]; a.ln1_b = (const float*)d_in[12];
    a.w_gu = (const float*)d_in[13]; a.conv_w = (const float*)d_in[14]; a.conv_b = (const float*)d_in[15]; a.w_down = (const float*)d_in[16]; a.ln2_g = (const float*)d_in[17]; a.ln2_b = (const float*)d_in[18];
    a.out = (float*)d_out; a.ws = (unsigned char*)d_ws;
#if MK_MULTI
    for (int ph = 0; ph < NPHASE; ++ph) { a.ph_lo = ph; a.ph_hi = ph + 1; hipLaunchKernelGGL(fwd, dim3(grid), dim3(512), LDS_BYTES, stream, a); }
#else
    a.ph_lo = 0; a.ph_hi = NPHASE;
    void* kargs[] = {&a};
    hipError_t e = hipLaunchCooperativeKernel((const void*)fwd, dim3(grid), dim3(512), kargs, LDS_BYTES, stream);
    if (e != hipSuccess) fprintf(stderr, "kernel_launch: cooperative launch failed: %s (grid %d)\n", hipGetErrorString(e), grid);
#endif
}
```

```cpp
#include <hip/hip_runtime.h>
#include <hip/hip_cooperative_groups.h>
#include <cstdio>
#include <cstdint>
namespace cg = cooperative_groups;

#ifndef PHMASK
#define PHMASK 0xffff
#endif
#ifndef MK_MULTI
#define MK_MULTI 0
#endif

#define LAS __attribute__((address_space(3)))
typedef unsigned short bf16_t;
typedef short bf16x8 __attribute__((ext_vector_type(8)));
typedef short s16x4 __attribute__((ext_vector_type(4)));
typedef float f32x2 __attribute__((ext_vector_type(2)));
typedef float f32x4 __attribute__((ext_vector_type(4)));
typedef float f32x8 __attribute__((ext_vector_type(8)));
typedef float f32x16 __attribute__((ext_vector_type(16)));
typedef unsigned u32x2 __attribute__((ext_vector_type(2)));
typedef unsigned u32x4 __attribute__((ext_vector_type(4)));

constexpr int DM = 1024, NPROJ = 3072, NPROJ_PAD = 3328, NIN = 3088, DFF = 2816, NGU = 5632;
constexpr int MT = 65536;
constexpr float ALPHA = 1.4142135623730951f, EPS = 1e-5f;
constexpr int LDS_BYTES = 147456;
constexpr int EPI_LDS = 131072;

constexpr size_t MiB = 1u << 20;
constexpr size_t WS_CTL = 0, CTL_BYTES = 1 * MiB;
constexpr size_t CTL_FLAG = 40960;
constexpr size_t CTL_KMAX = 32768;
constexpr size_t CTL_C1IN = 65536, CTL_C2IN = 81920, CTL_C1GU = 98304, CTL_C2GU = 147456;
constexpr size_t WS_LAM = 1 * MiB;
constexpr size_t WS_WIN = 2 * MiB, WS_WOUT = 15 * MiB, WS_WGU = 19 * MiB, WS_WDN = 41 * MiB;
constexpr size_t WS_ST1 = 52 * MiB, WS_ST2 = 54 * MiB, WS_GATES = 56 * MiB, WS_EDGE = 60 * MiB;
constexpr size_t WS_XB = 80 * MiB, WS_MIXED = 208 * MiB, WS_PROJ = 336 * MiB, WS_HDIR = 720 * MiB, WS_END = 848 * MiB;

__device__ __forceinline__ unsigned cvt_pk_bf16(float lo, float hi) { unsigned r; asm volatile("v_cvt_pk_bf16_f32 %0, %1, %2" : "=v"(r) : "v"(lo), "v"(hi)); return r; }
__device__ __forceinline__ float bf2f(bf16_t b) { return __uint_as_float(((unsigned)b) << 16); }
__device__ __forceinline__ bf16_t f2bf(float f) { return (bf16_t)(cvt_pk_bf16(f, 0.f) & 0xffffu); }
__device__ __forceinline__ float gelu_erf(float v) {
    const float av = fabsf(v), t = __builtin_amdgcn_rcpf(av * 0.2316418882f + 1.0f);
    float q = t * 0.5307027145f + (-0.7265760135f); q = q * t + 0.7107068705f; q = q * t + (-0.142248368f); q = q * t + 0.127414796f; q = q * t;
    const float e = __builtin_amdgcn_exp2f((v * v) * (-0.72134752044f));
    const float m = v * (q * e);
    return v < 0.f ? m : v - m;
}
__device__ __forceinline__ int crow(int r, int hi) { return (r & 3) + 8 * (r >> 2) + 4 * hi; }
#define EPI_BAR() do { asm volatile("s_waitcnt lgkmcnt(0)" ::: "memory"); __builtin_amdgcn_s_barrier(); asm volatile("" ::: "memory"); } while (0)
#define SBAR() __builtin_amdgcn_sched_barrier(0)
__device__ __forceinline__ int opaque_tid() { int t = threadIdx.x; asm volatile("" : "+v"(t)); return t; }

namespace pg8 {
constexpr int BM = 256, BK = 64, HALF = 128, HTB = HALF * BK * 2, STAGE_BYTES = 8 * HTB, NXCD = 8, WGM = 8;
__host__ __device__ __forceinline__ int lds_byte(int r, int c) { const int st = (r >> 4) * 2 + (c >> 5), rr = r & 15, cc = c & 31, ob = rr * 64 + cc * 2; return st * 1024 + (ob ^ (((ob >> 9) & 1) << 5)); }
__host__ __device__ __forceinline__ void stage_rc(int b, int& R, int& C) { const int st = b / 1024, sb = b % 1024, swz = sb ^ (((sb >> 9) & 1) << 5); R = (st >> 1) * 16 + swz / 64; C = (st & 1) * 32 + (swz % 64) / 2; }
__host__ __device__ __forceinline__ int perm32(int rho) { const int n = rho >> 4, i = rho & 15; return 8 * (i >> 2) + 4 * n + (i & 3); }
struct Unit { int pm, pn; };
struct Gemm { const bf16_t* A; const bf16_t* Bt; int M, N, K; };
struct StaticOrder {
    int nM, nN, nwg, G, c;
    __host__ __device__ void init(int M, int N, int G_, int c_) { nM = M / BM; nN = N / BM; nwg = nM * nN; G = G_; c = c_; }
    __host__ __device__ bool next(int i, Unit& u) const {
        const long L = (long)i * G + c; if (L >= nwg) return false;
        int wgid = (int)L; { const int q = nwg / NXCD, r = nwg % NXCD, xcd = wgid % NXCD, off = wgid / NXCD; wgid = (xcd < r ? xcd * (q + 1) : r * (q + 1) + (xcd - r) * q) + off; }
        const int nig = WGM * nN, gid = wgid / nig, fm = gid * WGM, gsz = (nM - fm) < WGM ? (nM - fm) : WGM;
        u.pm = fm + ((wgid % nig) % gsz); u.pn = (wgid % nig) / gsz; return true;
    }
    __device__ __forceinline__ void a_ready(const Unit&) const {}
    __device__ __forceinline__ void done(const Unit&) const {}
};

template <class Epi, class Sched>
__device__ __forceinline__ void gemm_phase(LAS unsigned char* lds, const Gemm g, const Sched& S, const Epi& E) {
    const int tid = opaque_tid(), wid = __builtin_amdgcn_readfirstlane(tid >> 6), lane = tid & 63, wr = wid >> 2, wc = wid & 3, fr = lane & 15, fq = lane >> 4;
    const int K = g.K, nt = K / BK;
    unsigned voffA[2], voffB[2];
#pragma unroll
    for (int i = 0; i < 2; ++i) { int R, C; stage_rc(tid * 16 + i * 8192, R, C); const int Rb = Epi::PERM ? ((R & ~31) + perm32(R & 31)) : R;
        voffA[i] = (unsigned)(R * K + C) * 2u; voffB[i] = (unsigned)(Rb * K + C) * 2u; }
    const size_t kstep = (size_t)(BK * 2);
    const size_t hstep = (size_t)HALF * K * 2;
    const size_t tstep = 2 * hstep;
    const unsigned ldsw = (unsigned)wid * 1024u;
    const int aoff = lds_byte(wr * 64 + fr, fq * 8), boff = lds_byte(wc * 32 + fr, fq * 8);
#define PG8_SA(b, h) (((b) * 2 + (h)) * HTB)
#define PG8_SB(b, h) ((4 + (b) * 2 + (h)) * HTB)
#define PG8_STAGE(bufoff, gbase, voff) do { _Pragma("unroll") for (int _i = 0; _i < 2; ++_i) \
        __builtin_amdgcn_global_load_lds((const unsigned*)((const char*)(gbase) + (voff)[_i]), (LAS unsigned*)(lds + (bufoff) + ldsw + _i * 8192), 16, 0, 0); } while (0)
#define PG8_LDA(dst, b, h) do { _Pragma("unroll") for (int m = 0; m < 4; ++m) _Pragma("unroll") for (int k = 0; k < 2; ++k) dst[m][k] = *(const LAS bf16x8*)(lds + PG8_SA(b, h) + aoff + m * 2048 + k * 1024); } while (0)
#define PG8_LDB(dst, b, h) do { _Pragma("unroll") for (int n = 0; n < 2; ++n) _Pragma("unroll") for (int k = 0; k < 2; ++k) dst[n][k] = *(const LAS bf16x8*)(lds + PG8_SB(b, h) + boff + n * 2048 + k * 1024); } while (0)
#define PG8_MMA(ai, bj, At, Bt) do { __builtin_amdgcn_s_setprio(1); _Pragma("unroll") for (int m = 0; m < 4; ++m) _Pragma("unroll") for (int n = 0; n < 2; ++n) _Pragma("unroll") for (int k = 0; k < 2; ++k) \
        acc[ai][bj][m][n] = __builtin_amdgcn_mfma_f32_16x16x32_bf16(Bt[n][k], At[m][k], acc[ai][bj][m][n], 0, 0, 0); __builtin_amdgcn_s_setprio(0); } while (0)
#define PG8_WAIT_V(n) asm volatile("s_waitcnt vmcnt(" #n ")" ::: "memory")
#define PG8_WAIT_L(n) asm volatile("s_waitcnt lgkmcnt(" #n ")" ::: "memory")
#define PG8_BAR __builtin_amdgcn_s_barrier()
#define PG8_SCHED __builtin_amdgcn_sched_barrier(0)
    Unit cur, nxt; int ui = 0;
    if (!S.next(0, cur)) return;
    f32x4 acc[2][2][4][2];
#pragma unroll
    for (int a = 0; a < 2; ++a)
#pragma unroll
        for (int b = 0; b < 2; ++b)
#pragma unroll
            for (int m = 0; m < 4; ++m)
#pragma unroll
                for (int n = 0; n < 2; ++n) acc[a][b][m][n] = (f32x4){0.f, 0.f, 0.f, 0.f};
    bf16x8 At[4][2], B0[2][2], B1[2][2];
    const char* cA = (const char*)g.A + (size_t)cur.pm * tstep; const char* cB = (const char*)g.Bt + (size_t)cur.pn * tstep;
    PG8_STAGE(PG8_SB(0, 0), cB, voffB); PG8_STAGE(PG8_SB(0, 1), cB + hstep, voffB); PG8_STAGE(PG8_SA(0, 0), cA, voffA); PG8_STAGE(PG8_SA(0, 1), cA + hstep, voffA);
    if (wr == 1) PG8_BAR;
    PG8_WAIT_V(2); PG8_BAR;
    PG8_STAGE(PG8_SB(1, 0), cB + kstep, voffB); PG8_STAGE(PG8_SA(1, 0), cA + kstep, voffA); PG8_STAGE(PG8_SB(1, 1), cB + hstep + kstep, voffB);
    PG8_WAIT_V(6); PG8_BAR;
    for (;;) {
        const bool has_next = S.next(ui + 1, nxt);
        const char* nA = has_next ? (const char*)g.A + (size_t)nxt.pm * tstep : cA; const char* nB = has_next ? (const char*)g.Bt + (size_t)nxt.pn * tstep : cB;
        for (int t = 0; t < nt; t += 2) {
            const bool last = (t == nt - 2);
            const char* a1 = cA + (size_t)(t + 1) * kstep;
            const char* a2 = last ? nA : cA + (size_t)(t + 2) * kstep; const char* b2 = last ? nB : cB + (size_t)(t + 2) * kstep;
            const char* a3 = a2 + kstep; const char* b3 = b2 + kstep;
            PG8_LDB(B0, 0, 0); PG8_LDB(B1, 0, 1); PG8_SCHED; PG8_LDA(At, 0, 0); PG8_STAGE(PG8_SA(1, 1), a1 + hstep, voffA);
            PG8_WAIT_V(8); PG8_WAIT_L(0); PG8_BAR; PG8_MMA(0, 0, At, B0); PG8_MMA(0, 1, At, B1); PG8_BAR; PG8_SCHED;
            PG8_LDA(At, 0, 1); PG8_STAGE(PG8_SB(0, 0), b2, voffB); PG8_STAGE(PG8_SB(0, 1), b2 + hstep, voffB); PG8_STAGE(PG8_SA(0, 0), a2, voffA);
            PG8_WAIT_V(8); PG8_WAIT_L(0); PG8_BAR; PG8_MMA(1, 0, At, B0); PG8_MMA(1, 1, At, B1); PG8_BAR; PG8_SCHED;
            PG8_LDB(B0, 1, 0); PG8_LDB(B1, 1, 1); PG8_SCHED; PG8_LDA(At, 1, 0); PG8_STAGE(PG8_SA(0, 1), a2 + hstep, voffA);
            PG8_WAIT_V(8); PG8_WAIT_L(0); PG8_BAR; PG8_MMA(0, 0, At, B0); PG8_MMA(0, 1, At, B1); PG8_BAR; PG8_SCHED;
            PG8_LDA(At, 1, 1); PG8_STAGE(PG8_SB(1, 0), b3, voffB); PG8_STAGE(PG8_SB(1, 1), b3 + hstep, voffB); PG8_STAGE(PG8_SA(1, 0), a3, voffA);
            PG8_WAIT_V(8); PG8_WAIT_L(0); PG8_BAR; PG8_MMA(1, 0, At, B0); PG8_MMA(1, 1, At, B1); PG8_BAR; PG8_SCHED;
        }
        if (wr == 0) PG8_BAR;
        E(acc, cur, wr, wc, fr, fq);
        if (!has_next) break;
#pragma unroll
        for (int a = 0; a < 2; ++a)
#pragma unroll
            for (int b = 0; b < 2; ++b)
#pragma unroll
                for (int m = 0; m < 4; ++m)
#pragma unroll
                    for (int n = 0; n < 2; ++n) acc[a][b][m][n] = (f32x4){0.f, 0.f, 0.f, 0.f};
        cur = nxt; cA = nA; cB = nB; ++ui;
        if (wr == 1) PG8_BAR;
    }
    PG8_WAIT_V(0);
    PG8_BAR;
#undef PG8_SA
#undef PG8_SB
#undef PG8_STAGE
#undef PG8_LDA
#undef PG8_LDB
#undef PG8_MMA
#undef PG8_WAIT_V
#undef PG8_WAIT_L
#undef PG8_BAR
#undef PG8_SCHED
}
}

__device__ __forceinline__ void row_stats(const f32x2* st, int row, float& mu, float& rstd) {
    const f32x4 a = *(const f32x4*)(st + (size_t)row * 4), b = *(const f32x4*)(st + (size_t)row * 4 + 2);
    const float s = (a[0] + a[2]) + (b[0] + b[2]), q = (a[1] + a[3]) + (b[1] + b[3]);
    mu = s * (1.f / 1024.f); const float var = fmaxf(q * (1.f / 1024.f) - mu * mu, 0.f); rstd = rsqrtf(var + EPS);
}

__device__ __forceinline__ void tile_stats_to_lds(const f32x2* st, int row0, LAS f32x2* S, int tid) {
    if (tid < 256) { float mu, rstd; row_stats(st, row0 + tid, mu, rstd); S[tid] = (f32x2){mu, rstd}; }
    EPI_BAR();
}
struct EpiProj {
    static constexpr bool PERM = true;
    bf16_t* O; float* gates; const float* gate_bias; const f32x2* stats; const float* c1; const float* c2; LAS f32x2* S;
    __device__ __forceinline__ void operator()(f32x4 (&acc)[2][2][4][2], const pg8::Unit& u, int wr, int wc, int fr, int fq) const {
        asm volatile("" : "+v"(fr), "+v"(fq));
        const int colt = u.pn * 256 + wc * 32 + 8 * fq;
        if (stats) tile_stats_to_lds(stats, u.pm * 256, S, (wr * 4 + wc) * 64 + fq * 16 + fr);
        f32x4 c1v[2][2], c2v[2][2];
#pragma unroll
        for (int bj = 0; bj < 2; ++bj)
#pragma unroll
            for (int n = 0; n < 2; ++n) {
                if (stats) { c1v[bj][n] = *(const f32x4*)(c1 + colt + bj * 128 + 4 * n); c2v[bj][n] = *(const f32x4*)(c2 + colt + bj * 128 + 4 * n); }
                else { c1v[bj][n] = (f32x4){0.f, 0.f, 0.f, 0.f}; c2v[bj][n] = (f32x4){0.f, 0.f, 0.f, 0.f}; } }
        const float sc = (u.pn < 2 || u.pn == 7) ? 0.125f : 1.0f;
#pragma unroll
        for (int ai = 0; ai < 2; ++ai)
#pragma unroll
            for (int m = 0; m < 4; ++m) {
                const int row = u.pm * 256 + ai * 128 + wr * 64 + m * 16 + fr;
                float mu = 0.f, rstd = 1.f; if (stats) { const f32x2 sr = S[ai * 128 + wr * 64 + m * 16 + fr]; mu = sr.x; rstd = sr.y; }
                if (u.pn < 12) {
#pragma unroll
                    for (int bj = 0; bj < 2; ++bj) {
                        const f32x4 v0 = ((acc[ai][bj][m][0] - mu * c1v[bj][0]) * rstd + c2v[bj][0]) * sc, v1 = ((acc[ai][bj][m][1] - mu * c1v[bj][1]) * rstd + c2v[bj][1]) * sc;
                        u32x4 w; w.x = cvt_pk_bf16(v0[0], v0[1]); w.y = cvt_pk_bf16(v0[2], v0[3]); w.z = cvt_pk_bf16(v1[0], v1[1]); w.w = cvt_pk_bf16(v1[2], v1[3]);
                        *(u32x4*)(O + (size_t)row * NPROJ + colt + bj * 128) = w; }
                } else if (wc == 0 && fq < 2) {
#pragma unroll
                    for (int n = 0; n < 2; ++n) {
                        const f32x4 gb = *(const f32x4*)(gate_bias + 8 * fq + 4 * n);
                        *(f32x4*)(gates + (size_t)row * 16 + 8 * fq + 4 * n) = (acc[ai][0][m][n] - mu * c1v[0][n]) * rstd + c2v[0][n] + gb; }
                }
            }
    }
};

struct EpiRes {
    static constexpr bool PERM = false;
    const float* xin; float* v; const f32x2* st_in; const float* g_in; const float* b_in; f32x2* st_out; bf16_t* xb; LAS f32x2* P; LAS f32x2* S;
    __device__ __forceinline__ void operator()(f32x4 (&acc)[2][2][4][2], const pg8::Unit& u, int wr, int wc, int fr, int fq) const {
        asm volatile("" : "+v"(fr), "+v"(fq));
        const int colb = u.pn * 256 + wc * 32 + 4 * fq;
        if (!xin) tile_stats_to_lds(st_in, u.pm * 256, S, (wr * 4 + wc) * 64 + fq * 16 + fr);
        f32x4 gv[2][2], bv[2][2];
#pragma unroll
        for (int bj = 0; bj < 2; ++bj)
#pragma unroll
            for (int n = 0; n < 2; ++n) {
                if (!xin) { gv[bj][n] = *(const f32x4*)(g_in + colb + bj * 128 + n * 16); bv[bj][n] = *(const f32x4*)(b_in + colb + bj * 128 + n * 16); }
                else { gv[bj][n] = (f32x4){1.f, 1.f, 1.f, 1.f}; bv[bj][n] = (f32x4){0.f, 0.f, 0.f, 0.f}; } }
#pragma unroll
        for (int ai = 0; ai < 2; ++ai)
#pragma unroll
            for (int m = 0; m < 4; ++m) {
                const int rl = ai * 128 + wr * 64 + m * 16 + fr; const int row = u.pm * 256 + rl;
                float mu = 0.f, rstd = 1.f; if (!xin) { const f32x2 sr = S[rl]; mu = sr.x; rstd = sr.y; }
                const float* src = xin ? xin : v;
                float s = 0.f, q = 0.f;
#pragma unroll
                for (int bj = 0; bj < 2; ++bj)
#pragma unroll
                    for (int n = 0; n < 2; ++n) {
                        const size_t off = (size_t)row * DM + colb + bj * 128 + n * 16;
                        const f32x4 xv = *(const f32x4*)(src + off);
                        const f32x4 xp = (xv - mu) * rstd * gv[bj][n] + bv[bj][n];
                        const f32x4 o = xp * ALPHA + acc[ai][bj][m][n];
                        *(f32x4*)(v + off) = o;
                        if (xb) { u32x2 w; w.x = cvt_pk_bf16(o[0], o[1]); w.y = cvt_pk_bf16(o[2], o[3]); *(u32x2*)(xb + off) = w; }
                        s += (o[0] + o[1]) + (o[2] + o[3]); q += (o[0] * o[0] + o[1] * o[1]) + (o[2] * o[2] + o[3] * o[3]);
                    }
                s += __shfl_xor(s, 16); s += __shfl_xor(s, 32); q += __shfl_xor(q, 16); q += __shfl_xor(q, 32);
                if (fq == 0) P[rl * 4 + wc] = (f32x2){s, q};
            }
        EPI_BAR();
        const int tid = (wr * 4 + wc) * 64 + fq * 16 + fr;
        if (tid < 256) {
            const f32x2 a = P[tid * 4 + 0], b = P[tid * 4 + 1], c = P[tid * 4 + 2], d = P[tid * 4 + 3];
            st_out[(size_t)(u.pm * 256 + tid) * 4 + u.pn] = (f32x2){(a.x + b.x) + (c.x + d.x), (a.y + b.y) + (c.y + d.y)};
        }
    }
};

struct EpiGU {
    static constexpr bool PERM = false;
    bf16_t* hmid; float* edge; const f32x2* stats; const float* c1; const float* c2; const float* cw; const float* cb; LAS float* halo; LAS f32x2* S;
    __device__ __forceinline__ void operator()(f32x4 (&acc)[2][2][4][2], const pg8::Unit& u, int wr, int wc, int fr, int fq) const {
        asm volatile("" : "+v"(fr), "+v"(fq));
        const int colb = wc * 32 + 4 * fq; const int lane = fq * 16 + fr;
        const int jch0 = u.pn * 128 + colb;
        tile_stats_to_lds(stats, u.pm * 256, S, (wr * 4 + wc) * 64 + lane);
        u32x2 gk[2][4][2], uk[2][4][2];
        {
            f32x4 c1v[2][2], c2v[2][2];
#pragma unroll
            for (int bj = 0; bj < 2; ++bj)
#pragma unroll
                for (int n = 0; n < 2; ++n) { c1v[bj][n] = *(const f32x4*)(c1 + u.pn * 256 + bj * 128 + colb + 16 * n); c2v[bj][n] = *(const f32x4*)(c2 + u.pn * 256 + bj * 128 + colb + 16 * n); }
#pragma unroll
            for (int ai = 0; ai < 2; ++ai)
#pragma unroll
                for (int m = 0; m < 4; ++m) {
                    const f32x2 sr = S[ai * 128 + wr * 64 + m * 16 + fr]; const float mu = sr.x, rstd = sr.y;
                    const int blk = ai * 2 + wr;
#pragma unroll
                    for (int n = 0; n < 2; ++n) {
                        const f32x4 gv = (acc[ai][0][m][n] - mu * c1v[0][n]) * rstd + c2v[0][n];
                        const f32x4 uv = (acc[ai][1][m][n] - mu * c1v[1][n]) * rstd + c2v[1][n];
                        gk[ai][m][n].x = cvt_pk_bf16(gv[0], gv[1]); gk[ai][m][n].y = cvt_pk_bf16(gv[2], gv[3]);
                        uk[ai][m][n].x = cvt_pk_bf16(uv[0], uv[1]); uk[ai][m][n].y = cvt_pk_bf16(uv[2], uv[3]);
                        if (m == 0) {
                            if (fr == 0) *(LAS u32x2*)(halo + (blk * 2 + 0) * 128 + (colb + 16 * n) / 2) = gk[ai][m][n];
                            if (ai == 0 && wr == 0 && fr <= 1) *(f32x4*)(edge + ((size_t)u.pm * 6 + fr) * DFF + jch0 + 16 * n) = gv;
                            if (ai == 0 && wr == 0 && fr == 0) *(f32x4*)(edge + ((size_t)u.pm * 6 + 4) * DFF + jch0 + 16 * n) = uv;
                        }
                        if (m == 3) {
                            if (fr == 15) *(LAS u32x2*)(halo + (blk * 2 + 1) * 128 + (colb + 16 * n) / 2) = gk[ai][m][n];
                            if (ai == 1 && wr == 1 && fr >= 14) *(f32x4*)(edge + ((size_t)u.pm * 6 + 2 + (fr - 14)) * DFF + jch0 + 16 * n) = gv;
                            if (ai == 1 && wr == 1 && fr == 15) *(f32x4*)(edge + ((size_t)u.pm * 6 + 5) * DFF + jch0 + 16 * n) = uv;
                        }
                    }
                    SBAR();
                }
        }
        EPI_BAR(); SBAR();
#define BLO(x) __uint_as_float((x) << 16)
#define BHI(x) __uint_as_float((x) & 0xffff0000u)
#pragma unroll
        for (int n = 0; n < 2; ++n) {
            const f32x4 w0 = *(const f32x4*)(cw + jch0 + 16 * n), w1 = *(const f32x4*)(cw + DFF + jch0 + 16 * n), w2 = *(const f32x4*)(cw + 2 * DFF + jch0 + 16 * n), cbv = *(const f32x4*)(cb + jch0 + 16 * n);
#pragma unroll
            for (int ai = 0; ai < 2; ++ai) {
                const int blk = ai * 2 + wr;
                u32x2 top = (u32x2){0u, 0u}, bot = (u32x2){0u, 0u};
                if (blk > 0) top = *(const LAS u32x2*)(halo + ((blk - 1) * 2 + 1) * 128 + (colb + 16 * n) / 2);
                if (blk < 3) bot = *(const LAS u32x2*)(halo + ((blk + 1) * 2 + 0) * 128 + (colb + 16 * n) / 2);
                u32x2 hk[4];
#pragma unroll
                for (int w = 0; w < 2; ++w) {
                    unsigned a_[4], b_[4], c_[4], d_[4];
#pragma unroll
                    for (int m = 0; m < 4; ++m) { const unsigned gv = gk[ai][m][n][w];
                        a_[m] = (unsigned)__shfl((int)gv, (lane - 1) & 63); b_[m] = (unsigned)__shfl((int)gv, (lane + 15) & 63);
                        c_[m] = (unsigned)__shfl((int)gv, (lane + 1) & 63); d_[m] = (unsigned)__shfl((int)gv, (lane - 15) & 63); }
#pragma unroll
                    for (int m = 0; m < 4; ++m) {
                        const unsigned prev = (fr > 0) ? a_[m] : (m > 0 ? b_[m > 0 ? m - 1 : 0] : top[w]);
                        const unsigned next = (fr < 15) ? c_[m] : (m < 3 ? d_[m < 3 ? m + 1 : 3] : bot[w]);
                        const unsigned cur = gk[ai][m][n][w], upw = uk[ai][m][n][w];
                        const float cv0 = cbv[2 * w] + w0[2 * w] * BLO(prev) + w1[2 * w] * BLO(cur) + w2[2 * w] * BLO(next);
                        const float cv1 = cbv[2 * w + 1] + w0[2 * w + 1] * BHI(prev) + w1[2 * w + 1] * BHI(cur) + w2[2 * w + 1] * BHI(next);
                        hk[m][w] = cvt_pk_bf16(gelu_erf(cv0) * BLO(upw), gelu_erf(cv1) * BHI(upw));
                    }
                    SBAR();
                }
#pragma unroll
                for (int m = 0; m < 4; ++m) {
                    const int rl = ai * 128 + wr * 64 + m * 16 + fr;
                    if (rl != 0 && rl != 255) *(u32x2*)(hmid + (size_t)(u.pm * 256 + rl) * DFF + jch0 + 16 * n) = hk[m];
                }
                SBAR();
            }
        }
#undef BLO
#undef BHI
    }
};

namespace att {
constexpr int KVBLK = 64, SHM_V = 16384, SHM_K = 16384, WS_OFF = 73728, OB_PITCH = 132;
constexpr float THR = 8.f;
#define KSWZ(row, colB) ((row) * 256 + ((colB) ^ (((row) & 7) << 4)))
__device__ __forceinline__ void alibi(f32x16& p0, f32x16& p1, float t0, float nslope) {
#pragma unroll
    for (int r = 0; r < 16; ++r) { const float kr = (float)((r & 3) + 8 * (r >> 2));
        p0[r] = fmaf(nslope, fabsf(t0 - kr), p0[r]); p1[r] = fmaf(nslope, fabsf(t0 - kr - 32.f), p1[r]); }
}
__device__ __forceinline__ void partialSM(f32x16& p0, f32x16& p1, float& m_reg, float& mn, float& alpha) {
    constexpr float C = 1.4426950408889634f;
    float pmax = p0[0];
#pragma unroll
    for (int r = 1; r < 16; ++r) pmax = fmaxf(pmax, p0[r]);
#pragma unroll
    for (int r = 0; r < 16; ++r) pmax = fmaxf(pmax, p1[r]);
    { auto rr = __builtin_amdgcn_permlane32_swap(__float_as_uint(pmax), __float_as_uint(pmax), false, false);
      pmax = fmaxf(__uint_as_float(rr[0]), __uint_as_float(rr[1])); }
    if (__builtin_expect(__all(pmax - m_reg <= THR), 1)) { mn = m_reg; alpha = 1.f; }
    else { mn = fmaxf(m_reg, pmax); alpha = __builtin_amdgcn_exp2f((m_reg - mn) * C); m_reg = mn; }
    const float mnC = -mn * C;
#pragma unroll
    for (int r = 0; r < 16; ++r) p0[r] = fmaf(p0[r], C, mnC);
#pragma unroll
    for (int r = 0; r < 16; ++r) p1[r] = fmaf(p1[r], C, mnC);
#pragma unroll
    for (int r = 0; r < 16; ++r) p0[r] = __builtin_amdgcn_exp2f(p0[r]);
}
__device__ __forceinline__ void finishSM(f32x16& p0, f32x16& p1, float alpha, float& l_reg, bf16x8& pa0, bf16x8& pa1, bf16x8& pa2, bf16x8& pa3) {
#pragma unroll
    for (int r = 0; r < 16; ++r) p1[r] = __builtin_amdgcn_exp2f(p1[r]);
    float ps = 0;
#pragma unroll
    for (int r = 0; r < 16; ++r) ps += p0[r];
#pragma unroll
    for (int r = 0; r < 16; ++r) ps += p1[r];
    { auto rr = __builtin_amdgcn_permlane32_swap(__float_as_uint(ps), __float_as_uint(ps), false, false);
      ps = __uint_as_float(rr[0]) + __uint_as_float(rr[1]); }
    l_reg = l_reg * alpha + ps;
#define PK4(P, BASE, OUT) do { unsigned a0 = cvt_pk_bf16(P[BASE + 0], P[BASE + 1]), a1 = cvt_pk_bf16(P[BASE + 2], P[BASE + 3]);   \
    unsigned b0 = cvt_pk_bf16(P[BASE + 4], P[BASE + 5]), b1 = cvt_pk_bf16(P[BASE + 6], P[BASE + 7]);                              \
    auto r0 = __builtin_amdgcn_permlane32_swap(a0, b0, false, false); auto r1 = __builtin_amdgcn_permlane32_swap(a1, b1, false, false); \
    u32x4 w = {r0[0], r1[0], r0[1], r1[1]}; OUT = *reinterpret_cast<bf16x8*>(&w); } while (0)
    PK4(p0, 0, pa0); PK4(p0, 8, pa1); PK4(p1, 0, pa2); PK4(p1, 8, pa3);
#undef PK4
}
__device__ __forceinline__ void qkt(f32x16& p0, f32x16& p1, const LAS char* Ks, const bf16x8* qr, int r32, int hi, int c) {
    p0 = f32x16{}; p1 = f32x16{};
#pragma unroll
    for (int d0 = 0; d0 < 4; ++d0) { const int cb = ((c * 4 + d0) * 16 + hi * 8) * 2;
        const bf16x8 b0 = *reinterpret_cast<const LAS bf16x8*>(Ks + KSWZ(r32, cb));
        const bf16x8 b1 = *reinterpret_cast<const LAS bf16x8*>(Ks + KSWZ(32 + r32, cb));
        p0 = __builtin_amdgcn_mfma_f32_32x32x16_bf16(b0, qr[d0], p0, 0, 0, 0);
        p1 = __builtin_amdgcn_mfma_f32_32x32x16_bf16(b1, qr[d0], p1, 0, 0, 0); }
}
__device__ __forceinline__ int v_st(int k, int c) { const int kk = (k & ~0xC) | ((k & 4) << 1) | ((k & 8) >> 1); return ((kk >> 3) * 4 + (c >> 5)) * 512 + ((kk & 7) * 32 + (c & 31)) * 2; }
__device__ __forceinline__ int v_rd_base(int lane) { return ((lane & 3) << 3) | (((lane >> 2) & 3) << 6) | (((lane >> 4) & 1) << 5) | (((lane >> 5) & 1) << 8); }
constexpr int v_rd_off(int d0, int ks, int half) { return d0 * 512 + ks * 4096 + half * 2048; }
template <int OFF> __device__ __forceinline__ s16x4 tr_read(int vb) {
    s16x4 r; asm volatile("ds_read_b64_tr_b16 %0, %1 offset:%2" : "=&v"(r) : "v"(vb), "i"(OFF) : "memory"); return r;
}
template <int D0> __device__ __forceinline__ void pv_one(f32x16& od, int vb, bf16x8 pa0, bf16x8 pa1, bf16x8 pa2, bf16x8 pa3) {
    const s16x4 l0 = tr_read<v_rd_off(D0, 0, 0)>(vb), h0 = tr_read<v_rd_off(D0, 0, 1)>(vb), l1 = tr_read<v_rd_off(D0, 1, 0)>(vb), h1 = tr_read<v_rd_off(D0, 1, 1)>(vb);
    const s16x4 l2 = tr_read<v_rd_off(D0, 2, 0)>(vb), h2 = tr_read<v_rd_off(D0, 2, 1)>(vb), l3 = tr_read<v_rd_off(D0, 3, 0)>(vb), h3 = tr_read<v_rd_off(D0, 3, 1)>(vb);
    asm volatile("s_waitcnt lgkmcnt(0)" ::: "memory"); SBAR();
#define PK(L, H) (bf16x8){L[0], L[1], L[2], L[3], H[0], H[1], H[2], H[3]}
    od = __builtin_amdgcn_mfma_f32_32x32x16_bf16(pa0, PK(l0, h0), od, 0, 0, 0);
    od = __builtin_amdgcn_mfma_f32_32x32x16_bf16(pa1, PK(l1, h1), od, 0, 0, 0);
    od = __builtin_amdgcn_mfma_f32_32x32x16_bf16(pa2, PK(l2, h2), od, 0, 0, 0);
    od = __builtin_amdgcn_mfma_f32_32x32x16_bf16(pa3, PK(l3, h3), od, 0, 0, 0);
#undef PK
}
__device__ __forceinline__ void pv_d0(f32x16* o, int vb, bf16x8 pa0, bf16x8 pa1, bf16x8 pa2, bf16x8 pa3) {
    pv_one<0>(o[0], vb, pa0, pa1, pa2, pa3); pv_one<1>(o[1], vb, pa0, pa1, pa2, pa3); pv_one<2>(o[2], vb, pa0, pa1, pa2, pa3); pv_one<3>(o[3], vb, pa0, pa1, pa2, pa3);
}

__device__ __forceinline__ void attn_unit(const bf16_t* __restrict__ proj, bf16_t* __restrict__ mixed, const float* __restrict__ att_g,
                                          int seq, long row0, int h, int qb, float lam, float nslope, float oscale, float kmax2, LAS char* lds) {
    const int tid = opaque_tid(), wid = tid >> 6, lane = tid & 63, r32 = lane & 31, hi = lane >> 5, c = wid >> 2, wq = wid & 3;
    LAS char* V_lds = lds; LAS char* K_lds = lds + 2 * SHM_V;
    LAS float* ws = (LAS float*)(lds + WS_OFF) + wid * 64; LAS float* li_l = ws; LAS float* al_l = ws + 32;
    float m_reg = -1e30f, l_reg = 0; f32x16 o[4] = {}; bf16x8 qr[4];
    const int qrow = qb * 128 + wq * 32 + r32;
    const bf16_t* Qw = proj + (size_t)(row0 + qrow) * NPROJ + h * 128 + c * 64 + hi * 8;
#pragma unroll
    for (int d0 = 0; d0 < 4; ++d0) qr[d0] = *reinterpret_cast<const bf16x8*>(Qw + d0 * 16);
    int tlo, NT;
    {
        float qs = 0.f;
#pragma unroll
        for (int d0 = 0; d0 < 4; ++d0)
#pragma unroll
            for (int e = 0; e < 8; ++e) { const float qv = bf2f((bf16_t)qr[d0][e]); qs += qv * qv; }
        qs += __shfl_xor(qs, 32);
#pragma unroll
        for (int o = 1; o < 32; o <<= 1) qs = fmaxf(qs, __shfl_xor(qs, o));
        if (lane == 0) ws[0] = qs;
        __syncthreads();
        float qm = 0.f;
#pragma unroll
        for (int w = 0; w < 8; ++w) qm = fmaxf(qm, ((LAS float*)(lds + WS_OFF))[w * 64]);
        const float smax = sqrtf(qm * kmax2) * 1.01f + 1e-3f;
        const float dstar = (36.0f + 2.0f * smax) / (-nslope);
        const int ntall = seq / KVBLK;
        int lo = (int)floorf(((float)(qb * 128) - dstar) * (1.0f / 64.0f)), hi_t = (int)floorf(((float)(qb * 128 + 127) + dstar) * (1.0f / 64.0f));
        lo = lo < 0 ? 0 : lo; hi_t = hi_t > ntall - 1 ? ntall - 1 : hi_t;
        if (((hi_t - lo + 1) & 1) != 0) { if (hi_t < ntall - 1) ++hi_t; else --lo; }
        tlo = lo; NT = hi_t - lo + 1;
    }
    const bf16_t* Kh = proj + (size_t)(row0 + tlo * KVBLK) * NPROJ + 512 + h * 128; const bf16_t* Vh = proj + (size_t)(row0 + tlo * KVBLK) * NPROJ + 1024 + h * 128;
    const int sr = tid >> 4, sc = (tid & 15) * 8, vst0 = v_st(sr, sc), vst1 = v_st(32 + sr, sc);
    const int vb0 = (int)(uintptr_t)V_lds + v_rd_base(lane);
    const float qposf = (float)(qrow - 4 * hi - tlo * KVBLK);
    struct { bf16x8 vs0, vs1, ks0, ks1; } sr_[2];
#define SLOAD(i, k0) do { sr_[i].vs0 = *reinterpret_cast<const bf16x8*>(&Vh[(size_t)((k0) + sr) * NPROJ + sc]); sr_[i].vs1 = *reinterpret_cast<const bf16x8*>(&Vh[(size_t)((k0) + 32 + sr) * NPROJ + sc]); \
    sr_[i].ks0 = *reinterpret_cast<const bf16x8*>(&Kh[(size_t)((k0) + sr) * NPROJ + sc]); sr_[i].ks1 = *reinterpret_cast<const bf16x8*>(&Kh[(size_t)((k0) + 32 + sr) * NPROJ + sc]); } while (0)
#define SWRITE(b, i) do { *(LAS bf16x8*)(V_lds + (b) * SHM_V + vst0) = sr_[i].vs0;          \
    *(LAS bf16x8*)(V_lds + (b) * SHM_V + vst1) = sr_[i].vs1; const int kc = sc * 2;               \
    *(LAS bf16x8*)(K_lds + (b) * SHM_K + KSWZ(sr, kc)) = sr_[i].ks0;                       \
    *(LAS bf16x8*)(K_lds + (b) * SHM_K + KSWZ(32 + sr, kc)) = sr_[i].ks1; } while (0)
#define SWAIT() asm volatile("s_waitcnt vmcnt(4)" ::: "memory")
#define RESC(a) do { if (__any((a) < 1.f)) { if (hi == 0) al_l[r32] = (a); asm volatile("s_waitcnt lgkmcnt(0)" ::: "memory"); \
    for (int d = 0; d < 4; ++d) for (int r = 0; r < 16; ++r) o[d][r] *= al_l[crow(r, hi)]; } } while (0)
    f32x16 pA0, pA1, pB0, pB1; float mnA, mnB, alA, alB; bf16x8 pa0, pa1, pa2, pa3;
    constexpr int SE = 0, SO = 1;
    SLOAD(SE, 0); asm volatile("s_waitcnt vmcnt(0)" ::: "memory"); SWRITE(0, SE); __syncthreads();
    qkt(pA0, pA1, K_lds, qr, r32, hi, c); alibi(pA0, pA1, qposf, nslope); partialSM(pA0, pA1, m_reg, mnA, alA);
    SLOAD(SO, KVBLK); if (2 < NT) SLOAD(SE, 2 * KVBLK);
    SWAIT(); SWRITE(1, SO); __syncthreads();
    for (int j = 1; j + 1 < NT; j += 2) {
        SBAR(); qkt(pB0, pB1, K_lds + SHM_K, qr, r32, hi, c);
        finishSM(pA0, pA1, alA, l_reg, pa0, pa1, pa2, pa3); SBAR();
        SLOAD(SO, (j + 2) * KVBLK); SBAR();
        pv_d0(o, vb0, pa0, pa1, pa2, pa3); alibi(pB0, pB1, qposf - (float)(j * KVBLK), nslope); partialSM(pB0, pB1, m_reg, mnB, alB);
        __syncthreads(); SWAIT(); SWRITE(0, SE);
        RESC(alB); __syncthreads();
        SBAR(); qkt(pA0, pA1, K_lds, qr, r32, hi, c);
        finishSM(pB0, pB1, alB, l_reg, pa0, pa1, pa2, pa3); SBAR();
        if (j + 3 < NT) SLOAD(SE, (j + 3) * KVBLK); SBAR();
        pv_d0(o, vb0 + SHM_V, pa0, pa1, pa2, pa3); alibi(pA0, pA1, qposf - (float)((j + 1) * KVBLK), nslope); partialSM(pA0, pA1, m_reg, mnA, alA);
        __syncthreads(); SWAIT(); SWRITE(1, SO);
        RESC(alA); __syncthreads();
    }
    SBAR(); qkt(pB0, pB1, K_lds + SHM_K, qr, r32, hi, c);
    finishSM(pA0, pA1, alA, l_reg, pa0, pa1, pa2, pa3); SBAR();
    pv_d0(o, vb0, pa0, pa1, pa2, pa3); alibi(pB0, pB1, qposf - (float)((NT - 1) * KVBLK), nslope); partialSM(pB0, pB1, m_reg, mnB, alB);
    __syncthreads(); RESC(alB);
    finishSM(pB0, pB1, alB, l_reg, pa0, pa1, pa2, pa3); SBAR();
    pv_d0(o, vb0 + SHM_V, pa0, pa1, pa2, pa3);
    if (hi == 0) li_l[r32] = l_reg; asm volatile("s_waitcnt lgkmcnt(0)" ::: "memory");
    float rli[16];
#pragma unroll
    for (int r = 0; r < 16; ++r) rli[r] = __builtin_amdgcn_rcpf(li_l[crow(r, hi)]);
    __syncthreads();
    LAS float* OB = (LAS float*)lds;
    if (c == 1) {
#pragma unroll
        for (int r = 0; r < 16; ++r) { const int orow = wq * 32 + crow(r, hi);
#pragma unroll
            for (int d0 = 0; d0 < 4; ++d0) OB[orow * OB_PITCH + d0 * 32 + r32] = o[d0][r] * rli[r]; }
    }
    __syncthreads();
    if (c == 0) {
        float gcol[4];
#pragma unroll
        for (int d0 = 0; d0 < 4; ++d0) gcol[d0] = att_g[h * 128 + d0 * 32 + r32] * oscale;
#pragma unroll
        for (int r = 0; r < 16; ++r) { const int orow = wq * 32 + crow(r, hi);
            float dv[4]; float ss = 0.f;
#pragma unroll
            for (int d0 = 0; d0 < 4; ++d0) { dv[d0] = o[d0][r] * rli[r] - lam * OB[orow * OB_PITCH + d0 * 32 + r32]; ss += dv[d0] * dv[d0]; }
            ss += __shfl_xor(ss, 1); ss += __shfl_xor(ss, 2); ss += __shfl_xor(ss, 4); ss += __shfl_xor(ss, 8); ss += __shfl_xor(ss, 16);
            const float rs = rsqrtf(ss * (1.f / 128.f) + EPS);
            bf16_t* orp = mixed + (size_t)(row0 + qb * 128 + orow) * DM + h * 128 + r32;
#pragma unroll
            for (int d0 = 0; d0 < 4; ++d0) orp[d0 * 32] = f2bf(dv[d0] * rs * gcol[d0]); }
    }
    __syncthreads();
#undef SLOAD
#undef SWRITE
#undef SWAIT
#undef RESC
}
}

namespace ml {
constexpr int QP = 192, VP = 320, SP = 272, CP = 320;
constexpr int OFF_Q = 0, OFF_K = 24576, OFF_KE = 49152, OFF_V = 73728, OFF_C = 114688, OFF_VEC = 135168;
constexpr int V_U = 0, V_MX = 128, V_EINT = 256, V_EEND = 384, V_EMO = 512, V_QN = 640, V_RS = 768, V_GI = 896, V_GF = 1024, V_NST = 1152, V_NPART = 1216, V_SCAL = 1728;
constexpr int HS_PITCH = 132;
__device__ __forceinline__ s16x4 trr(unsigned addr) { s16x4 r; asm volatile("ds_read_b64_tr_b16 %0, %1" : "=&v"(r) : "v"(addr) : "memory"); return r; }
#define TRWAIT4(a, b, c, d) asm volatile("s_waitcnt lgkmcnt(0)" : "+v"(a), "+v"(b), "+v"(c), "+v"(d) :: "memory")
#define TRWAIT8(a, b, c, d, e, f, g, h) asm volatile("s_waitcnt lgkmcnt(0)" : "+v"(a), "+v"(b), "+v"(c), "+v"(d), "+v"(e), "+v"(f), "+v"(g), "+v"(h) :: "memory")
#define CAT(L, H) (bf16x8){L[0], L[1], L[2], L[3], H[0], H[1], H[2], H[3]}
__device__ __forceinline__ float logsig(float x) { return fminf(x, 0.f) - __logf(1.0f + __expf(-fabsf(x))); }

__device__ __forceinline__ void mlstm_dir(const bf16_t* __restrict__ proj, const float* __restrict__ gates, bf16_t* __restrict__ hdir,
                                          int seq, long row0, int h, int dir, LAS unsigned char* lds) {
    const int tid0 = opaque_tid();
    LAS float* vec = (LAS float*)(lds + OFF_VEC);
    const unsigned lbase = (unsigned)(uintptr_t)lds;
    const int nc = seq / 128;
    constexpr float L2E = 1.4426950408889634f;
    f32x16 Cst = {};
    if (tid0 < 64) vec[V_NST + tid0] = 0.f;
    float m_state = 0.f;
    bf16x8 pq[2], pk[2], pv[4]; float pgi = 0.f, pgf = 0.f;
#define POSB(cb_, j) ((cb_) + (dir ? 127 - (j) : (j)))
#define PREFETCH(cidx) do { const long cb_ = row0 + (long)(cidx) * 128; \
        _Pragma("unroll") for (int i = 0; i < 2; ++i) { const int chunk = tid0 + 512 * i, j = chunk >> 3, c8 = chunk & 7; const bf16_t* src = proj + (size_t)POSB(cb_, j) * NPROJ + h * 64 + c8 * 8; \
            pq[i] = *(const bf16x8*)(src + 1536); pk[i] = *(const bf16x8*)(src + 1792); } \
        _Pragma("unroll") for (int i = 0; i < 4; ++i) { const int chunk = tid0 + 512 * i, j = chunk >> 4, c16 = chunk & 15; \
            pv[i] = *(const bf16x8*)(proj + (size_t)POSB(cb_, j) * NPROJ + 2048 + h * 128 + c16 * 8); } \
        if (tid0 < 128) { const float* gp = gates + (size_t)POSB(cb_, tid0) * 16; pgi = gp[(dir ? 8 : 0) + h]; pgf = gp[(dir ? 12 : 4) + h]; } } while (0)
    PREFETCH(dir ? nc - 1 : 0);
    __syncthreads();
    for (int cc = 0; cc < nc; ++cc) {
        int tid = tid0; asm volatile("" : "+v"(tid));
        const int wid = tid >> 6, lane = tid & 63, r = lane & 31, hh = lane >> 5, i16 = lane & 15, q4 = i16 >> 2, p4 = i16 & 3, blk = (lane >> 4) & 1;
        const int rb = wid >> 1, ch = wid & 1, db = wid >> 2, eb = wid & 3;
        const int c = dir ? nc - 1 - cc : cc;
        const long cbase = row0 + (long)c * 128;
#pragma unroll
        for (int i = 0; i < 2; ++i) { const int chunk = tid + 512 * i, j = chunk >> 3, c8 = chunk & 7;
            *(LAS bf16x8*)(lds + OFF_Q + j * QP + c8 * 16) = pq[i]; *(LAS bf16x8*)(lds + OFF_K + j * QP + c8 * 16) = pk[i]; }
#pragma unroll
        for (int i = 0; i < 4; ++i) { const int chunk = tid + 512 * i, j = chunk >> 4, c16 = chunk & 15; *(LAS bf16x8*)(lds + OFF_V + j * VP + c16 * 16) = pv[i]; }
        if (tid < 128) { vec[V_GI + tid] = pgi; vec[V_GF + tid] = pgf; }
#pragma unroll
        for (int i = 0; i < 16; ++i) *(LAS bf16_t*)(lds + OFF_C + (32 * db + crow(i, hh)) * CP + (32 * eb + r) * 2) = f2bf(Cst[i]);
        __syncthreads();
        if (cc + 1 < nc) PREFETCH(dir ? nc - 2 - cc : cc + 1);
        if (wid == 0) {
            const float gf0 = vec[V_GF + 2 * lane], gf1 = vec[V_GF + 2 * lane + 1], gi0 = vec[V_GI + 2 * lane], gi1 = vec[V_GI + 2 * lane + 1];
            const float lf0 = logsig(gf0), lf1 = logsig(gf1);
            float incl = lf0 + lf1;
#pragma unroll
            for (int d = 1; d < 64; d <<= 1) { const float t = __shfl_up(incl, d); if (lane >= d) incl += t; }
            const float b1 = incl, b0 = incl - lf1, g = __shfl(incl, 63);
            const float u0 = gi0 - b0, u1 = gi1 - b1;
            float cm = fmaxf(u0, u1);
#pragma unroll
            for (int d = 1; d < 64; d <<= 1) { const float t = __shfl_up(cm, d); if (lane >= d) cm = fmaxf(cm, t); }
            float excl = __shfl_up(cm, 1); if (lane == 0) excl = -INFINITY;
            const float cmx0 = fmaxf(excl, u0), cmx1 = cm, umax = __shfl(cm, 63);
            const float mp = m_state, mx0 = fmaxf(mp, cmx0), mx1 = fmaxf(mp, cmx1);
            vec[V_U + 2 * lane] = u0; vec[V_U + 2 * lane + 1] = u1; vec[V_MX + 2 * lane] = mx0; vec[V_MX + 2 * lane + 1] = mx1;
            vec[V_EINT + 2 * lane] = __expf(mp - mx0); vec[V_EINT + 2 * lane + 1] = __expf(mp - mx1);
            vec[V_EEND + 2 * lane] = __expf(u0 - umax); vec[V_EEND + 2 * lane + 1] = __expf(u1 - umax);
            vec[V_EMO + 2 * lane] = __expf(-(b0 + mx0)); vec[V_EMO + 2 * lane + 1] = __expf(-(b1 + mx1));
            const float m_loc = g + umax, m_new = fmaxf(g + mp, m_loc);
            if (lane == 0) { vec[V_SCAL] = __expf(g + mp - m_new); vec[V_SCAL + 1] = __expf(m_loc - m_new); }
            m_state = m_new;
        }
        bf16x8 qa[4];
#pragma unroll
        for (int ks = 0; ks < 4; ++ks) qa[ks] = *(const LAS bf16x8*)(lds + OFF_Q + (32 * rb + r) * QP + (16 * ks + 8 * hh) * 2);
        f32x16 Sv[2] = {}, Ov[2] = {};
#pragma unroll
        for (int t = 0; t < 2; ++t) {
            if (2 * ch + t <= rb) {
#pragma unroll
                for (int ks = 0; ks < 4; ++ks) { const bf16x8 kb = *(const LAS bf16x8*)(lds + OFF_K + (64 * ch + 32 * t + r) * QP + (16 * ks + 8 * hh) * 2);
                    Sv[t] = __builtin_amdgcn_mfma_f32_32x32x16_bf16(qa[ks], kb, Sv[t], 0, 0, 0); } }
        }
#pragma unroll
        for (int t = 0; t < 2; ++t) {
            const unsigned a0 = lbase + OFF_C + (8 * hh + q4) * CP + (64 * ch + 32 * t + 16 * blk + 4 * p4) * 2;
            s16x4 l0 = trr(a0), h0 = trr(a0 + 4 * CP), l1 = trr(a0 + 16 * CP), h1 = trr(a0 + 20 * CP), l2 = trr(a0 + 32 * CP), h2 = trr(a0 + 36 * CP), l3 = trr(a0 + 48 * CP), h3 = trr(a0 + 52 * CP);
            TRWAIT8(l0, h0, l1, h1, l2, h2, l3, h3);
            Ov[t] = __builtin_amdgcn_mfma_f32_32x32x16_bf16(qa[0], CAT(l0, h0), Ov[t], 0, 0, 0);
            Ov[t] = __builtin_amdgcn_mfma_f32_32x32x16_bf16(qa[1], CAT(l1, h1), Ov[t], 0, 0, 0);
            Ov[t] = __builtin_amdgcn_mfma_f32_32x32x16_bf16(qa[2], CAT(l2, h2), Ov[t], 0, 0, 0);
            Ov[t] = __builtin_amdgcn_mfma_f32_32x32x16_bf16(qa[3], CAT(l3, h3), Ov[t], 0, 0, 0);
        }
        { const int j = tid >> 2, part = tid & 3; float s = 0.f;
#pragma unroll
          for (int k2 = 0; k2 < 2; ++k2) { const bf16x8 qv = *(const LAS bf16x8*)(lds + OFF_Q + j * QP + (16 * part + 8 * k2) * 2);
#pragma unroll
              for (int e = 0; e < 8; ++e) s += bf2f((bf16_t)qv[e]) * vec[V_NST + 16 * part + 8 * k2 + e]; }
          s += __shfl_xor(s, 1); s += __shfl_xor(s, 2); if (part == 0) vec[V_QN + j] = s; }
        __syncthreads();
#pragma unroll
        for (int i = 0; i < 2; ++i) { const int chunk = tid + 512 * i, j = chunk >> 3, c8 = chunk & 7; const float ee = vec[V_EEND + j];
            const bf16x8 kv = *(const LAS bf16x8*)(lds + OFF_K + j * QP + c8 * 16); u32x4 w;
            w.x = cvt_pk_bf16(bf2f((bf16_t)kv[0]) * ee, bf2f((bf16_t)kv[1]) * ee); w.y = cvt_pk_bf16(bf2f((bf16_t)kv[2]) * ee, bf2f((bf16_t)kv[3]) * ee);
            w.z = cvt_pk_bf16(bf2f((bf16_t)kv[4]) * ee, bf2f((bf16_t)kv[5]) * ee); w.w = cvt_pk_bf16(bf2f((bf16_t)kv[6]) * ee, bf2f((bf16_t)kv[7]) * ee);
            *(LAS u32x4*)(lds + OFF_KE + j * QP + c8 * 16) = w; }
        {
            const float us0 = vec[V_U + 64 * ch + r] * L2E, us1 = vec[V_U + 64 * ch + 32 + r] * L2E;
#pragma unroll
            for (int i = 0; i < 16; ++i) { const int j = 32 * rb + crow(i, hh); const float mxj = vec[V_MX + j] * L2E, ei = vec[V_EINT + j];
                const int s0 = 64 * ch + r, s1 = s0 + 32;
                Sv[0][i] = (s0 <= j) ? Sv[0][i] * __builtin_amdgcn_exp2f(us0 - mxj) : 0.f;
                Sv[1][i] = (s1 <= j) ? Sv[1][i] * __builtin_amdgcn_exp2f(us1 - mxj) : 0.f;
                Ov[0][i] *= ei; Ov[1][i] *= ei; }
        }
        __syncthreads();
#pragma unroll
        for (int t = 0; t < 2; ++t)
#pragma unroll
            for (int i = 0; i < 16; ++i) *(LAS bf16_t*)(lds + OFF_Q + (32 * rb + crow(i, hh)) * SP + (64 * ch + 32 * t + r) * 2) = f2bf(Sv[t][i]);
        __syncthreads();
#pragma unroll 1
        for (int kp = 0; kp <= rb; ++kp) {
            const bf16x8 a0v = *(const LAS bf16x8*)(lds + OFF_Q + (32 * rb + r) * SP + (32 * kp + 8 * hh) * 2), a1v = *(const LAS bf16x8*)(lds + OFF_Q + (32 * rb + r) * SP + (32 * kp + 16 + 8 * hh) * 2);
            const unsigned a0 = lbase + OFF_V + (32 * kp + 8 * hh + q4) * VP + (64 * ch + 16 * blk + 4 * p4) * 2;
            s16x4 l0 = trr(a0), h0 = trr(a0 + 4 * VP), l1 = trr(a0 + 64), h1 = trr(a0 + 4 * VP + 64);
            s16x4 l2 = trr(a0 + 16 * VP), h2 = trr(a0 + 20 * VP), l3 = trr(a0 + 16 * VP + 64), h3 = trr(a0 + 20 * VP + 64);
            TRWAIT8(l0, h0, l1, h1, l2, h2, l3, h3);
            Ov[0] = __builtin_amdgcn_mfma_f32_32x32x16_bf16(a0v, CAT(l0, h0), Ov[0], 0, 0, 0);
            Ov[1] = __builtin_amdgcn_mfma_f32_32x32x16_bf16(a0v, CAT(l1, h1), Ov[1], 0, 0, 0);
            Ov[0] = __builtin_amdgcn_mfma_f32_32x32x16_bf16(a1v, CAT(l2, h2), Ov[0], 0, 0, 0);
            Ov[1] = __builtin_amdgcn_mfma_f32_32x32x16_bf16(a1v, CAT(l3, h3), Ov[1], 0, 0, 0);
        }
        { const int j = tid >> 2, part = tid & 3; float s = 0.f;
#pragma unroll
          for (int k4 = 0; k4 < 4; ++k4) { const bf16x8 sv = *(const LAS bf16x8*)(lds + OFF_Q + j * SP + (32 * part + 8 * k4) * 2);
#pragma unroll
              for (int e = 0; e < 8; ++e) s += bf2f((bf16_t)sv[e]); }
          s += __shfl_xor(s, 1); s += __shfl_xor(s, 2); if (part == 0) vec[V_RS + j] = s; }
        f32x16 Cl = {};
#pragma unroll 1
        for (int kp = 0; kp < 4; ++kp) {
            const unsigned aa = lbase + OFF_KE + (32 * kp + 8 * hh + q4) * QP + (32 * db + 16 * blk + 4 * p4) * 2;
            const unsigned ab = lbase + OFF_V + (32 * kp + 8 * hh + q4) * VP + (32 * eb + 16 * blk + 4 * p4) * 2;
            s16x4 la = trr(aa), ha = trr(aa + 4 * QP), lb = trr(ab), hb = trr(ab + 4 * VP), la2 = trr(aa + 16 * QP), ha2 = trr(aa + 20 * QP), lb2 = trr(ab + 16 * VP), hb2 = trr(ab + 20 * VP);
            TRWAIT8(la, ha, lb, hb, la2, ha2, lb2, hb2);
            Cl = __builtin_amdgcn_mfma_f32_32x32x16_bf16(CAT(la, ha), CAT(lb, hb), Cl, 0, 0, 0);
            Cl = __builtin_amdgcn_mfma_f32_32x32x16_bf16(CAT(la2, ha2), CAT(lb2, hb2), Cl, 0, 0, 0);
        }
        const float sa = vec[V_SCAL], sb = vec[V_SCAL + 1];
#pragma unroll
        for (int i = 0; i < 16; ++i) Cst[i] = sa * Cst[i] + sb * Cl[i];
        { const int d = tid & 63, part = tid >> 6; float s = 0.f;
#pragma unroll
          for (int k = 0; k < 16; ++k) s += bf2f(*(const LAS bf16_t*)(lds + OFF_KE + (16 * part + k) * QP + d * 2));
          vec[V_NPART + part * 64 + d] = s; }
        __syncthreads();
        if (tid < 64) { float nl = 0.f;
#pragma unroll
            for (int p = 0; p < 8; ++p) nl += vec[V_NPART + p * 64 + tid];
            vec[V_NST + tid] = sa * vec[V_NST + tid] + sb * nl; }
        LAS float* HS = (LAS float*)lds;
#pragma unroll
        for (int i = 0; i < 16; ++i) { const int j = 32 * rb + crow(i, hh);
            const float den = vec[V_EINT + j] * vec[V_QN + j] + vec[V_RS + j];
            const float scl = 1.0f / fmaxf(fabsf(den), vec[V_EMO + j]);
            HS[j * HS_PITCH + 64 * ch + r] = Ov[0][i] * scl; HS[j * HS_PITCH + 64 * ch + 32 + r] = Ov[1][i] * scl; }
        __syncthreads();
        { const int j = tid >> 2, part = tid & 3;
          bf16_t* op = hdir + (size_t)POSB(cbase, j) * 512 + h * 128 + 32 * part;
#pragma unroll
          for (int k = 0; k < 4; ++k) { const f32x4 xa = *(const LAS f32x4*)(HS + j * HS_PITCH + 32 * part + 8 * k), xb4 = *(const LAS f32x4*)(HS + j * HS_PITCH + 32 * part + 8 * k + 4);
              u32x4 w; w.x = cvt_pk_bf16(xa[0], xa[1]); w.y = cvt_pk_bf16(xa[2], xa[3]); w.z = cvt_pk_bf16(xb4[0], xb4[1]); w.w = cvt_pk_bf16(xb4[2], xb4[3]);
              *(u32x4*)(op + 8 * k) = w; } }
        __syncthreads();
    }
#undef POSB
#undef PREFETCH
}

__device__ __forceinline__ void mlstm_combine(const bf16_t* __restrict__ proj, const bf16_t* hf, const bf16_t* hb, bf16_t* __restrict__ mixed, const float* __restrict__ lstm_g, int seq, long row0, int h) {
    const int tid = opaque_tid(), part = tid & 3;
    const float* gp = lstm_g + h * 128 + 32 * part;
    for (int r0 = 0; r0 < seq; r0 += 128) {
        const size_t row = (size_t)(row0 + r0 + (tid >> 2));
        const bf16_t* fp = hf + row * 512 + h * 128 + 32 * part; const bf16_t* bp = hb + row * 512 + h * 128 + 32 * part;
        const bf16_t* lop = proj + row * NPROJ + 2560 + h * 128 + 32 * part; bf16_t* op = mixed + row * DM + 512 + h * 128 + 32 * part;
        float hs[32]; float ss = 0.f;
#pragma unroll
        for (int k = 0; k < 4; ++k) { const bf16x8 a = *(const bf16x8*)(fp + 8 * k), b = *(const bf16x8*)(bp + 8 * k);
#pragma unroll
            for (int e = 0; e < 8; ++e) { const float x = bf2f((bf16_t)a[e]) + bf2f((bf16_t)b[e]); hs[8 * k + e] = x; ss += x * x; } }
        ss += __shfl_xor(ss, 1); ss += __shfl_xor(ss, 2);
        const float rs = rsqrtf(ss * (1.f / 128.f) + EPS);
#pragma unroll
        for (int k = 0; k < 4; ++k) { const bf16x8 lo8 = *(const bf16x8*)(lop + 8 * k); float ov[8];
#pragma unroll
            for (int e = 0; e < 8; ++e) { const float lg = bf2f((bf16_t)lo8[e]); const float sg = 1.0f / (1.0f + __expf(-lg)); ov[e] = sg * hs[8 * k + e] * rs * gp[8 * k + e]; }
            u32x4 w; w.x = cvt_pk_bf16(ov[0], ov[1]); w.y = cvt_pk_bf16(ov[2], ov[3]); w.z = cvt_pk_bf16(ov[4], ov[5]); w.w = cvt_pk_bf16(ov[6], ov[7]);
            *(u32x4*)(op + 8 * k) = w; }
    }
}
}

struct Args {
    const float* xin[2]; const float* w_in; const float* gate_bias; const float* lam_q1; const float* lam_k1; const float* lam_q2; const float* lam_k2;
    const float* att_g; const float* lstm_g; const float* w_out; const float* ln1_g; const float* ln1_b; const float* w_gu; const float* conv_w; const float* conv_b;
    const float* w_down; const float* ln2_g; const float* ln2_b; float* out; unsigned char* ws; int ph_lo, ph_hi;
};
constexpr int NPHASE = 31;

__device__ __forceinline__ void transpose_item(const float* W, int K, int N, bf16_t* WT, int gu_map, const float* g, const float* b, float* c1, float* c2, LAS float* scr, int item, int lane) {
    const int nblk = (N + 31) / 32, kb = item / nblk, nb = item % nblk, k0 = 64 * kb, n0 = 32 * nb;
    const int ncol = n0 + (lane & 31); const bool okc = ncol < N;
    float a1 = 0.f, a2 = 0.f;
#pragma unroll 8
    for (int i = 0; i < 32; ++i) { const int kk = 2 * i + (lane >> 5); float w = okc ? W[(size_t)(k0 + kk) * N + ncol] : 0.f;
        if (g) { a2 += w * b[k0 + kk]; w *= g[k0 + kk]; a1 += bf2f(f2bf(w)); }
        scr[kk * 33 + (lane & 31)] = w; }
    asm volatile("s_waitcnt lgkmcnt(0)" ::: "memory");
    if (g) { a1 += __shfl_xor(a1, 32); a2 += __shfl_xor(a2, 32); }
    const int c = lane & 7;
#pragma unroll
    for (int j = 0; j < 4; ++j) { const int nl = (lane >> 3) + 8 * j; const int n = n0 + nl; const LAS float* s = scr + (8 * c) * 33 + nl;
        u32x4 o; o.x = cvt_pk_bf16(s[0 * 33], s[1 * 33]); o.y = cvt_pk_bf16(s[2 * 33], s[3 * 33]); o.z = cvt_pk_bf16(s[4 * 33], s[5 * 33]); o.w = cvt_pk_bf16(s[6 * 33], s[7 * 33]);
        if (n < N) { int rowm = n; if (gu_map) { const int n2 = n < DFF ? n : n - DFF; rowm = 256 * (n2 >> 7) + (n < DFF ? 0 : 128) + (n2 & 127); }
            *(u32x4*)(WT + (size_t)rowm * K + k0 + 8 * c) = o; } }
    if (g && lane < 32 && okc) { int rowm = ncol; if (gu_map) { const int n2 = ncol < DFF ? ncol : ncol - DFF; rowm = 256 * (n2 >> 7) + (ncol < DFF ? 0 : 128) + (n2 & 127); }
        atomicAdd(c1 + rowm, a1); atomicAdd(c2 + rowm, a2); }
    asm volatile("s_waitcnt lgkmcnt(0)" ::: "memory");
}

__device__ __forceinline__ void cvt_rows(const float* x, bf16_t* xb, int gtid, int nthr) {
    for (size_t i = gtid; i < (size_t)MT * DM / 8; i += nthr) {
        const f32x4 a = *(const f32x4*)(x + i * 8), b = *(const f32x4*)(x + i * 8 + 4);
        u32x4 w; w.x = cvt_pk_bf16(a[0], a[1]); w.y = cvt_pk_bf16(a[2], a[3]); w.z = cvt_pk_bf16(b[0], b[1]); w.w = cvt_pk_bf16(b[2], b[3]);
        *(u32x4*)(xb + i * 8) = w; }
}

__global__ void __launch_bounds__(512, 2) fwd(Args args) {
    extern __shared__ __attribute__((aligned(16))) unsigned char lds_raw[];
    LAS unsigned char* lds = (LAS unsigned char*)lds_raw;
    for (int ph = args.ph_lo; ph < args.ph_hi; ++ph) {
        if (ph > args.ph_lo) cg::this_grid().sync();
        const int tid = opaque_tid(), lane = tid & 63, wave = __builtin_amdgcn_readfirstlane(tid >> 6);
        const int G = gridDim.x, gtid = blockIdx.x * 512 + tid, nthr = G * 512;
        unsigned char* ws = args.ws; asm volatile("" : "+s"(ws));
        bf16_t* XB = (bf16_t*)(ws + WS_XB); bf16_t* MIXED = (bf16_t*)(ws + WS_MIXED); bf16_t* PROJ = (bf16_t*)(ws + WS_PROJ); bf16_t* HMID = PROJ;
        float* GATES = (float*)(ws + WS_GATES); float* EDGE = (float*)(ws + WS_EDGE);
        f32x2* ST1 = (f32x2*)(ws + WS_ST1); f32x2* ST2 = (f32x2*)(ws + WS_ST2);
        float* LAMV = (float*)(ws + WS_LAM);
        float* C1IN = (float*)(ws + CTL_C1IN); float* C2IN = (float*)(ws + CTL_C2IN); float* C1GU = (float*)(ws + CTL_C1GU); float* C2GU = (float*)(ws + CTL_C2GU);
        unsigned* QCNT = (unsigned*)(ws + WS_CTL);
        if ((PHMASK & 1) && ph == 0) {
            LAS float* scr = (LAS float*)(lds + wave * 8448);
            const int gw = blockIdx.x * 8 + wave, NGW = G * 8;
            constexpr int I_IN = 16 * 97, I_OUT = 16 * 32, I_GU = 16 * 176, I_DN = 44 * 32, I_L = I_IN + I_OUT + I_GU + I_DN;
            for (int it = gw; it < 2 * I_L; it += NGW) {
                const int l = it / I_L; int r = it % I_L;
                if (r < I_IN) { transpose_item(args.w_in + (size_t)l * DM * NIN, DM, NIN, (bf16_t*)(ws + WS_WIN) + (size_t)l * NPROJ_PAD * DM, 0,
                                               l ? args.ln2_g : nullptr, l ? args.ln2_b : nullptr, C1IN, C2IN, scr, r, lane); continue; } r -= I_IN;
                if (r < I_OUT) { transpose_item(args.w_out + (size_t)l * DM * DM, DM, DM, (bf16_t*)(ws + WS_WOUT) + (size_t)l * DM * DM, 0, nullptr, nullptr, nullptr, nullptr, scr, r, lane); continue; } r -= I_OUT;
                if (r < I_GU) { transpose_item(args.w_gu + (size_t)l * DM * NGU, DM, NGU, (bf16_t*)(ws + WS_WGU) + (size_t)l * NGU * DM, 1,
                                               args.ln1_g + l * DM, args.ln1_b + l * DM, C1GU + l * NGU, C2GU + l * NGU, scr, r, lane); continue; } r -= I_GU;
                transpose_item(args.w_down + (size_t)l * DFF * DM, DFF, DM, (bf16_t*)(ws + WS_WDN) + (size_t)l * DM * DFF, 0, nullptr, nullptr, nullptr, nullptr, scr, r, lane);
            }
            for (int i = gtid; i < 2 * (NPROJ_PAD - NIN) * DM / 8; i += nthr) { const int l = i / ((NPROJ_PAD - NIN) * DM / 8), o = i % ((NPROJ_PAD - NIN) * DM / 8);
                *(u32x4*)((bf16_t*)(ws + WS_WIN) + (size_t)l * NPROJ_PAD * DM + (size_t)NIN * DM + (size_t)o * 8) = (u32x4){0u, 0u, 0u, 0u}; }
            if (blockIdx.x == 0 && wave == 0) {
                for (int l = 0; l < 2; ++l) {
                    float s1 = args.lam_q1[l * 64 + lane] * args.lam_k1[l * 64 + lane], s2 = args.lam_q2[l * 64 + lane] * args.lam_k2[l * 64 + lane];
#pragma unroll
                    for (int o = 1; o < 64; o <<= 1) { s1 += __shfl_xor(s1, o); s2 += __shfl_xor(s2, o); }
                    const float lam_init = 0.8f - 0.6f * expf(-0.3f * (float)l);
                    if (lane == 0) LAMV[l] = expf(s1) - expf(s2) + lam_init;
                }
            }
            cvt_rows(args.xin[0], XB, gtid, nthr);
            continue;
        }
        const int trunk = (ph - 1) / 15, pp = (ph - 1) % 15;
        const int seq = trunk ? 2048 : 4096, nseq = trunk ? 32 : 16;
        float* V = args.out + (size_t)trunk * MT * DM;
        if ((PHMASK & 256) && pp == 14) {
            const float* g = args.ln2_g + DM; const float* b = args.ln2_b + DM;
            for (size_t i = gtid; i < (size_t)MT * DM / 4; i += nthr) { const int row = (int)(i >> 8), col = (int)(i & 255) * 4;
                float mu, rstd; row_stats(ST2, row, mu, rstd);
                const f32x4 x = *(const f32x4*)(V + i * 4), gv = *(const f32x4*)(g + col), bv = *(const f32x4*)(b + col);
                *(f32x4*)(V + i * 4) = (x - mu) * rstd * gv + bv; }
            if (trunk == 0) cvt_rows(args.xin[1], XB, gtid, nthr);
            continue;
        }
        const int l = pp / 7, sp0 = pp % 7, sp = sp0 == 0 ? 0 : sp0 - 1;
        unsigned* KMAX = (unsigned*)(ws + CTL_KMAX) + (trunk * 2 + l) * 128;
        if (sp0 == 1) {
            const int gw = blockIdx.x * 8 + wave, NGW = G * 8;
            for (int chunk = gw; chunk < MT / 32; chunk += NGW) {
                float mx = 0.f;
                for (int i = 0; i < 32; ++i) { const bf16x8 kv = *(const bf16x8*)(PROJ + (size_t)(chunk * 32 + i) * NPROJ + 512 + lane * 8); float ss = 0.f;
#pragma unroll
                    for (int e = 0; e < 8; ++e) { const float x = bf2f((bf16_t)kv[e]); ss += x * x; }
                    ss += __shfl_xor(ss, 1); ss += __shfl_xor(ss, 2); ss += __shfl_xor(ss, 4); mx = fmaxf(mx, ss); }
                if ((lane & 7) == 0) atomicMax(KMAX + ((chunk * 32) / seq) * 4 + (lane >> 4), __float_as_uint(mx));
            }
        } else if ((PHMASK & 2) && sp == 0) {
            pg8::Gemm g{XB, (const bf16_t*)(ws + WS_WIN) + (size_t)l * NPROJ_PAD * DM, MT, NPROJ_PAD, DM};
            pg8::StaticOrder S; S.init(MT, NPROJ_PAD, G, (int)blockIdx.x);
            EpiProj E{PROJ, GATES, args.gate_bias + l * 16, l ? ST2 : nullptr, C1IN, C2IN, (LAS f32x2*)(lds + EPI_LDS + 8192)};
            pg8::gemm_phase<EpiProj, pg8::StaticOrder>(lds, g, S, E);
        } else if ((PHMASK & 12) && sp == 1) {
            unsigned* qc = QCNT + (size_t)((trunk * 2 + l) * 8) * 64;
            const int myx = (int)(__builtin_amdgcn_s_getreg((3 << 11) | 20) & 7);
            const int npair = nseq / 2, nqb = seq / 128, nitems = npair * (2 + nqb);
            unsigned* FLAG = (unsigned*)(ws + CTL_FLAG) + (trunk * 2 + l) * 128;
            bf16_t* HDIR = (bf16_t*)(ws + WS_HDIR);
            const float lam = LAMV[l]; const float lam_init = 0.8f - 0.6f * expf(-0.3f * (float)l);
            LAS int* sitem = (LAS int*)(lds + LDS_BYTES - 64);
            for (int qq = 0; qq < 8; ++qq) {
                const int x = (myx + qq) & 7;
                for (;;) {
                    if (tid == 0) sitem[0] = (int)atomicAdd(qc + 64 * x, 1u);
                    __syncthreads();
                    const int item = sitem[0];
                    __syncthreads();
                    if (item >= nitems) break;
                    const int nbh = nseq / 8;
                    if ((PHMASK & 4) && item < 2 * npair) {
                        const int pi = item >> 1, dir = item & 1, h = 3 - pi / nbh, b = ((x - 2 * h) & 7) + 8 * (pi % nbh);
                        ml::mlstm_dir(PROJ, GATES, HDIR + (size_t)dir * MT * 512, seq, (long)b * seq, h, dir, lds);
                        __threadfence();
                        __syncthreads();
                        if (tid == 0) sitem[1] = (int)atomicAdd(FLAG + b * 4 + h, 1u);
                        __syncthreads();
                        const int old = sitem[1];
                        if (old == 1) { __threadfence(); ml::mlstm_combine(PROJ, HDIR, HDIR + (size_t)MT * 512, MIXED, args.lstm_g + l * 512, seq, (long)b * seq, h); }
                        __syncthreads();
                    } else if (PHMASK & 8) {
                        const int a = item - 2 * npair, pi = a / nqb, qb = a % nqb, h = 3 - pi / nbh, b = ((x - 2 * h) & 7) + 8 * (pi % nbh);
                        const float slope = exp2f(-2.0f * (float)(h + 1));
                        att::attn_unit(PROJ, MIXED, args.att_g + l * 512, seq, (long)b * seq, h, qb, lam, -slope, 1.0f - lam_init, __uint_as_float(KMAX[b * 4 + h]), (LAS char*)lds);
                    }
                }
            }
        } else if ((PHMASK & 16) && sp == 2) {
            pg8::Gemm g{MIXED, (const bf16_t*)(ws + WS_WOUT) + (size_t)l * DM * DM, MT, DM, DM};
            pg8::StaticOrder S; S.init(MT, DM, G, (int)blockIdx.x);
            EpiRes E{l ? nullptr : args.xin[trunk], V, ST2, args.ln2_g, args.ln2_b, ST1, XB, (LAS f32x2*)(lds + EPI_LDS), (LAS f32x2*)(lds + EPI_LDS + 8192)};
            pg8::gemm_phase<EpiRes, pg8::StaticOrder>(lds, g, S, E);
        } else if ((PHMASK & 32) && sp == 3) {
            pg8::Gemm g{XB, (const bf16_t*)(ws + WS_WGU) + (size_t)l * NGU * DM, MT, NGU, DM};
            pg8::StaticOrder S; S.init(MT, NGU, G, (int)blockIdx.x);
            EpiGU E{HMID, EDGE, ST1, C1GU + l * NGU, C2GU + l * NGU, args.conv_w + (size_t)l * 3 * DFF, args.conv_b + (size_t)l * DFF, (LAS float*)(lds + EPI_LDS), (LAS f32x2*)(lds + EPI_LDS + 8192)};
            pg8::gemm_phase<EpiGU, pg8::StaticOrder>(lds, g, S, E);
        } else if ((PHMASK & 64) && sp == 4) {
            const float* cw = args.conv_w + (size_t)l * 3 * DFF; const float* cb = args.conv_b + (size_t)l * DFF; const int st = seq / 256;
            for (int i = gtid; i < 256 * 2 * (DFF / 4); i += nthr) {
                const int grp = i % (DFF / 4), e2 = (i / (DFF / 4)) & 1, pm = i / (2 * (DFF / 4)), j = grp * 4;
                const float* Ep = EDGE + (size_t)pm * 6 * DFF + j;
                const f32x4 w0 = *(const f32x4*)(cw + j), w1 = *(const f32x4*)(cw + DFF + j), w2 = *(const f32x4*)(cw + 2 * DFF + j), cbv = *(const f32x4*)(cb + j);
                f32x4 ga, gb, gc, up; const f32x4 z = (f32x4){0.f, 0.f, 0.f, 0.f}; int row;
                if (e2 == 0) { ga = (pm % st == 0) ? z : *(const f32x4*)(Ep - 6 * DFF + 3 * DFF); gb = *(const f32x4*)(Ep); gc = *(const f32x4*)(Ep + DFF); up = *(const f32x4*)(Ep + 4 * DFF); row = pm * 256; }
                else { ga = *(const f32x4*)(Ep + 2 * DFF); gb = *(const f32x4*)(Ep + 3 * DFF); gc = (pm % st == st - 1) ? z : *(const f32x4*)(Ep + 6 * DFF); up = *(const f32x4*)(Ep + 5 * DFF); row = pm * 256 + 255; }
                const f32x4 cv = cbv + w0 * ga + w1 * gb + w2 * gc;
                u32x2 w; w.x = cvt_pk_bf16(gelu_erf(cv[0]) * up[0], gelu_erf(cv[1]) * up[1]); w.y = cvt_pk_bf16(gelu_erf(cv[2]) * up[2], gelu_erf(cv[3]) * up[3]);
                *(u32x2*)(HMID + (size_t)row * DFF + j) = w; }
        } else if (PHMASK & 128) {
            pg8::Gemm g{HMID, (const bf16_t*)(ws + WS_WDN) + (size_t)l * DM * DFF, MT, DM, DFF};
            pg8::StaticOrder S; S.init(MT, DM, G, (int)blockIdx.x);
            EpiRes E{nullptr, V, ST1, args.ln1_g + l * DM, args.ln1_b + l * DM, ST2, l == 0 ? XB : nullptr, (LAS f32x2*)(lds + EPI_LDS), (LAS f32x2*)(lds + EPI_LDS + 8192)};
            pg8::gemm_phase<EpiRes, pg8::StaticOrder>(lds, g, S, E);
        }
    }
}

extern "C" void kernel_launch(void* const* d_in, const int* in_sizes, int n_in, void* d_out, int out_size, void* d_ws, size_t ws_size, hipStream_t stream) {
    static int grid = 0;
    if (grid == 0) {
        if (n_in != 19 || ws_size < WS_END) { fprintf(stderr, "kernel_launch: unexpected n_in %d / ws %zu\n", n_in, ws_size); grid = -1; return; }
        int dev = 0, cus = 0, per_cu = 0;
        hipGetDevice(&dev); hipDeviceGetAttribute(&cus, hipDeviceAttributeMultiprocessorCount, dev);
        if (hipFuncSetAttribute((const void*)fwd, hipFuncAttributeMaxDynamicSharedMemorySize, LDS_BYTES) != hipSuccess) { fprintf(stderr, "kernel_launch: hipFuncSetAttribute failed\n"); grid = -1; return; }
        hipOccupancyMaxActiveBlocksPerMultiprocessor(&per_cu, (const void*)fwd, 512, LDS_BYTES);
        (void)hipGetLastError();
        if (per_cu < 1) per_cu = 1;
        grid = cus;
    }
    if (grid < 0) return;
    hipMemsetAsync((char*)d_ws + WS_CTL, 0, CTL_BYTES, stream);
    Args a{};
    a.xin[0] = (const float*)d_in[0]; a.xin[1] = (const float*)d_in[1]; a.w_in = (const float*)d_in[2]; a.gate_bias = (const float*)d_in[3];
    a.lam_q1 = (const float*)d_in[4]; a.lam_k1 = (const float*)d_in[5]; a.lam_q2 = (const float*)d_in[6]; a.lam_k2 = (const float*)d_in[7];
    a.att_g = (const float*)d_in[8]; a.lstm_g = (const float*)d_in[9]; a.w_out = (const float*)d_in[10]; a.ln1_g = (const float*)d_in[11]; a.ln1_b = (const float*)d_in[12];
    a.w_gu = (const float*)d_in[13]; a.conv_w = (const float*)d_in[14]; a.conv_b = (const float*)d_in[15]; a.w_down = (const float*)d_in[16]; a.ln2_g = (const float*)d_in[17]; a.ln2_b = (const float*)d_in[18];
    a.out = (float*)d_out; a.ws = (unsigned char*)d_ws;
#if MK_MULTI
    for (int ph = 0; ph < NPHASE; ++ph) { a.ph_lo = ph; a.ph_hi = ph + 1; hipLaunchKernelGGL(fwd, dim3(grid), dim3(512), LDS_BYTES, stream, a); }
#else
    a.ph_lo = 0; a.ph_hi = NPHASE;
    void* kargs[] = {&a};
    hipError_t e = hipLaunchCooperativeKernel((const void*)fwd, dim3(grid), dim3(512), kargs, LDS_BYTES, stream);
    if (e != hipSuccess) fprintf(stderr, "kernel_launch: cooperative launch failed: %s (grid %d)\n", hipGetErrorString(e), grid);
#endif
}
```

```cpp
#include <hip/hip_runtime.h>
#include <hip/hip_cooperative_groups.h>
#include <cstdio>
#include <cstdint>
namespace cg = cooperative_groups;

#ifndef PHMASK
#define PHMASK 0xffff
#endif
#ifndef PROBE_TYPES
#define PROBE_TYPES 0
#endif
#ifndef MK_MULTI
#define MK_MULTI 0
#endif

#define LAS __attribute__((address_space(3)))
typedef unsigned short bf16_t;
typedef short bf16x8 __attribute__((ext_vector_type(8)));
typedef short s16x4 __attribute__((ext_vector_type(4)));
typedef float f32x2 __attribute__((ext_vector_type(2)));
typedef float f32x4 __attribute__((ext_vector_type(4)));
typedef float f32x8 __attribute__((ext_vector_type(8)));
typedef float f32x16 __attribute__((ext_vector_type(16)));
typedef _Float16 h16x8 __attribute__((ext_vector_type(8)));
typedef unsigned u32x2 __attribute__((ext_vector_type(2)));
typedef unsigned u32x4 __attribute__((ext_vector_type(4)));

constexpr int DM = 1024, NPROJ = 3072, NPROJ_PAD = 3328, NIN = 3088, DFF = 2816, NGU = 5632;
constexpr int MT = 65536;
constexpr float ALPHA = 1.4142135623730951f, EPS = 1e-5f;
constexpr int LDS_BYTES = 147456;
constexpr int EPI_LDS = 131072;

constexpr size_t MiB = 1u << 20;
constexpr size_t WS_CTL = 0, CTL_BYTES = 1 * MiB;
constexpr size_t CTL_FLAG = 40960;
constexpr size_t CTL_XBAR = 262144;
constexpr size_t CTL_KMAX = 32768;
constexpr size_t CTL_C1IN = 65536, CTL_C2IN = 81920, CTL_C1GU = 98304, CTL_C2GU = 147456;
constexpr size_t WS_LAM = 1 * MiB;
constexpr size_t WS_WIN = 2 * MiB, WS_WOUT = 15 * MiB, WS_WGU = 19 * MiB, WS_WDN = 41 * MiB;
constexpr size_t WS_ST1 = 52 * MiB, WS_ST2 = 54 * MiB, WS_GATES = 56 * MiB, WS_EDGE = 60 * MiB;
constexpr size_t WS_XB = 80 * MiB, WS_MIXED = 208 * MiB, WS_PROJ = 336 * MiB, WS_HDIR = 720 * MiB, WS_VB = 848 * MiB, WS_END = 976 * MiB;

__device__ __forceinline__ unsigned cvt_pk_bf16(float lo, float hi) { unsigned r; asm volatile("v_cvt_pk_bf16_f32 %0, %1, %2" : "=v"(r) : "v"(lo), "v"(hi)); return r; }
__device__ __forceinline__ unsigned cvt4_fp8(float a, float b, float c, float d) { int w = 0; w = __builtin_amdgcn_cvt_pk_fp8_f32(a, b, w, false); w = __builtin_amdgcn_cvt_pk_fp8_f32(c, d, w, true); return (unsigned)w; }
__device__ __forceinline__ float bf2f(bf16_t b) { return __uint_as_float(((unsigned)b) << 16); }
__device__ __forceinline__ bf16_t f2bf(float f) { return (bf16_t)(cvt_pk_bf16(f, 0.f) & 0xffffu); }
__device__ __forceinline__ float gelu_erf(float v) {
    const float av = fabsf(v), t = __builtin_amdgcn_rcpf(av * 0.2316418882f + 1.0f);
    float q = t * 0.5307027145f + (-0.7265760135f); q = q * t + 0.7107068705f; q = q * t + (-0.142248368f); q = q * t + 0.127414796f; q = q * t;
    const float e = __builtin_amdgcn_exp2f((v * v) * (-0.72134752044f));
    const float m = v * (q * e);
    return v < 0.f ? m : v - m;
}
__device__ __forceinline__ int crow(int r, int hi) { return (r & 3) + 8 * (r >> 2) + 4 * hi; }
#define EPI_BAR() do { asm volatile("s_waitcnt lgkmcnt(0)" ::: "memory"); __builtin_amdgcn_s_barrier(); asm volatile("" ::: "memory"); } while (0)
#define SBAR() __builtin_amdgcn_sched_barrier(0)
__device__ __forceinline__ int opaque_tid() { int t = threadIdx.x; asm volatile("" : "+v"(t)); return t; }

namespace pg8 {
constexpr int BM = 256, BK = 64, HALF = 128, HTB = HALF * BK * 2, STAGE_BYTES = 8 * HTB, NXCD = 8, WGM = 8;
__host__ __device__ __forceinline__ int lds_byte(int r, int c) { const int st = (r >> 4) * 2 + (c >> 5), rr = r & 15, cc = c & 31, ob = rr * 64 + cc * 2; return st * 1024 + (ob ^ (((ob >> 9) & 1) << 5)); }
__host__ __device__ __forceinline__ void stage_rc(int b, int& R, int& C) { const int st = b / 1024, sb = b % 1024, swz = sb ^ (((sb >> 9) & 1) << 5); R = (st >> 1) * 16 + swz / 64; C = (st & 1) * 32 + (swz % 64) / 2; }
__host__ __device__ __forceinline__ int perm32(int rho) { const int n = rho >> 4, i = rho & 15; return 8 * (i >> 2) + 4 * n + (i & 3); }
struct Unit { int pm, pn; };
struct Gemm { const void* A; const void* Bt; int M, N, K; };
typedef int i32x8 __attribute__((ext_vector_type(8)));
struct StaticOrder {
    int nM, nN, nwg, G, c;
    __host__ __device__ void init(int M, int N, int G_, int c_) { nM = M / BM; nN = N / BM; nwg = nM * nN; G = G_; c = c_; }
    __host__ __device__ bool next(int i, Unit& u) const {
        const long L = (long)i * G + c; if (L >= nwg) return false;
        int wgid = (int)L; { const int q = nwg / NXCD, r = nwg % NXCD, xcd = wgid % NXCD, off = wgid / NXCD; wgid = (xcd < r ? xcd * (q + 1) : r * (q + 1) + (xcd - r) * q) + off; }
        const int nig = WGM * nN, gid = wgid / nig, fm = gid * WGM, gsz = (nM - fm) < WGM ? (nM - fm) : WGM;
        u.pm = fm + ((wgid % nig) % gsz); u.pn = (wgid % nig) / gsz; return true;
    }
    __device__ __forceinline__ void a_ready(const Unit&) const {}
    __device__ __forceinline__ void done(const Unit&) const {}
};

template <class Epi, class Sched, bool FP8 = false>
__device__ __forceinline__ void gemm_phase(LAS unsigned char* lds, const Gemm g, const Sched& S, const Epi& E) {
    const int tid = opaque_tid(), wid = __builtin_amdgcn_readfirstlane(tid >> 6), lane = tid & 63, wr = wid >> 2, wc = wid & 3, fr = lane & 15, fq = lane >> 4;
    const int pitch = FP8 ? g.K : 2 * g.K, nt = pitch / 128;
    unsigned voffA[2], voffB[2];
#pragma unroll
    for (int i = 0; i < 2; ++i) { int R, C; stage_rc(tid * 16 + i * 8192, R, C); const int Rb = Epi::PERM ? ((R & ~31) + perm32(R & 31)) : R;
        voffA[i] = (unsigned)(R * pitch + 2 * C); voffB[i] = (unsigned)(Rb * pitch + 2 * C); }
    const size_t kstep = (size_t)128;
    const size_t hstep = (size_t)HALF * pitch;
    const size_t tstep = 2 * hstep;
    const unsigned ldsw = (unsigned)wid * 1024u;
    const int aoff0 = FP8 ? lds_byte(wr * 64 + fr, 16 * fq) : lds_byte(wr * 64 + fr, fq * 8), aoff1 = aoff0 + (FP8 ? 16 : 1024);
    const int boff0 = FP8 ? lds_byte(wc * 32 + fr, 16 * fq) : lds_byte(wc * 32 + fr, fq * 8), boff1 = boff0 + (FP8 ? 16 : 1024);
#define PG8_SA(b, h) (((b) * 2 + (h)) * HTB)
#define PG8_SB(b, h) ((4 + (b) * 2 + (h)) * HTB)
#define PG8_STAGE(bufoff, gbase, voff) do { _Pragma("unroll") for (int _i = 0; _i < 2; ++_i) \
        __builtin_amdgcn_global_load_lds((const unsigned*)((const char*)(gbase) + (voff)[_i]), (LAS unsigned*)(lds + (bufoff) + ldsw + _i * 8192), 16, 0, 0); } while (0)
#define PG8_RD16(off) (*(const LAS bf16x8*)(lds + (off)))
#define PG8_CAT8(lo, hi) __builtin_bit_cast(i32x8, __builtin_shufflevector((lo), (hi), 0, 1, 2, 3, 4, 5, 6, 7, 8, 9, 10, 11, 12, 13, 14, 15))
#define PG8_LDA(dst, b, h) do { _Pragma("unroll") for (int m = 0; m < 4; ++m) { \
        if constexpr (FP8) { const bf16x8 lo_ = PG8_RD16(PG8_SA(b, h) + aoff0 + m * 2048), hi_ = PG8_RD16(PG8_SA(b, h) + aoff1 + m * 2048); dst##8[m] = PG8_CAT8(lo_, hi_); } \
        else { dst[m][0] = PG8_RD16(PG8_SA(b, h) + aoff0 + m * 2048); dst[m][1] = PG8_RD16(PG8_SA(b, h) + aoff1 + m * 2048); } } } while (0)
#define PG8_LDB(dst, b, h) do { _Pragma("unroll") for (int n = 0; n < 2; ++n) { \
        if constexpr (FP8) { const bf16x8 lo_ = PG8_RD16(PG8_SB(b, h) + boff0 + n * 2048), hi_ = PG8_RD16(PG8_SB(b, h) + boff1 + n * 2048); dst##8[n] = PG8_CAT8(lo_, hi_); } \
        else { dst[n][0] = PG8_RD16(PG8_SB(b, h) + boff0 + n * 2048); dst[n][1] = PG8_RD16(PG8_SB(b, h) + boff1 + n * 2048); } } } while (0)
#define PG8_MMA(ai, bj, At, Bt) do { __builtin_amdgcn_s_setprio(1); _Pragma("unroll") for (int m = 0; m < 4; ++m) _Pragma("unroll") for (int n = 0; n < 2; ++n) { \
        if constexpr (FP8) asm volatile("v_mfma_f32_16x16x128_f8f6f4 %0, %1, %2, %0" : "+v"(acc[ai][bj][m][n]) : "v"(Bt##8[n]), "v"(At##8[m]));   \
        else { _Pragma("unroll") for (int k = 0; k < 2; ++k) acc[ai][bj][m][n] = __builtin_amdgcn_mfma_f32_16x16x32_bf16(Bt[n][k], At[m][k], acc[ai][bj][m][n], 0, 0, 0); } } \
        __builtin_amdgcn_s_setprio(0); } while (0)
#define PG8_WAIT_V(n) asm volatile("s_waitcnt vmcnt(" #n ")" ::: "memory")
#define PG8_WAIT_L(n) asm volatile("s_waitcnt lgkmcnt(" #n ")" ::: "memory")
#define PG8_BAR __builtin_amdgcn_s_barrier()
#define PG8_SCHED __builtin_amdgcn_sched_barrier(0)
    Unit cur, nxt; int ui = 0;
    if (!S.next(0, cur)) return;
    f32x4 acc[2][2][4][2];
#pragma unroll
    for (int a = 0; a < 2; ++a)
#pragma unroll
        for (int b = 0; b < 2; ++b)
#pragma unroll
            for (int m = 0; m < 4; ++m)
#pragma unroll
                for (int n = 0; n < 2; ++n) acc[a][b][m][n] = (f32x4){0.f, 0.f, 0.f, 0.f};
    bf16x8 At[4][2], B0[2][2], B1[2][2]; i32x8 At8[4], B08[2], B18[2];
    const char* cA = (const char*)g.A + (size_t)cur.pm * tstep; const char* cB = (const char*)g.Bt + (size_t)cur.pn * tstep;
    PG8_STAGE(PG8_SB(0, 0), cB, voffB); PG8_STAGE(PG8_SB(0, 1), cB + hstep, voffB); PG8_STAGE(PG8_SA(0, 0), cA, voffA); PG8_STAGE(PG8_SA(0, 1), cA + hstep, voffA);
    if (wr == 1) PG8_BAR;
    PG8_WAIT_V(2); PG8_BAR;
    PG8_STAGE(PG8_SB(1, 0), cB + kstep, voffB); PG8_STAGE(PG8_SA(1, 0), cA + kstep, voffA); PG8_STAGE(PG8_SB(1, 1), cB + hstep + kstep, voffB);
    PG8_WAIT_V(6); PG8_BAR;
    for (;;) {
        const bool has_next = S.next(ui + 1, nxt);
        const char* nA = has_next ? (const char*)g.A + (size_t)nxt.pm * tstep : cA; const char* nB = has_next ? (const char*)g.Bt + (size_t)nxt.pn * tstep : cB;
#pragma unroll 1
        for (int t = 0; t < nt; t += 2) {
            const bool last = (t == nt - 2);
            const char* a1 = cA + (size_t)(t + 1) * kstep;
            const char* a2 = last ? nA : cA + (size_t)(t + 2) * kstep; const char* b2 = last ? nB : cB + (size_t)(t + 2) * kstep;
            const char* a3 = a2 + kstep; const char* b3 = b2 + kstep;
            PG8_LDB(B0, 0, 0); PG8_LDB(B1, 0, 1); PG8_SCHED; PG8_LDA(At, 0, 0); PG8_STAGE(PG8_SA(1, 1), a1 + hstep, voffA);
            PG8_WAIT_V(8); PG8_WAIT_L(0); PG8_BAR; PG8_MMA(0, 0, At, B0); PG8_MMA(0, 1, At, B1); PG8_BAR; PG8_SCHED;
            PG8_LDA(At, 0, 1); PG8_STAGE(PG8_SB(0, 0), b2, voffB); PG8_STAGE(PG8_SB(0, 1), b2 + hstep, voffB); PG8_STAGE(PG8_SA(0, 0), a2, voffA);
            PG8_WAIT_V(8); PG8_WAIT_L(0); PG8_BAR; PG8_MMA(1, 0, At, B0); PG8_MMA(1, 1, At, B1); PG8_BAR; PG8_SCHED;
            PG8_LDB(B0, 1, 0); PG8_LDB(B1, 1, 1); PG8_SCHED; PG8_LDA(At, 1, 0); PG8_STAGE(PG8_SA(0, 1), a2 + hstep, voffA);
            PG8_WAIT_V(8); PG8_WAIT_L(0); PG8_BAR; PG8_MMA(0, 0, At, B0); PG8_MMA(0, 1, At, B1); PG8_BAR; PG8_SCHED;
            PG8_LDA(At, 1, 1); PG8_STAGE(PG8_SB(1, 0), b3, voffB); PG8_STAGE(PG8_SB(1, 1), b3 + hstep, voffB); PG8_STAGE(PG8_SA(1, 0), a3, voffA);
            PG8_WAIT_V(8); PG8_WAIT_L(0); PG8_BAR; PG8_MMA(1, 0, At, B0); PG8_MMA(1, 1, At, B1); PG8_BAR; PG8_SCHED;
        }
        if (wr == 0) PG8_BAR;
        if constexpr (FP8) asm volatile("s_nop 15\n\ts_nop 15" ::: "memory");
        E(acc, cur, wr, wc, fr, fq);
        if (!has_next) break;
#pragma unroll
        for (int a = 0; a < 2; ++a)
#pragma unroll
            for (int b = 0; b < 2; ++b)
#pragma unroll
                for (int m = 0; m < 4; ++m)
#pragma unroll
                    for (int n = 0; n < 2; ++n) acc[a][b][m][n] = (f32x4){0.f, 0.f, 0.f, 0.f};
        cur = nxt; cA = nA; cB = nB; ++ui;
        if (wr == 1) PG8_BAR;
    }
    PG8_WAIT_V(0);
    PG8_BAR;
#undef PG8_SA
#undef PG8_SB
#undef PG8_STAGE
#undef PG8_LDA
#undef PG8_LDB
#undef PG8_MMA
#undef PG8_CAT8
#undef PG8_RD16
#undef PG8_WAIT_V
#undef PG8_WAIT_L
#undef PG8_BAR
#undef PG8_SCHED
}
}

__device__ __forceinline__ f32x2 gelu_pk(f32x2 v) {
    const f32x2 av = __builtin_elementwise_abs(v), d = av * 0.2316418882f + 1.0f;
    f32x2 t; t.x = __builtin_amdgcn_rcpf(d.x); t.y = __builtin_amdgcn_rcpf(d.y);
    f32x2 q = t * 0.5307027145f + (-0.7265760135f); q = q * t + 0.7107068705f; q = q * t + (-0.142248368f); q = q * t + 0.127414796f; q = q * t;
    const f32x2 s = (v * v) * (-0.72134752044f);
    f32x2 e; e.x = __builtin_amdgcn_exp2f(s.x); e.y = __builtin_amdgcn_exp2f(s.y);
    const f32x2 m = v * (q * e), r = v - m;
    f32x2 o; o.x = v.x < 0.f ? m.x : r.x; o.y = v.y < 0.f ? m.y : r.y; return o;
}
__device__ __forceinline__ void row_stats(const f32x2* st, int row, float& mu, float& rstd) {
    const f32x4 a = *(const f32x4*)(st + (size_t)row * 4), b = *(const f32x4*)(st + (size_t)row * 4 + 2);
    const float s = (a[0] + a[2]) + (b[0] + b[2]), q = (a[1] + a[3]) + (b[1] + b[3]);
    mu = s * (1.f / 1024.f); const float var = fmaxf(q * (1.f / 1024.f) - mu * mu, 0.f); rstd = rsqrtf(var + EPS);
}

__device__ __forceinline__ void tile_stats_to_lds(const f32x2* st, int row0, LAS f32x2* S, int tid) {
    if (tid < 256) { float mu, rstd; row_stats(st, row0 + tid, mu, rstd); S[tid] = (f32x2){mu, rstd}; }
    EPI_BAR();
}
struct EpiProj {
    static constexpr bool PERM = true;
    bf16_t* O; float* gates; const float* gate_bias; const f32x2* stats; const float* c1; const float* c2; LAS f32x2* S;
    __device__ __forceinline__ void operator()(f32x4 (&acc)[2][2][4][2], const pg8::Unit& u, int wr, int wc, int fr, int fq) const {
        asm volatile("" : "+v"(fr), "+v"(fq));
        const int colt = u.pn * 256 + wc * 32 + 8 * fq;
        if (stats) tile_stats_to_lds(stats, u.pm * 256, S, (wr * 4 + wc) * 64 + fq * 16 + fr);
        f32x4 c1v[2][2], c2v[2][2];
#pragma unroll
        for (int bj = 0; bj < 2; ++bj)
#pragma unroll
            for (int n = 0; n < 2; ++n) {
                if (stats) { c1v[bj][n] = *(const f32x4*)(c1 + colt + bj * 128 + 4 * n); c2v[bj][n] = *(const f32x4*)(c2 + colt + bj * 128 + 4 * n); }
                else { c1v[bj][n] = (f32x4){0.f, 0.f, 0.f, 0.f}; c2v[bj][n] = (f32x4){0.f, 0.f, 0.f, 0.f}; } }
        const float sc = (u.pn < 2 || u.pn == 7) ? 0.125f : 1.0f;
#pragma unroll
        for (int ai = 0; ai < 2; ++ai)
#pragma unroll
            for (int m = 0; m < 4; ++m) {
                const int row = u.pm * 256 + ai * 128 + wr * 64 + m * 16 + fr;
                float mu = 0.f, rstd = 1.f; if (stats) { const f32x2 sr = S[ai * 128 + wr * 64 + m * 16 + fr]; mu = sr.x; rstd = sr.y; }
                if (u.pn < 12) {
#pragma unroll
                    for (int bj = 0; bj < 2; ++bj) {
                        const f32x4 v0 = ((acc[ai][bj][m][0] - mu * c1v[bj][0]) * rstd + c2v[bj][0]) * sc, v1 = ((acc[ai][bj][m][1] - mu * c1v[bj][1]) * rstd + c2v[bj][1]) * sc;
                        u32x4 w; w.x = cvt_pk_bf16(v0[0], v0[1]); w.y = cvt_pk_bf16(v0[2], v0[3]); w.z = cvt_pk_bf16(v1[0], v1[1]); w.w = cvt_pk_bf16(v1[2], v1[3]);
                        *(u32x4*)(O + (size_t)row * NPROJ + colt + bj * 128) = w; }
                } else if (wc == 0 && fq < 2) {
#pragma unroll
                    for (int n = 0; n < 2; ++n) {
                        const f32x4 gb = *(const f32x4*)(gate_bias + 8 * fq + 4 * n);
                        *(f32x4*)(gates + (size_t)row * 16 + 8 * fq + 4 * n) = (acc[ai][0][m][n] - mu * c1v[0][n]) * rstd + c2v[0][n] + gb; }
                }
            }
    }
};

__device__ __forceinline__ unsigned pkh2(float a, float b) { return (unsigned)__builtin_bit_cast(unsigned short, (_Float16)a) | ((unsigned)__builtin_bit_cast(unsigned short, (_Float16)b) << 16); }
__device__ __forceinline__ f32x4 unph4(unsigned x, unsigned y) { return (f32x4){(float)__builtin_bit_cast(_Float16, (unsigned short)(x & 0xffffu)), (float)__builtin_bit_cast(_Float16, (unsigned short)(x >> 16)),
                                                                                (float)__builtin_bit_cast(_Float16, (unsigned short)(y & 0xffffu)), (float)__builtin_bit_cast(_Float16, (unsigned short)(y >> 16))}; }
__device__ __forceinline__ f32x4 unpk4(u32x2 p) { return (f32x4){__uint_as_float(p.x << 16), __uint_as_float(p.x & 0xffff0000u), __uint_as_float(p.y << 16), __uint_as_float(p.y & 0xffff0000u)}; }
template <bool SRC_BF16> struct EpiRes {
    static constexpr bool PERM = true;
    const bf16_t* src; bf16_t* dst; const f32x2* st_in; const float* g_in; const float* b_in; f32x2* st_out; LAS f32x2* P; LAS f32x2* S; unsigned char* xb8; float accs; bf16_t* xb;
    __device__ __forceinline__ void operator()(f32x4 (&acc)[2][2][4][2], const pg8::Unit& u, int wr, int wc, int fr, int fq) const {
        asm volatile("" : "+v"(fr), "+v"(fq));
        const int colb = u.pn * 256 + wc * 32 + 8 * fq;
        u32x2 pk[2][2][4][2];
#pragma unroll
        for (int ai = 0; ai < 2; ++ai)
#pragma unroll
            for (int bj = 0; bj < 2; ++bj)
#pragma unroll
                for (int m = 0; m < 4; ++m)
#pragma unroll
                    for (int n = 0; n < 2; ++n) { const f32x4 a = acc[ai][bj][m][n] * accs; pk[ai][bj][m][n] = (u32x2){cvt_pk_bf16(a[0], a[1]), cvt_pk_bf16(a[2], a[3])}; }
        u32x4 xr[2][4][2];
#pragma unroll
        for (int ai = 0; ai < 2; ++ai)
#pragma unroll
            for (int m = 0; m < 4; ++m)
#pragma unroll
                for (int bj = 0; bj < 2; ++bj) xr[ai][m][bj] = *(const u32x4*)(src + (size_t)(u.pm * 256 + ai * 128 + wr * 64 + m * 16 + fr) * DM + colb + bj * 128);
        if (st_in) tile_stats_to_lds(st_in, u.pm * 256, S, (wr * 4 + wc) * 64 + fq * 16 + fr);
        f32x4 gv[2][2], bv[2][2];
#pragma unroll
        for (int bj = 0; bj < 2; ++bj)
#pragma unroll
            for (int n = 0; n < 2; ++n) {
                if (st_in) { gv[bj][n] = *(const f32x4*)(g_in + colb + bj * 128 + n * 4); bv[bj][n] = *(const f32x4*)(b_in + colb + bj * 128 + n * 4); }
                else { gv[bj][n] = (f32x4){1.f, 1.f, 1.f, 1.f}; bv[bj][n] = (f32x4){0.f, 0.f, 0.f, 0.f}; } }
        SBAR();
#pragma unroll
        for (int ai = 0; ai < 2; ++ai) {
#pragma unroll
            for (int m = 0; m < 4; ++m) {
                const int rl = ai * 128 + wr * 64 + m * 16 + fr; const int row = u.pm * 256 + rl;
                float mu = 0.f, rstd = 1.f; if (st_in) { const f32x2 sr = S[rl]; mu = sr.x; rstd = sr.y; }
                float s = 0.f, q = 0.f;
#pragma unroll
                for (int bj = 0; bj < 2; ++bj) {
                    const size_t off = (size_t)row * DM + colb + bj * 128;
                    const u32x4 xw = xr[ai][m][bj];
                    f32x4 x0, x1;
                    if constexpr (!SRC_BF16) { x0 = unph4(xw.x, xw.y); x1 = unph4(xw.z, xw.w); }
                    else { x0 = unpk4((u32x2){xw.x, xw.y}); x1 = unpk4((u32x2){xw.z, xw.w}); }
                    const f32x4 o0 = ((x0 - mu) * rstd * gv[bj][0] + bv[bj][0]) * ALPHA + unpk4(pk[ai][bj][m][0]);
                    const f32x4 o1 = ((x1 - mu) * rstd * gv[bj][1] + bv[bj][1]) * ALPHA + unpk4(pk[ai][bj][m][1]);
                    { u32x4 w; w.x = pkh2(o0[0], o0[1]); w.y = pkh2(o0[2], o0[3]); w.z = pkh2(o1[0], o1[1]); w.w = pkh2(o1[2], o1[3]); *(u32x4*)(dst + off) = w; }
                    if (xb) { u32x4 w; w.x = cvt_pk_bf16(o0[0], o0[1]); w.y = cvt_pk_bf16(o0[2], o0[3]); w.z = cvt_pk_bf16(o1[0], o1[1]); w.w = cvt_pk_bf16(o1[2], o1[3]); *(u32x4*)(xb + off) = w; }
                    if (xb8) { u32x2 w; w.x = cvt4_fp8(o0[0], o0[1], o0[2], o0[3]); w.y = cvt4_fp8(o1[0], o1[1], o1[2], o1[3]); *(u32x2*)(xb8 + off) = w; }
                    s += ((o0[0] + o0[1]) + (o0[2] + o0[3])) + ((o1[0] + o1[1]) + (o1[2] + o1[3]));
                    q += ((o0[0] * o0[0] + o0[1] * o0[1]) + (o0[2] * o0[2] + o0[3] * o0[3])) + ((o1[0] * o1[0] + o1[1] * o1[1]) + (o1[2] * o1[2] + o1[3] * o1[3]));
                }
                s += __shfl_xor(s, 16); s += __shfl_xor(s, 32); q += __shfl_xor(q, 16); q += __shfl_xor(q, 32);
                if (fq == 0) P[rl * 4 + wc] = (f32x2){s, q};
            }
            SBAR();
        }
        EPI_BAR();
        const int tid = (wr * 4 + wc) * 64 + fq * 16 + fr;
        if (tid < 256) {
            const f32x2 a = P[tid * 4 + 0], b = P[tid * 4 + 1], c = P[tid * 4 + 2], d = P[tid * 4 + 3];
            st_out[(size_t)(u.pm * 256 + tid) * 4 + u.pn] = (f32x2){(a.x + b.x) + (c.x + d.x), (a.y + b.y) + (c.y + d.y)};
        }
    }
};

struct EpiGU {
    static constexpr bool PERM = false;
    unsigned char* hmid  ; float* edge; const f32x2* stats; const float* c1; const float* c2; const float* cw; const float* cb; LAS float* halo; LAS f32x2* S;
    __device__ __forceinline__ void operator()(f32x4 (&acc)[2][2][4][2], const pg8::Unit& u, int wr, int wc, int fr, int fq) const {
        asm volatile("" : "+v"(fr), "+v"(fq));
        const int colb = wc * 32 + 4 * fq; const int lane = fq * 16 + fr;
        const int jch0 = u.pn * 128 + colb;
        tile_stats_to_lds(stats, u.pm * 256, S, (wr * 4 + wc) * 64 + lane);
        u32x2 gk[2][4][2], uk[2][4][2];
        {
            f32x4 c1v[2][2], c2v[2][2];
#pragma unroll
            for (int bj = 0; bj < 2; ++bj)
#pragma unroll
                for (int n = 0; n < 2; ++n) { c1v[bj][n] = *(const f32x4*)(c1 + u.pn * 256 + bj * 128 + colb + 16 * n); c2v[bj][n] = *(const f32x4*)(c2 + u.pn * 256 + bj * 128 + colb + 16 * n); }
#pragma unroll
            for (int ai = 0; ai < 2; ++ai)
#pragma unroll
                for (int m = 0; m < 4; ++m) {
                    const f32x2 sr = S[ai * 128 + wr * 64 + m * 16 + fr]; const float mu = sr.x, rstd = sr.y;
                    const int blk = ai * 2 + wr;
#pragma unroll
                    for (int n = 0; n < 2; ++n) {
                        const f32x4 gv = (acc[ai][0][m][n] * (1.0f / 64.0f) - mu * c1v[0][n]) * rstd + c2v[0][n];
                        const f32x4 uv = (acc[ai][1][m][n] * (1.0f / 64.0f) - mu * c1v[1][n]) * rstd + c2v[1][n];
                        gk[ai][m][n].x = cvt_pk_bf16(gv[0], gv[1]); gk[ai][m][n].y = cvt_pk_bf16(gv[2], gv[3]);
                        uk[ai][m][n].x = cvt_pk_bf16(uv[0], uv[1]); uk[ai][m][n].y = cvt_pk_bf16(uv[2], uv[3]);
                        if (m == 0) {
                            if (fr == 0) *(LAS u32x2*)(halo + (blk * 2 + 0) * 128 + (colb + 16 * n) / 2) = gk[ai][m][n];
                            if (ai == 0 && wr == 0 && fr <= 1) *(f32x4*)(edge + ((size_t)u.pm * 6 + fr) * DFF + jch0 + 16 * n) = gv;
                            if (ai == 0 && wr == 0 && fr == 0) *(f32x4*)(edge + ((size_t)u.pm * 6 + 4) * DFF + jch0 + 16 * n) = uv;
                        }
                        if (m == 3) {
                            if (fr == 15) *(LAS u32x2*)(halo + (blk * 2 + 1) * 128 + (colb + 16 * n) / 2) = gk[ai][m][n];
                            if (ai == 1 && wr == 1 && fr >= 14) *(f32x4*)(edge + ((size_t)u.pm * 6 + 2 + (fr - 14)) * DFF + jch0 + 16 * n) = gv;
                            if (ai == 1 && wr == 1 && fr == 15) *(f32x4*)(edge + ((size_t)u.pm * 6 + 5) * DFF + jch0 + 16 * n) = uv;
                        }
                    }
                    SBAR();
                }
        }
        EPI_BAR(); SBAR();
#define BLO(x) __uint_as_float((x) << 16)
#define BHI(x) __uint_as_float((x) & 0xffff0000u)
#pragma unroll
        for (int n = 0; n < 2; ++n) {
            const f32x4 w0 = *(const f32x4*)(cw + jch0 + 16 * n), w1 = *(const f32x4*)(cw + DFF + jch0 + 16 * n), w2 = *(const f32x4*)(cw + 2 * DFF + jch0 + 16 * n), cbv = *(const f32x4*)(cb + jch0 + 16 * n);
#pragma unroll
            for (int ai = 0; ai < 2; ++ai) {
                const int blk = ai * 2 + wr;
                u32x2 top = (u32x2){0u, 0u}, bot = (u32x2){0u, 0u};
                if (blk > 0) top = *(const LAS u32x2*)(halo + ((blk - 1) * 2 + 1) * 128 + (colb + 16 * n) / 2);
                if (blk < 3) bot = *(const LAS u32x2*)(halo + ((blk + 1) * 2 + 0) * 128 + (colb + 16 * n) / 2);
                u32x2 hk[4];
#pragma unroll
                for (int w = 0; w < 2; ++w) {
                    unsigned a_[4], c_[4];
#pragma unroll
                    for (int m = 0; m < 4; ++m) { const unsigned gv = gk[ai][m][n][w];
                        a_[m] = (unsigned)__builtin_amdgcn_update_dpp(0, (int)gv, 0x121, 0xf, 0xf, false);
                        c_[m] = (unsigned)__builtin_amdgcn_update_dpp(0, (int)gv, 0x12f, 0xf, 0xf, false); }
                    const f32x2 cb2 = (f32x2){cbv[2 * w], cbv[2 * w + 1]}, w02 = (f32x2){w0[2 * w], w0[2 * w + 1]}, w12 = (f32x2){w1[2 * w], w1[2 * w + 1]}, w22 = (f32x2){w2[2 * w], w2[2 * w + 1]};
#pragma unroll
                    for (int m = 0; m < 4; ++m) {
                        const unsigned prev = (fr > 0) ? a_[m] : (m > 0 ? a_[m > 0 ? m - 1 : 0] : top[w]);
                        const unsigned next = (fr < 15) ? c_[m] : (m < 3 ? c_[m < 3 ? m + 1 : 3] : bot[w]);
                        const unsigned cur = gk[ai][m][n][w], upw = uk[ai][m][n][w];
                        const f32x2 cv = cb2 + w02 * (f32x2){BLO(prev), BHI(prev)} + w12 * (f32x2){BLO(cur), BHI(cur)} + w22 * (f32x2){BLO(next), BHI(next)};
                        const f32x2 hv2 = gelu_pk(cv) * (f32x2){BLO(upw), BHI(upw)};
                        hk[m][w] = cvt_pk_bf16(hv2.x, hv2.y);
                    }
                    SBAR();
                }
#pragma unroll
                for (int m = 0; m < 4; ++m) {
                    const int rl = ai * 128 + wr * 64 + m * 16 + fr;
                    if (rl != 0 && rl != 255) *(unsigned*)(hmid + (size_t)(u.pm * 256 + rl) * DFF + jch0 + 16 * n) = cvt4_fp8(BLO(hk[m].x) * 16.f, BHI(hk[m].x) * 16.f, BLO(hk[m].y) * 16.f, BHI(hk[m].y) * 16.f);
                }
                SBAR();
            }
        }
#undef BLO
#undef BHI
    }
};

namespace att {
constexpr int KVBLK = 64, SHM_V = 16384, SHM_K = 16384, WS_OFF = 73728, OB_PITCH = 132;
#define KSWZ(row, colB) ((row) * 256 + ((colB) ^ (((row) & 7) << 4)))
__device__ __forceinline__ void alibi(f32x16& p0, f32x16& p1, float t0, float nslope) {
#pragma unroll
    for (int r = 0; r < 16; ++r) { const float kr = (float)((r & 3) + 8 * (r >> 2));
        p0[r] = fmaf(nslope, fabsf(t0 - kr), p0[r]); p1[r] = fmaf(nslope, fabsf(t0 - kr - 32.f), p1[r]); }
}
__device__ __forceinline__ void partialSM(f32x16& p0, f32x16& p1, float mC) {
    constexpr float C = 1.4426950408889634f;
#pragma unroll
    for (int r = 0; r < 16; ++r) p0[r] = fmaf(p0[r], C, mC);
#pragma unroll
    for (int r = 0; r < 16; ++r) p1[r] = fmaf(p1[r], C, mC);
#pragma unroll
    for (int r = 0; r < 16; ++r) p0[r] = __builtin_amdgcn_exp2f(p0[r]);
}
__device__ __forceinline__ void finishSM(f32x16& p0, f32x16& p1, float& l_reg, bf16x8& pa0, bf16x8& pa1, bf16x8& pa2, bf16x8& pa3) {
#pragma unroll
    for (int r = 0; r < 16; ++r) p1[r] = __builtin_amdgcn_exp2f(p1[r]);
    float ps = 0;
#pragma unroll
    for (int r = 0; r < 16; ++r) ps += p0[r];
#pragma unroll
    for (int r = 0; r < 16; ++r) ps += p1[r];
    { auto rr = __builtin_amdgcn_permlane32_swap(__float_as_uint(ps), __float_as_uint(ps), false, false);
      ps = __uint_as_float(rr[0]) + __uint_as_float(rr[1]); }
    l_reg += ps;
#define PK4(P, BASE, OUT) do { unsigned a0 = cvt_pk_bf16(P[BASE + 0], P[BASE + 1]), a1 = cvt_pk_bf16(P[BASE + 2], P[BASE + 3]);   \
    unsigned b0 = cvt_pk_bf16(P[BASE + 4], P[BASE + 5]), b1 = cvt_pk_bf16(P[BASE + 6], P[BASE + 7]);                              \
    auto r0 = __builtin_amdgcn_permlane32_swap(a0, b0, false, false); auto r1 = __builtin_amdgcn_permlane32_swap(a1, b1, false, false); \
    u32x4 w = {r0[0], r1[0], r0[1], r1[1]}; OUT = *reinterpret_cast<bf16x8*>(&w); } while (0)
    PK4(p0, 0, pa0); PK4(p0, 8, pa1); PK4(p1, 0, pa2); PK4(p1, 8, pa3);
#undef PK4
}
__device__ __forceinline__ void qkt(f32x16& p0, f32x16& p1, const LAS char* Ks, const bf16x8* qr, int r32, int hi, int c) {
    p0 = f32x16{}; p1 = f32x16{};
#pragma unroll
    for (int d0 = 0; d0 < 4; ++d0) { const int cb = ((c * 4 + d0) * 16 + hi * 8) * 2;
        const bf16x8 b0 = *reinterpret_cast<const LAS bf16x8*>(Ks + KSWZ(r32, cb));
        const bf16x8 b1 = *reinterpret_cast<const LAS bf16x8*>(Ks + KSWZ(32 + r32, cb));
        p0 = __builtin_amdgcn_mfma_f32_32x32x16_bf16(b0, qr[d0], p0, 0, 0, 0);
        p1 = __builtin_amdgcn_mfma_f32_32x32x16_bf16(b1, qr[d0], p1, 0, 0, 0); }
}
__device__ __forceinline__ int v_st(int k, int c) { const int kk = (k & ~0xC) | ((k & 4) << 1) | ((k & 8) >> 1); return ((kk >> 3) * 4 + (c >> 5)) * 512 + ((kk & 7) * 32 + (c & 31)) * 2; }
__device__ __forceinline__ int v_rd_base(int lane) { return ((lane & 3) << 3) | (((lane >> 2) & 3) << 6) | (((lane >> 4) & 1) << 5) | (((lane >> 5) & 1) << 8); }
constexpr int v_rd_off(int d0, int ks, int half) { return d0 * 512 + ks * 4096 + half * 2048; }
template <int OFF> __device__ __forceinline__ s16x4 tr_read(int vb) {
    s16x4 r; asm volatile("ds_read_b64_tr_b16 %0, %1 offset:%2" : "=&v"(r) : "v"(vb), "i"(OFF) : "memory"); return r;
}
template <int D0> __device__ __forceinline__ void pv_one(f32x16& od, int vb, bf16x8 pa0, bf16x8 pa1, bf16x8 pa2, bf16x8 pa3) {
    const s16x4 l0 = tr_read<v_rd_off(D0, 0, 0)>(vb), h0 = tr_read<v_rd_off(D0, 0, 1)>(vb), l1 = tr_read<v_rd_off(D0, 1, 0)>(vb), h1 = tr_read<v_rd_off(D0, 1, 1)>(vb);
    const s16x4 l2 = tr_read<v_rd_off(D0, 2, 0)>(vb), h2 = tr_read<v_rd_off(D0, 2, 1)>(vb), l3 = tr_read<v_rd_off(D0, 3, 0)>(vb), h3 = tr_read<v_rd_off(D0, 3, 1)>(vb);
    asm volatile("s_waitcnt lgkmcnt(0)" ::: "memory"); SBAR();
#define PK(L, H) (bf16x8){L[0], L[1], L[2], L[3], H[0], H[1], H[2], H[3]}
    od = __builtin_amdgcn_mfma_f32_32x32x16_bf16(pa0, PK(l0, h0), od, 0, 0, 0);
    od = __builtin_amdgcn_mfma_f32_32x32x16_bf16(pa1, PK(l1, h1), od, 0, 0, 0);
    od = __builtin_amdgcn_mfma_f32_32x32x16_bf16(pa2, PK(l2, h2), od, 0, 0, 0);
    od = __builtin_amdgcn_mfma_f32_32x32x16_bf16(pa3, PK(l3, h3), od, 0, 0, 0);
#undef PK
}
__device__ __forceinline__ void pv_d0(f32x16* o, int vb, bf16x8 pa0, bf16x8 pa1, bf16x8 pa2, bf16x8 pa3) {
    pv_one<0>(o[0], vb, pa0, pa1, pa2, pa3); pv_one<1>(o[1], vb, pa0, pa1, pa2, pa3); pv_one<2>(o[2], vb, pa0, pa1, pa2, pa3); pv_one<3>(o[3], vb, pa0, pa1, pa2, pa3);
}

__device__ __forceinline__ void attn_unit(const bf16_t* __restrict__ proj, bf16_t* __restrict__ mixed, const float* __restrict__ att_g,
                                          int seq, long row0, int h, int qb, float lam, float nslope, float oscale, float kmax2, LAS char* lds) {
    const int tid = opaque_tid(), wid = tid >> 6, lane = tid & 63, r32 = lane & 31, hi = lane >> 5, c = wid >> 2, wq = wid & 3;
    LAS char* V_lds = lds; LAS char* K_lds = lds + 2 * SHM_V;
    LAS float* ws = (LAS float*)(lds + WS_OFF) + wid * 64; LAS float* li_l = ws;
    float l_reg = 0; f32x16 o[4] = {}; bf16x8 qr[4];
    const int qrow = qb * 128 + wq * 32 + r32;
    const bf16_t* Qw = proj + (size_t)(row0 + qrow) * NPROJ + h * 128 + c * 64 + hi * 8;
#pragma unroll
    for (int d0 = 0; d0 < 4; ++d0) qr[d0] = *reinterpret_cast<const bf16x8*>(Qw + d0 * 16);
    int tlo, NT; float mC;
    {
        float qs = 0.f;
#pragma unroll
        for (int d0 = 0; d0 < 4; ++d0)
#pragma unroll
            for (int e = 0; e < 8; ++e) { const float qv = bf2f((bf16_t)qr[d0][e]); qs += qv * qv; }
        qs += __shfl_xor(qs, 32);
        mC = -fminf(sqrtf(qs * kmax2) * 1.01f + 1e-3f, 60.0f) * 1.4426950408889634f;
#pragma unroll
        for (int o = 1; o < 32; o <<= 1) qs = fmaxf(qs, __shfl_xor(qs, o));
        if (lane == 0) ws[0] = qs;
        __syncthreads();
        float qm = 0.f;
#pragma unroll
        for (int w = 0; w < 8; ++w) qm = fmaxf(qm, ((LAS float*)(lds + WS_OFF))[w * 64]);
        const float smax = sqrtf(qm * kmax2) * 1.01f + 1e-3f;
        const float dstar = (36.0f + 2.0f * smax) / (-nslope);
        const int ntall = seq / KVBLK;
        int lo = (int)floorf(((float)(qb * 128) - dstar) * (1.0f / 64.0f)), hi_t = (int)floorf(((float)(qb * 128 + 127) + dstar) * (1.0f / 64.0f));
        lo = lo < 0 ? 0 : lo; hi_t = hi_t > ntall - 1 ? ntall - 1 : hi_t;
        if (((hi_t - lo + 1) & 1) != 0) { if (hi_t < ntall - 1) ++hi_t; else --lo; }
        tlo = lo; NT = hi_t - lo + 1;
    }
    const bf16_t* Kh = proj + (size_t)(row0 + tlo * KVBLK) * NPROJ + 512 + h * 128; const bf16_t* Vh = proj + (size_t)(row0 + tlo * KVBLK) * NPROJ + 1024 + h * 128;
    const int sr = tid >> 4, sc = (tid & 15) * 8, vst0 = v_st(sr, sc), vst1 = v_st(32 + sr, sc);
    const int vb0 = (int)(uintptr_t)V_lds + v_rd_base(lane);
    const float qposf = (float)(qrow - 4 * hi - tlo * KVBLK);
    struct { bf16x8 vs0, vs1, ks0, ks1; } sr_[2];
#define SLOAD(i, k0) do { sr_[i].vs0 = *reinterpret_cast<const bf16x8*>(&Vh[(size_t)((k0) + sr) * NPROJ + sc]); sr_[i].vs1 = *reinterpret_cast<const bf16x8*>(&Vh[(size_t)((k0) + 32 + sr) * NPROJ + sc]); \
    sr_[i].ks0 = *reinterpret_cast<const bf16x8*>(&Kh[(size_t)((k0) + sr) * NPROJ + sc]); sr_[i].ks1 = *reinterpret_cast<const bf16x8*>(&Kh[(size_t)((k0) + 32 + sr) * NPROJ + sc]); } while (0)
#define SWRITE(b, i) do { *(LAS bf16x8*)(V_lds + (b) * SHM_V + vst0) = sr_[i].vs0;          \
    *(LAS bf16x8*)(V_lds + (b) * SHM_V + vst1) = sr_[i].vs1; const int kc = sc * 2;               \
    *(LAS bf16x8*)(K_lds + (b) * SHM_K + KSWZ(sr, kc)) = sr_[i].ks0;                       \
    *(LAS bf16x8*)(K_lds + (b) * SHM_K + KSWZ(32 + sr, kc)) = sr_[i].ks1; } while (0)
#define SWAIT() asm volatile("s_waitcnt vmcnt(4)" ::: "memory")
    f32x16 pA0, pA1, pB0, pB1; bf16x8 pa0, pa1, pa2, pa3;
    constexpr int SE = 0, SO = 1;
    SLOAD(SE, 0); asm volatile("s_waitcnt vmcnt(0)" ::: "memory"); SWRITE(0, SE); __syncthreads();
    qkt(pA0, pA1, K_lds, qr, r32, hi, c); alibi(pA0, pA1, qposf, nslope); partialSM(pA0, pA1, mC);
    SLOAD(SO, KVBLK); if (2 < NT) SLOAD(SE, 2 * KVBLK);
    SWAIT(); SWRITE(1, SO); __syncthreads();
    for (int j = 1; j + 1 < NT; j += 2) {
        SBAR(); qkt(pB0, pB1, K_lds + SHM_K, qr, r32, hi, c);
        finishSM(pA0, pA1, l_reg, pa0, pa1, pa2, pa3); SBAR();
        SLOAD(SO, (j + 2) * KVBLK); SBAR();
        pv_d0(o, vb0, pa0, pa1, pa2, pa3); alibi(pB0, pB1, qposf - (float)(j * KVBLK), nslope); partialSM(pB0, pB1, mC);
        __syncthreads(); SWAIT(); SWRITE(0, SE);
        __syncthreads();
        SBAR(); qkt(pA0, pA1, K_lds, qr, r32, hi, c);
        finishSM(pB0, pB1, l_reg, pa0, pa1, pa2, pa3); SBAR();
        if (j + 3 < NT) SLOAD(SE, (j + 3) * KVBLK); SBAR();
        pv_d0(o, vb0 + SHM_V, pa0, pa1, pa2, pa3); alibi(pA0, pA1, qposf - (float)((j + 1) * KVBLK), nslope); partialSM(pA0, pA1, mC);
        __syncthreads(); SWAIT(); SWRITE(1, SO);
        __syncthreads();
    }
    SBAR(); qkt(pB0, pB1, K_lds + SHM_K, qr, r32, hi, c);
    finishSM(pA0, pA1, l_reg, pa0, pa1, pa2, pa3); SBAR();
    pv_d0(o, vb0, pa0, pa1, pa2, pa3); alibi(pB0, pB1, qposf - (float)((NT - 1) * KVBLK), nslope); partialSM(pB0, pB1, mC);
    __syncthreads();
    finishSM(pB0, pB1, l_reg, pa0, pa1, pa2, pa3); SBAR();
    pv_d0(o, vb0 + SHM_V, pa0, pa1, pa2, pa3);
    if (hi == 0) li_l[r32] = l_reg; asm volatile("s_waitcnt lgkmcnt(0)" ::: "memory");
    float rli[16];
#pragma unroll
    for (int r = 0; r < 16; ++r) rli[r] = __builtin_amdgcn_rcpf(li_l[crow(r, hi)]);
    __syncthreads();
    LAS float* OB = (LAS float*)lds;
    if (c == 1) {
#pragma unroll
        for (int r = 0; r < 16; ++r) { const int orow = wq * 32 + crow(r, hi);
#pragma unroll
            for (int d0 = 0; d0 < 4; ++d0) OB[orow * OB_PITCH + d0 * 32 + r32] = o[d0][r] * rli[r]; }
    }
    __syncthreads();
    if (c == 0) {
        float gcol[4];
#pragma unroll
        for (int d0 = 0; d0 < 4; ++d0) gcol[d0] = att_g[h * 128 + d0 * 32 + r32] * oscale;
#pragma unroll
        for (int r = 0; r < 16; ++r) { const int orow = wq * 32 + crow(r, hi);
            float dv[4]; float ss = 0.f;
#pragma unroll
            for (int d0 = 0; d0 < 4; ++d0) { dv[d0] = o[d0][r] * rli[r] - lam * OB[orow * OB_PITCH + d0 * 32 + r32]; ss += dv[d0] * dv[d0]; }
            ss += __shfl_xor(ss, 1); ss += __shfl_xor(ss, 2); ss += __shfl_xor(ss, 4); ss += __shfl_xor(ss, 8); ss += __shfl_xor(ss, 16);
            const float rs = rsqrtf(ss * (1.f / 128.f) + EPS);
            bf16_t* orp = mixed + (size_t)(row0 + qb * 128 + orow) * DM + h * 128 + r32;
#pragma unroll
            for (int d0 = 0; d0 < 4; ++d0) orp[d0 * 32] = f2bf(dv[d0] * rs * gcol[d0]); }
    }
    __syncthreads();
#undef SLOAD
#undef SWRITE
#undef SWAIT
}
}

namespace ml {
constexpr int QP = 192, VP = 320, SP = 272, CP = 320;
constexpr int OFF_Q = 0, OFF_K = 24576, OFF_KE = 49152, OFF_V = 73728, OFF_C = 114688, OFF_VEC = 135168;
constexpr int V_U = 0, V_MX = 128, V_EINT = 256, V_EEND = 384, V_EMO = 512, V_QN = 640, V_RS = 768, V_GI = 896, V_GF = 1024, V_NST = 1152, V_NPART = 1216, V_SCAL = 1728;
constexpr int HS_PITCH = 132;
__device__ __forceinline__ s16x4 trr(unsigned addr) { s16x4 r; asm volatile("ds_read_b64_tr_b16 %0, %1" : "=&v"(r) : "v"(addr) : "memory"); return r; }
#define TRWAIT4(a, b, c, d) asm volatile("s_waitcnt lgkmcnt(0)" : "+v"(a), "+v"(b), "+v"(c), "+v"(d) :: "memory")
#define TRWAIT8(a, b, c, d, e, f, g, h) asm volatile("s_waitcnt lgkmcnt(0)" : "+v"(a), "+v"(b), "+v"(c), "+v"(d), "+v"(e), "+v"(f), "+v"(g), "+v"(h) :: "memory")
#define CAT(L, H) (bf16x8){L[0], L[1], L[2], L[3], H[0], H[1], H[2], H[3]}
__device__ __forceinline__ float logsig(float x) { return fminf(x, 0.f) - __logf(1.0f + __expf(-fabsf(x))); }

__device__ __forceinline__ void mlstm_dir(const bf16_t* __restrict__ proj, const float* __restrict__ gates, bf16_t* __restrict__ hdir,
                                          int seq, long row0, int h, int dir, LAS unsigned char* lds) {
    const int tid0 = opaque_tid();
    LAS float* vec = (LAS float*)(lds + OFF_VEC);
    const unsigned lbase = (unsigned)(uintptr_t)lds;
    const int nc = seq / 128;
    constexpr float L2E = 1.4426950408889634f;
    f32x16 Cst = {};
    if (tid0 < 64) vec[V_NST + tid0] = 0.f;
    float m_state = 0.f;
    bf16x8 pq[2], pk[2], pv[4]; float pgi = 0.f, pgf = 0.f;
#define POSB(cb_, j) ((cb_) + (dir ? 127 - (j) : (j)))
#define PREFETCH(cidx) do { const long cb_ = row0 + (long)(cidx) * 128; \
        _Pragma("unroll") for (int i = 0; i < 2; ++i) { const int chunk = tid0 + 512 * i, j = chunk >> 3, c8 = chunk & 7; const bf16_t* src = proj + (size_t)POSB(cb_, j) * NPROJ + h * 64 + c8 * 8; \
            pq[i] = *(const bf16x8*)(src + 1536); pk[i] = *(const bf16x8*)(src + 1792); } \
        _Pragma("unroll") for (int i = 0; i < 4; ++i) { const int chunk = tid0 + 512 * i, j = chunk >> 4, c16 = chunk & 15; \
            pv[i] = *(const bf16x8*)(proj + (size_t)POSB(cb_, j) * NPROJ + 2048 + h * 128 + c16 * 8); } \
        if (tid0 < 128) { const float* gp = gates + (size_t)POSB(cb_, tid0) * 16; pgi = gp[(dir ? 8 : 0) + h]; pgf = gp[(dir ? 12 : 4) + h]; } } while (0)
    PREFETCH(dir ? nc - 1 : 0);
    __syncthreads();
    for (int cc = 0; cc < nc; ++cc) {
        int tid = tid0; asm volatile("" : "+v"(tid));
        const int wid = tid >> 6, lane = tid & 63, r = lane & 31, hh = lane >> 5, i16 = lane & 15, q4 = i16 >> 2, p4 = i16 & 3, blk = (lane >> 4) & 1;
        const int rb = wid >> 1, ch = wid & 1, db = wid >> 2, eb = wid & 3;
        const int c = dir ? nc - 1 - cc : cc;
        const long cbase = row0 + (long)c * 128;
#pragma unroll
        for (int i = 0; i < 2; ++i) { const int chunk = tid + 512 * i, j = chunk >> 3, c8 = chunk & 7;
            *(LAS bf16x8*)(lds + OFF_Q + j * QP + c8 * 16) = pq[i]; *(LAS bf16x8*)(lds + OFF_K + j * QP + c8 * 16) = pk[i]; }
#pragma unroll
        for (int i = 0; i < 4; ++i) { const int chunk = tid + 512 * i, j = chunk >> 4, c16 = chunk & 15; *(LAS bf16x8*)(lds + OFF_V + j * VP + c16 * 16) = pv[i]; }
        if (tid < 128) { vec[V_GI + tid] = pgi; vec[V_GF + tid] = pgf; }
#pragma unroll
        for (int i = 0; i < 16; ++i) *(LAS bf16_t*)(lds + OFF_C + (32 * db + crow(i, hh)) * CP + (32 * eb + r) * 2) = f2bf(Cst[i]);
        __syncthreads();
        if (cc + 1 < nc) PREFETCH(dir ? nc - 2 - cc : cc + 1);
        if (wid == 0) {
            const float gf0 = vec[V_GF + 2 * lane], gf1 = vec[V_GF + 2 * lane + 1], gi0 = vec[V_GI + 2 * lane], gi1 = vec[V_GI + 2 * lane + 1];
            const float lf0 = logsig(gf0), lf1 = logsig(gf1);
            float incl = lf0 + lf1;
#pragma unroll
            for (int d = 1; d < 64; d <<= 1) { const float t = __shfl_up(incl, d); if (lane >= d) incl += t; }
            const float b1 = incl, b0 = incl - lf1, g = __shfl(incl, 63);
            const float u0 = gi0 - b0, u1 = gi1 - b1;
            float cm = fmaxf(u0, u1);
#pragma unroll
            for (int d = 1; d < 64; d <<= 1) { const float t = __shfl_up(cm, d); if (lane >= d) cm = fmaxf(cm, t); }
            float excl = __shfl_up(cm, 1); if (lane == 0) excl = -INFINITY;
            const float cmx0 = fmaxf(excl, u0), cmx1 = cm, umax = __shfl(cm, 63);
            const float mp = m_state, mx0 = fmaxf(mp, cmx0), mx1 = fmaxf(mp, cmx1);
            vec[V_U + 2 * lane] = u0; vec[V_U + 2 * lane + 1] = u1; vec[V_MX + 2 * lane] = mx0; vec[V_MX + 2 * lane + 1] = mx1;
            vec[V_EINT + 2 * lane] = __expf(mp - mx0); vec[V_EINT + 2 * lane + 1] = __expf(mp - mx1);
            vec[V_EEND + 2 * lane] = __expf(u0 - umax); vec[V_EEND + 2 * lane + 1] = __expf(u1 - umax);
            vec[V_EMO + 2 * lane] = __expf(-(b0 + mx0)); vec[V_EMO + 2 * lane + 1] = __expf(-(b1 + mx1));
            const float m_loc = g + umax, m_new = fmaxf(g + mp, m_loc);
            if (lane == 0) { vec[V_SCAL] = __expf(g + mp - m_new); vec[V_SCAL + 1] = __expf(m_loc - m_new); }
            m_state = m_new;
        }
        bf16x8 qa[4];
#pragma unroll
        for (int ks = 0; ks < 4; ++ks) qa[ks] = *(const LAS bf16x8*)(lds + OFF_Q + (32 * rb + r) * QP + (16 * ks + 8 * hh) * 2);
        f32x16 Sv[2] = {}, Ov[2] = {};
#pragma unroll
        for (int t = 0; t < 2; ++t) {
            if (2 * ch + t <= rb) {
#pragma unroll
                for (int ks = 0; ks < 4; ++ks) { const bf16x8 kb = *(const LAS bf16x8*)(lds + OFF_K + (64 * ch + 32 * t + r) * QP + (16 * ks + 8 * hh) * 2);
                    Sv[t] = __builtin_amdgcn_mfma_f32_32x32x16_bf16(qa[ks], kb, Sv[t], 0, 0, 0); } }
        }
#pragma unroll
        for (int t = 0; t < 2; ++t) {
            const unsigned a0 = lbase + OFF_C + (8 * hh + q4) * CP + (64 * ch + 32 * t + 16 * blk + 4 * p4) * 2;
            s16x4 l0 = trr(a0), h0 = trr(a0 + 4 * CP), l1 = trr(a0 + 16 * CP), h1 = trr(a0 + 20 * CP), l2 = trr(a0 + 32 * CP), h2 = trr(a0 + 36 * CP), l3 = trr(a0 + 48 * CP), h3 = trr(a0 + 52 * CP);
            TRWAIT8(l0, h0, l1, h1, l2, h2, l3, h3);
            Ov[t] = __builtin_amdgcn_mfma_f32_32x32x16_bf16(qa[0], CAT(l0, h0), Ov[t], 0, 0, 0);
            Ov[t] = __builtin_amdgcn_mfma_f32_32x32x16_bf16(qa[1], CAT(l1, h1), Ov[t], 0, 0, 0);
            Ov[t] = __builtin_amdgcn_mfma_f32_32x32x16_bf16(qa[2], CAT(l2, h2), Ov[t], 0, 0, 0);
            Ov[t] = __builtin_amdgcn_mfma_f32_32x32x16_bf16(qa[3], CAT(l3, h3), Ov[t], 0, 0, 0);
        }
        { const int j = tid >> 2, part = tid & 3; float s = 0.f;
#pragma unroll
          for (int k2 = 0; k2 < 2; ++k2) { const bf16x8 qv = *(const LAS bf16x8*)(lds + OFF_Q + j * QP + (16 * part + 8 * k2) * 2);
#pragma unroll
              for (int e = 0; e < 8; ++e) s += bf2f((bf16_t)qv[e]) * vec[V_NST + 16 * part + 8 * k2 + e]; }
          s += __shfl_xor(s, 1); s += __shfl_xor(s, 2); if (part == 0) vec[V_QN + j] = s; }
        __syncthreads();
#pragma unroll
        for (int i = 0; i < 2; ++i) { const int chunk = tid + 512 * i, j = chunk >> 3, c8 = chunk & 7; const float ee = vec[V_EEND + j];
            const bf16x8 kv = *(const LAS bf16x8*)(lds + OFF_K + j * QP + c8 * 16); u32x4 w;
            w.x = cvt_pk_bf16(bf2f((bf16_t)kv[0]) * ee, bf2f((bf16_t)kv[1]) * ee); w.y = cvt_pk_bf16(bf2f((bf16_t)kv[2]) * ee, bf2f((bf16_t)kv[3]) * ee);
            w.z = cvt_pk_bf16(bf2f((bf16_t)kv[4]) * ee, bf2f((bf16_t)kv[5]) * ee); w.w = cvt_pk_bf16(bf2f((bf16_t)kv[6]) * ee, bf2f((bf16_t)kv[7]) * ee);
            *(LAS u32x4*)(lds + OFF_KE + j * QP + c8 * 16) = w; }
        {
            const float us0 = vec[V_U + 64 * ch + r] * L2E, us1 = vec[V_U + 64 * ch + 32 + r] * L2E;
#pragma unroll
            for (int i = 0; i < 16; ++i) { const int j = 32 * rb + crow(i, hh); const float mxj = vec[V_MX + j] * L2E, ei = vec[V_EINT + j];
                const int s0 = 64 * ch + r, s1 = s0 + 32;
                Sv[0][i] = (s0 <= j) ? Sv[0][i] * __builtin_amdgcn_exp2f(us0 - mxj) : 0.f;
                Sv[1][i] = (s1 <= j) ? Sv[1][i] * __builtin_amdgcn_exp2f(us1 - mxj) : 0.f;
                Ov[0][i] *= ei; Ov[1][i] *= ei; }
        }
        __syncthreads();
#pragma unroll
        for (int t = 0; t < 2; ++t)
#pragma unroll
            for (int i = 0; i < 16; ++i) *(LAS bf16_t*)(lds + OFF_Q + (32 * rb + crow(i, hh)) * SP + (64 * ch + 32 * t + r) * 2) = f2bf(Sv[t][i]);
        __syncthreads();
#pragma unroll 1
        for (int kp = 0; kp <= rb; ++kp) {
            const bf16x8 a0v = *(const LAS bf16x8*)(lds + OFF_Q + (32 * rb + r) * SP + (32 * kp + 8 * hh) * 2), a1v = *(const LAS bf16x8*)(lds + OFF_Q + (32 * rb + r) * SP + (32 * kp + 16 + 8 * hh) * 2);
            const unsigned a0 = lbase + OFF_V + (32 * kp + 8 * hh + q4) * VP + (64 * ch + 16 * blk + 4 * p4) * 2;
            s16x4 l0 = trr(a0), h0 = trr(a0 + 4 * VP), l1 = trr(a0 + 64), h1 = trr(a0 + 4 * VP + 64);
            s16x4 l2 = trr(a0 + 16 * VP), h2 = trr(a0 + 20 * VP), l3 = trr(a0 + 16 * VP + 64), h3 = trr(a0 + 20 * VP + 64);
            TRWAIT8(l0, h0, l1, h1, l2, h2, l3, h3);
            Ov[0] = __builtin_amdgcn_mfma_f32_32x32x16_bf16(a0v, CAT(l0, h0), Ov[0], 0, 0, 0);
            Ov[1] = __builtin_amdgcn_mfma_f32_32x32x16_bf16(a0v, CAT(l1, h1), Ov[1], 0, 0, 0);
            Ov[0] = __builtin_amdgcn_mfma_f32_32x32x16_bf16(a1v, CAT(l2, h2), Ov[0], 0, 0, 0);
            Ov[1] = __builtin_amdgcn_mfma_f32_32x32x16_bf16(a1v, CAT(l3, h3), Ov[1], 0, 0, 0);
        }
        { const int j = tid >> 2, part = tid & 3; float s = 0.f;
#pragma unroll
          for (int k4 = 0; k4 < 4; ++k4) { const bf16x8 sv = *(const LAS bf16x8*)(lds + OFF_Q + j * SP + (32 * part + 8 * k4) * 2);
#pragma unroll
              for (int e = 0; e < 8; ++e) s += bf2f((bf16_t)sv[e]); }
          s += __shfl_xor(s, 1); s += __shfl_xor(s, 2); if (part == 0) vec[V_RS + j] = s; }
        f32x16 Cl = {};
#pragma unroll 1
        for (int kp = 0; kp < 4; ++kp) {
            const unsigned aa = lbase + OFF_KE + (32 * kp + 8 * hh + q4) * QP + (32 * db + 16 * blk + 4 * p4) * 2;
            const unsigned ab = lbase + OFF_V + (32 * kp + 8 * hh + q4) * VP + (32 * eb + 16 * blk + 4 * p4) * 2;
            s16x4 la = trr(aa), ha = trr(aa + 4 * QP), lb = trr(ab), hb = trr(ab + 4 * VP), la2 = trr(aa + 16 * QP), ha2 = trr(aa + 20 * QP), lb2 = trr(ab + 16 * VP), hb2 = trr(ab + 20 * VP);
            TRWAIT8(la, ha, lb, hb, la2, ha2, lb2, hb2);
            Cl = __builtin_amdgcn_mfma_f32_32x32x16_bf16(CAT(la, ha), CAT(lb, hb), Cl, 0, 0, 0);
            Cl = __builtin_amdgcn_mfma_f32_32x32x16_bf16(CAT(la2, ha2), CAT(lb2, hb2), Cl, 0, 0, 0);
        }
        const float sa = vec[V_SCAL], sb = vec[V_SCAL + 1];
#pragma unroll
        for (int i = 0; i < 16; ++i) Cst[i] = sa * Cst[i] + sb * Cl[i];
        { const int d = tid & 63, part = tid >> 6; float s = 0.f;
#pragma unroll
          for (int k = 0; k < 16; ++k) s += bf2f(*(const LAS bf16_t*)(lds + OFF_KE + (16 * part + k) * QP + d * 2));
          vec[V_NPART + part * 64 + d] = s; }
        __syncthreads();
        if (tid < 64) { float nl = 0.f;
#pragma unroll
            for (int p = 0; p < 8; ++p) nl += vec[V_NPART + p * 64 + tid];
            vec[V_NST + tid] = sa * vec[V_NST + tid] + sb * nl; }
#pragma unroll
        for (int i = 0; i < 16; ++i) { const int j = 32 * rb + crow(i, hh);
            const float den = vec[V_EINT + j] * vec[V_QN + j] + vec[V_RS + j];
            const float scl = 1.0f / fmaxf(fabsf(den), vec[V_EMO + j]);
            *(unsigned*)(hdir + (size_t)POSB(cbase, j) * 512 + h * 128 + ch * 64 + r * 2) = cvt_pk_bf16(Ov[0][i] * scl, Ov[1][i] * scl); }
        __syncthreads();
    }
#undef POSB
#undef PREFETCH
}

__device__ __forceinline__ void mlstm_combine(const bf16_t* __restrict__ proj, const bf16_t* hf, const bf16_t* hb, bf16_t* __restrict__ mixed, const float* __restrict__ lstm_g, int seq, long row0, int h) {
    const int tid = opaque_tid(), part = tid & 3, base0 = 64 * (part >> 1) + 16 * (part & 1);
    const float* gp = lstm_g + h * 128 + base0;
    for (int r0 = 0; r0 < seq; r0 += 128) {
        const size_t row = (size_t)(row0 + r0 + (tid >> 2));
        const bf16_t* fp = hf + row * 512 + h * 128 + 32 * part; const bf16_t* bp = hb + row * 512 + h * 128 + 32 * part;
        const bf16_t* lop = proj + row * NPROJ + 2560 + h * 128 + base0; bf16_t* op = mixed + row * DM + 512 + h * 128 + base0;
        float hs[32]; float ss = 0.f;
#pragma unroll
        for (int k = 0; k < 4; ++k) { const bf16x8 a = *(const bf16x8*)(fp + 8 * k), b = *(const bf16x8*)(bp + 8 * k);
#pragma unroll
            for (int e = 0; e < 8; ++e) { const float x = bf2f((bf16_t)a[e]) + bf2f((bf16_t)b[e]); hs[8 * k + e] = x; ss += x * x; } }
        ss += __shfl_xor(ss, 1); ss += __shfl_xor(ss, 2);
        const float rs = rsqrtf(ss * (1.f / 128.f) + EPS);
#pragma unroll
        for (int t = 0; t < 2; ++t)
#pragma unroll
            for (int k = 0; k < 2; ++k) { const bf16x8 lo8 = *(const bf16x8*)(lop + 32 * t + 8 * k); float ov[8];
#pragma unroll
                for (int e = 0; e < 8; ++e) { const float lg = bf2f((bf16_t)lo8[e]); const float sg = 1.0f / (1.0f + __expf(-lg)); ov[e] = sg * hs[2 * (8 * k + e) + t] * rs * gp[32 * t + 8 * k + e]; }
                u32x4 w; w.x = cvt_pk_bf16(ov[0], ov[1]); w.y = cvt_pk_bf16(ov[2], ov[3]); w.z = cvt_pk_bf16(ov[4], ov[5]); w.w = cvt_pk_bf16(ov[6], ov[7]);
                *(u32x4*)(op + 32 * t + 8 * k) = w; }
    }
}
}

#define XB_TMO      128
#define XB_XCNT(j)  (256  + 64 * (j))
#define XB_XSUB(j)  (1280 + 64 * (j))
#define XB_XGEN(j)  (2304 + 64 * (j))
#define XB_TOP      3328
#define XB_TOPGEN   3392
#define XCD_BAR_WORDS 3456
#define XB_SPIN_CAP (1u << 22)
__device__ __forceinline__ unsigned xb_ld(unsigned* p)              { return __hip_atomic_load(p, __ATOMIC_RELAXED, __HIP_MEMORY_SCOPE_AGENT); }
__device__ __forceinline__ unsigned xb_add(unsigned* p, unsigned v) { return __hip_atomic_fetch_add(p, v, __ATOMIC_RELAXED, __HIP_MEMORY_SCOPE_AGENT); }
__device__ __forceinline__ unsigned xb_xcc_id() { return (unsigned)__builtin_amdgcn_s_getreg((3 << 11) | 20) & 0xFu; }
#define XB_SPIN(cond, bar) do { unsigned _sp = 0; while (cond) { __builtin_amdgcn_s_sleep(1); \
    if ((++_sp & 255u) == 0u) { if (xb_ld(&(bar)[XB_TMO])) break; if (_sp > XB_SPIN_CAP) { atomicAdd(&(bar)[XB_TMO], 1u); break; } } } } while (0)
__device__ __forceinline__ void xcd_barrier_complete(unsigned* bar, unsigned x, unsigned& nloc, unsigned& nx) {
    const unsigned G = gridDim.x * gridDim.y * gridDim.z;
    unsigned sum, cnt, mine, sp = 0u;
    for (;;) {
        sum = 0u; cnt = 0u; mine = 0u;
#pragma unroll
        for (unsigned j = 0; j < 16; ++j) { const unsigned c = xb_ld(&bar[XB_XCNT(j)]); sum += c; cnt += (c > 0u) ? 1u : 0u; mine = (j == x) ? c : mine; }
        if (sum == G) break;
        __builtin_amdgcn_s_sleep(1);
        if ((++sp & 255u) == 0u) { if (xb_ld(&bar[XB_TMO])) break; if (sp > XB_SPIN_CAP) { atomicAdd(&bar[XB_TMO], 1u); break; } }
    }
    nloc = mine > 0u ? mine : 1u; nx = cnt > 0u ? cnt : 1u;
}
__device__ __forceinline__ void xcd_barrier(unsigned* bar, volatile LAS unsigned* st) {
    asm volatile("s_waitcnt vmcnt(0)" ::: "memory");
    __syncthreads();
    if (threadIdx.x == 0) {
        const unsigned x = xb_xcc_id();
        __builtin_amdgcn_s_waitcnt(0);
        unsigned nloc = st[0], nx = st[1];
        if (nloc == 0u) { xcd_barrier_complete(bar, x, nloc, nx); st[0] = nloc; st[1] = nx; }
        const unsigned old = xb_add(&bar[XB_XSUB(x)], 1u);
        const unsigned gen = old / nloc;
        if (old + 1u == (gen + 1u) * nloc) {
            __builtin_amdgcn_fence(__ATOMIC_RELEASE, "agent");
            asm volatile("s_waitcnt vmcnt(0)" ::: "memory");
            const unsigned og = xb_add(&bar[XB_TOP], 1u);
            const unsigned tg = og / nx;
            if (og + 1u == (tg + 1u) * nx) xb_add(&bar[XB_TOPGEN], 1u);
            else XB_SPIN(xb_ld(&bar[XB_TOPGEN]) == tg, bar);
            __builtin_amdgcn_fence(__ATOMIC_ACQUIRE, "agent");
            xb_add(&bar[XB_XGEN(x)], 1u);
            asm volatile("s_waitcnt vmcnt(0)" ::: "memory");
        } else {
            XB_SPIN(xb_ld(&bar[XB_XGEN(x)]) == gen, bar);
            __builtin_amdgcn_fence(__ATOMIC_ACQUIRE, "agent");
            asm volatile("s_waitcnt vmcnt(0)" ::: "memory");
        }
    }
    __syncthreads();
}

struct Args {
    const float* xin[2]; const float* w_in; const float* gate_bias; const float* lam_q1; const float* lam_k1; const float* lam_q2; const float* lam_k2;
    const float* att_g; const float* lstm_g; const float* w_out; const float* ln1_g; const float* ln1_b; const float* w_gu; const float* conv_w; const float* conv_b;
    const float* w_down; const float* ln2_g; const float* ln2_b; float* out; unsigned char* ws; int ph_lo, ph_hi;
};
constexpr int NPHASE = 27;

__device__ __forceinline__ void transpose_item_fp8(const float* W, int K, int N, unsigned char* WT, int gu_map, const float* g, const float* b, float* c1, float* c2, LAS float* scr, int item, int lane) {
    const int nblk = N / 32, kb = item / nblk, nb = item % nblk, k0 = 64 * kb, n0 = 32 * nb;
    const int ncol = n0 + (lane & 31);
    float a1 = 0.f, a2 = 0.f;
#pragma unroll 8
    for (int i = 0; i < 32; ++i) { const int kk = 2 * i + (lane >> 5); float w = W[(size_t)(k0 + kk) * N + ncol];
        if (g) { a2 += w * b[k0 + kk]; w *= g[k0 + kk]; }
        w *= 64.0f;
        if (g) { const int q8 = __builtin_amdgcn_cvt_pk_fp8_f32(w, 0.f, 0, false); a1 += __builtin_amdgcn_cvt_f32_fp8(q8, 0); }
        scr[kk * 33 + (lane & 31)] = w; }
    asm volatile("s_waitcnt lgkmcnt(0)" ::: "memory");
    if (g) { a1 += __shfl_xor(a1, 32); a2 += __shfl_xor(a2, 32); }
    const int c = lane & 7;
#pragma unroll
    for (int j = 0; j < 4; ++j) { const int nl = (lane >> 3) + 8 * j; const int n = n0 + nl; const LAS float* s = scr + (8 * c) * 33 + nl;
        u32x2 o; o.x = cvt4_fp8(s[0 * 33], s[1 * 33], s[2 * 33], s[3 * 33]); o.y = cvt4_fp8(s[4 * 33], s[5 * 33], s[6 * 33], s[7 * 33]);
        int rowm = n; if (gu_map) { const int n2 = n < DFF ? n : n - DFF; rowm = 256 * (n2 >> 7) + (n < DFF ? 0 : 128) + (n2 & 127); }
        *(u32x2*)(WT + (size_t)rowm * K + k0 + 8 * c) = o; }
    if (g && lane < 32) { const int n2 = ncol < DFF ? ncol : ncol - DFF; const int rowm = 256 * (n2 >> 7) + (ncol < DFF ? 0 : 128) + (n2 & 127);
        atomicAdd(c1 + rowm, a1 * (1.0f / 64.0f)); atomicAdd(c2 + rowm, a2); }
    asm volatile("s_waitcnt lgkmcnt(0)" ::: "memory");
}
__device__ __forceinline__ void transpose_item(const float* W, int K, int N, bf16_t* WT, int gu_map, const float* g, const float* b, float* c1, float* c2, LAS float* scr, int item, int lane) {
    const int nblk = (N + 31) / 32, kb = item / nblk, nb = item % nblk, k0 = 64 * kb, n0 = 32 * nb;
    const int ncol = n0 + (lane & 31); const bool okc = ncol < N;
    float a1 = 0.f, a2 = 0.f;
#pragma unroll 8
    for (int i = 0; i < 32; ++i) { const int kk = 2 * i + (lane >> 5); float w = okc ? W[(size_t)(k0 + kk) * N + ncol] : 0.f;
        if (g) { a2 += w * b[k0 + kk]; w *= g[k0 + kk]; a1 += bf2f(f2bf(w)); }
        scr[kk * 33 + (lane & 31)] = w; }
    asm volatile("s_waitcnt lgkmcnt(0)" ::: "memory");
    if (g) { a1 += __shfl_xor(a1, 32); a2 += __shfl_xor(a2, 32); }
    const int c = lane & 7;
#pragma unroll
    for (int j = 0; j < 4; ++j) { const int nl = (lane >> 3) + 8 * j; const int n = n0 + nl; const LAS float* s = scr + (8 * c) * 33 + nl;
        u32x4 o; o.x = cvt_pk_bf16(s[0 * 33], s[1 * 33]); o.y = cvt_pk_bf16(s[2 * 33], s[3 * 33]); o.z = cvt_pk_bf16(s[4 * 33], s[5 * 33]); o.w = cvt_pk_bf16(s[6 * 33], s[7 * 33]);
        if (n < N) { int rowm = n; if (gu_map) { const int n2 = n < DFF ? n : n - DFF; rowm = 256 * (n2 >> 7) + (n < DFF ? 0 : 128) + (n2 & 127); }
            *(u32x4*)(WT + (size_t)rowm * K + k0 + 8 * c) = o; } }
    if (g && lane < 32 && okc) { int rowm = ncol; if (gu_map) { const int n2 = ncol < DFF ? ncol : ncol - DFF; rowm = 256 * (n2 >> 7) + (ncol < DFF ? 0 : 128) + (n2 & 127); }
        atomicAdd(c1 + rowm, a1); atomicAdd(c2 + rowm, a2); }
    asm volatile("s_waitcnt lgkmcnt(0)" ::: "memory");
}

__device__ __forceinline__ void cvt_rows(const float* x, bf16_t* xb, int gtid, int nthr) {
    for (size_t i = gtid; i < (size_t)MT * DM / 8; i += nthr) {
        const f32x4 a = *(const f32x4*)(x + i * 8), b = *(const f32x4*)(x + i * 8 + 4);
        u32x4 w; w.x = cvt_pk_bf16(a[0], a[1]); w.y = cvt_pk_bf16(a[2], a[3]); w.z = cvt_pk_bf16(b[0], b[1]); w.w = cvt_pk_bf16(b[2], b[3]);
        *(u32x4*)(xb + i * 8) = w; }
}

__global__ void __launch_bounds__(512, 2) fwd(Args args) {
    extern __shared__ __attribute__((aligned(16))) unsigned char lds_raw[];
    LAS unsigned char* lds = (LAS unsigned char*)lds_raw;
#if PROBE_TYPES
    unsigned long long tprev = __builtin_amdgcn_s_memrealtime(), tsel = 0; int ptype = 0;
#endif
    volatile LAS unsigned* xst = (volatile LAS unsigned*)(lds + LDS_BYTES - 32);
    if (threadIdx.x == 0) { xst[0] = 0u; xst[1] = 0u; (void)xb_add((unsigned*)(args.ws + CTL_XBAR) + XB_XCNT(xb_xcc_id()), 1u); }
    __syncthreads();
    for (int ph = args.ph_lo; ph < args.ph_hi; ++ph) {
        if (args.ph_hi > 1000) cg::this_grid().sync();
        if (ph > args.ph_lo) xcd_barrier((unsigned*)(args.ws + CTL_XBAR), xst);
#if PROBE_TYPES
        { const unsigned long long tn = __builtin_amdgcn_s_memrealtime(); if (ph > args.ph_lo && ((PROBE_TYPES >> ptype) & 1)) tsel += tn - tprev; tprev = tn;
          if (ph == 0) ptype = 0; else { const int pp_ = (ph - 1) % 13; ptype = pp_ == 12 ? 8 : (pp_ % 6 == 5 ? 7 : 1 + (pp_ % 6)); } }
#endif
        const int tid = opaque_tid(), lane = tid & 63, wave = __builtin_amdgcn_readfirstlane(tid >> 6);
        const int G = gridDim.x, gtid = blockIdx.x * 512 + tid, nthr = G * 512;
        size_t wsoff = 0; asm volatile("" : "+s"(wsoff));
        unsigned char* ws = args.ws + wsoff;
        bf16_t* VB = (bf16_t*)(ws + WS_VB); unsigned char* XB8 = ws + WS_HDIR;
        bf16_t* XB = (bf16_t*)(ws + WS_XB); bf16_t* MIXED = (bf16_t*)(ws + WS_MIXED); bf16_t* PROJ = (bf16_t*)(ws + WS_PROJ); bf16_t* HMID = PROJ;
        float* GATES = (float*)(ws + WS_GATES); float* EDGE = (float*)(ws + WS_EDGE);
        f32x2* ST1 = (f32x2*)(ws + WS_ST1); f32x2* ST2 = (f32x2*)(ws + WS_ST2);
        float* LAMV = (float*)(ws + WS_LAM);
        float* C1IN = (float*)(ws + CTL_C1IN); float* C2IN = (float*)(ws + CTL_C2IN); float* C1GU = (float*)(ws + CTL_C1GU); float* C2GU = (float*)(ws + CTL_C2GU);
        unsigned* QCNT = (unsigned*)(ws + WS_CTL);
        if ((PHMASK & 1) && ph == 0) {
            LAS float* scr = (LAS float*)(lds + wave * 8448);
            const int gw = blockIdx.x * 8 + wave, NGW = G * 8;
            constexpr int I_IN = 16 * 97, I_OUT = 16 * 32, I_GU = 16 * 176, I_DN = 44 * 32, I_L = I_IN + I_OUT + I_GU + I_DN;
            for (int it = gw; it < 2 * I_L; it += NGW) {
                const int l = it / I_L; int r = it % I_L;
                if (r < I_IN) { transpose_item(args.w_in + (size_t)l * DM * NIN, DM, NIN, (bf16_t*)(ws + WS_WIN) + (size_t)l * NPROJ_PAD * DM, 0,
                                               l ? args.ln2_g : nullptr, l ? args.ln2_b : nullptr, C1IN, C2IN, scr, r, lane); continue; } r -= I_IN;
                if (r < I_OUT) { transpose_item(args.w_out + (size_t)l * DM * DM, DM, DM, (bf16_t*)(ws + WS_WOUT) + (size_t)l * DM * DM, 0, nullptr, nullptr, nullptr, nullptr, scr, r, lane); continue; } r -= I_OUT;
                if (r < I_GU) { transpose_item_fp8(args.w_gu + (size_t)l * DM * NGU, DM, NGU, (unsigned char*)(ws + WS_WGU) + (size_t)l * NGU * DM, 1,
                                                   args.ln1_g + l * DM, args.ln1_b + l * DM, C1GU + l * NGU, C2GU + l * NGU, scr, r, lane); continue; } r -= I_GU;
                transpose_item_fp8(args.w_down + (size_t)l * DFF * DM, DFF, DM, (unsigned char*)(ws + WS_WDN) + (size_t)l * DM * DFF, 0, nullptr, nullptr, nullptr, nullptr, scr, r, lane);
            }
            for (int i = gtid; i < 2 * (NPROJ_PAD - NIN) * DM / 8; i += nthr) { const int l = i / ((NPROJ_PAD - NIN) * DM / 8), o = i % ((NPROJ_PAD - NIN) * DM / 8);
                *(u32x4*)((bf16_t*)(ws + WS_WIN) + (size_t)l * NPROJ_PAD * DM + (size_t)NIN * DM + (size_t)o * 8) = (u32x4){0u, 0u, 0u, 0u}; }
            if (blockIdx.x == 0 && wave == 0) {
                for (int l = 0; l < 2; ++l) {
                    float s1 = args.lam_q1[l * 64 + lane] * args.lam_k1[l * 64 + lane], s2 = args.lam_q2[l * 64 + lane] * args.lam_k2[l * 64 + lane];
#pragma unroll
                    for (int o = 1; o < 64; o <<= 1) { s1 += __shfl_xor(s1, o); s2 += __shfl_xor(s2, o); }
                    const float lam_init = 0.8f - 0.6f * expf(-0.3f * (float)l);
                    if (lane == 0) LAMV[l] = expf(s1) - expf(s2) + lam_init;
                }
            }
            cvt_rows(args.xin[0], XB, gtid, nthr);
            continue;
        }
        const int trunk = (ph - 1) / 13, pp = (ph - 1) % 13;
        const int seq = trunk ? 2048 : 4096, nseq = trunk ? 32 : 16;
        float* V = args.out + (size_t)trunk * MT * DM;
        if ((PHMASK & 256) && pp == 12) {
            const float* g = args.ln2_g + DM; const float* b = args.ln2_b + DM;
            for (size_t i = gtid; i < (size_t)MT * DM / 8; i += nthr) { const int row = (int)(i >> 7), col = (int)(i & 127) * 8;
                float mu, rstd; row_stats(ST2, row, mu, rstd);
                const u32x4 xw = *(const u32x4*)(VB + i * 8);
                const f32x4 x0 = unph4(xw.x, xw.y), x1 = unph4(xw.z, xw.w);
                const f32x4 g0 = *(const f32x4*)(g + col), g1 = *(const f32x4*)(g + col + 4), b0 = *(const f32x4*)(b + col), b1 = *(const f32x4*)(b + col + 4);
                *(f32x4*)(V + i * 8) = (x0 - mu) * rstd * g0 + b0; *(f32x4*)(V + i * 8 + 4) = (x1 - mu) * rstd * g1 + b1; }
            if (trunk == 0) cvt_rows(args.xin[1], XB, gtid, nthr);
            continue;
        }
        const int l = pp / 6, sp0 = pp % 6, sp = sp0 == 0 ? 0 : (sp0 == 5 ? 5 : sp0 - 1);
        unsigned* KMAX = (unsigned*)(ws + CTL_KMAX) + (trunk * 2 + l) * 128;
        if (sp0 == 1) {
            const int gw = blockIdx.x * 8 + wave, NGW = G * 8;
            for (int chunk = gw; chunk < MT / 32; chunk += NGW) {
                float mx = 0.f;
                for (int i = 0; i < 32; ++i) { const bf16x8 kv = *(const bf16x8*)(PROJ + (size_t)(chunk * 32 + i) * NPROJ + 512 + lane * 8); float ss = 0.f;
#pragma unroll
                    for (int e = 0; e < 8; ++e) { const float x = bf2f((bf16_t)kv[e]); ss += x * x; }
                    ss += __shfl_xor(ss, 1); ss += __shfl_xor(ss, 2); ss += __shfl_xor(ss, 4); mx = fmaxf(mx, ss); }
                if ((lane & 7) == 0) atomicMax(KMAX + ((chunk * 32) / seq) * 4 + (lane >> 4), __float_as_uint(mx));
            }
        } else if ((PHMASK & 2) && sp == 0) {
            pg8::Gemm g{XB, (const bf16_t*)(ws + WS_WIN) + (size_t)l * NPROJ_PAD * DM, MT, NPROJ_PAD, DM};
            pg8::StaticOrder S; S.init(MT, NPROJ_PAD, G, (int)blockIdx.x);
            EpiProj E{PROJ, GATES, args.gate_bias + l * 16, l ? ST2 : nullptr, C1IN, C2IN, (LAS f32x2*)(lds + EPI_LDS + 8192)};
            pg8::gemm_phase<EpiProj, pg8::StaticOrder>(lds, g, S, E);
        } else if ((PHMASK & 12) && sp == 1) {
            unsigned* qc = QCNT + (size_t)((trunk * 2 + l) * 8) * 64;
            const int myx = (int)(__builtin_amdgcn_s_getreg((3 << 11) | 20) & 7);
            const int npair = nseq / 2, nqb = seq / 128, nitems = npair * (2 + nqb);
            unsigned* FLAG = (unsigned*)(ws + CTL_FLAG) + (trunk * 2 + l) * 128;
            bf16_t* HDIR = (bf16_t*)(ws + WS_HDIR);
            const float lam = LAMV[l]; const float lam_init = 0.8f - 0.6f * expf(-0.3f * (float)l);
            LAS int* sitem = (LAS int*)(lds + LDS_BYTES - 64);
            for (int qq = 0; qq < 8; ++qq) {
                const int x = (myx + qq) & 7;
                for (;;) {
                    if (tid == 0) sitem[0] = (int)atomicAdd(qc + 64 * x, 1u);
                    __syncthreads();
                    const int item = sitem[0];
                    __syncthreads();
                    if (item >= nitems) break;
                    const int nbh = nseq / 8;
                    if ((PHMASK & 4) && item < 2 * npair) {
                        const int pi = item >> 1, dir = item & 1, h = 3 - pi / nbh, b = ((x - 2 * h) & 7) + 8 * (pi % nbh);
                        ml::mlstm_dir(PROJ, GATES, HDIR + (size_t)dir * MT * 512, seq, (long)b * seq, h, dir, lds);
                        __threadfence();
                        __syncthreads();
                        if (tid == 0) sitem[1] = (int)atomicAdd(FLAG + b * 4 + h, 1u);
                        __syncthreads();
                        const int old = sitem[1];
                        if (old == 1) { __threadfence(); ml::mlstm_combine(PROJ, HDIR, HDIR + (size_t)MT * 512, MIXED, args.lstm_g + l * 512, seq, (long)b * seq, h); }
                        __syncthreads();
                    } else if (PHMASK & 8) {
                        const int a = item - 2 * npair, pi = a / nqb, qb = a % nqb, h = 3 - pi / nbh, b = ((x - 2 * h) & 7) + 8 * (pi % nbh);
                        const float slope = exp2f(-2.0f * (float)(h + 1));
                        att::attn_unit(PROJ, MIXED, args.att_g + l * 512, seq, (long)b * seq, h, qb, lam, -slope, 1.0f - lam_init, __uint_as_float(KMAX[b * 4 + h]), (LAS char*)lds);
                    }
                }
            }
        } else if ((PHMASK & 16) && sp == 2) {
            pg8::Gemm g{MIXED, (const bf16_t*)(ws + WS_WOUT) + (size_t)l * DM * DM, MT, DM, DM};
            pg8::StaticOrder S; S.init(MT, DM, G, (int)blockIdx.x);
            if (l == 0) { EpiRes<true> E{XB, VB, nullptr, args.ln2_g, args.ln2_b, ST1, (LAS f32x2*)(lds + EPI_LDS), (LAS f32x2*)(lds + EPI_LDS + 8192), XB8, 1.0f, nullptr};
                          pg8::gemm_phase<EpiRes<true>, pg8::StaticOrder>(lds, g, S, E); }
            else { EpiRes<false> E{VB, VB, ST2, args.ln2_g, args.ln2_b, ST1, (LAS f32x2*)(lds + EPI_LDS), (LAS f32x2*)(lds + EPI_LDS + 8192), XB8, 1.0f, nullptr};
                   pg8::gemm_phase<EpiRes<false>, pg8::StaticOrder>(lds, g, S, E); }
        } else if ((PHMASK & 32) && sp == 3) {
            pg8::Gemm g{XB8, (const unsigned char*)(ws + WS_WGU) + (size_t)l * NGU * DM, MT, NGU, DM};
            pg8::StaticOrder S; S.init(MT, NGU, G, (int)blockIdx.x);
            EpiGU E{(unsigned char*)HMID, EDGE, ST1, C1GU + l * NGU, C2GU + l * NGU, args.conv_w + (size_t)l * 3 * DFF, args.conv_b + (size_t)l * DFF, (LAS float*)(lds + EPI_LDS), (LAS f32x2*)(lds + EPI_LDS + 8192)};
            pg8::gemm_phase<EpiGU, pg8::StaticOrder, true>(lds, g, S, E);
        } else if (PHMASK & 128) {
            pg8::Gemm g{HMID, (const unsigned char*)(ws + WS_WDN) + (size_t)l * DM * DFF, MT, DM, DFF};
            pg8::StaticOrder S; S.init(MT, DM, G, (int)blockIdx.x);
            {
                const int tid = opaque_tid();
                const float* cw = args.conv_w + (size_t)l * 3 * DFF; const float* cb = args.conv_b + (size_t)l * DFF; const int st = seq / 256;
                pg8::Unit uu;
                for (int ui = 0; S.next(ui, uu); ++ui) {
                    const int pm = uu.pm;
                    for (int i = tid; i < 2 * (DFF / 4); i += 512) {
                        const int grp = i % (DFF / 4), e2 = i / (DFF / 4), j = grp * 4;
                        const float* Ep = EDGE + (size_t)pm * 6 * DFF + j;
                        const f32x4 w0 = *(const f32x4*)(cw + j), w1 = *(const f32x4*)(cw + DFF + j), w2 = *(const f32x4*)(cw + 2 * DFF + j), cbv = *(const f32x4*)(cb + j);
                        f32x4 ga, gb, gc, up; const f32x4 z = (f32x4){0.f, 0.f, 0.f, 0.f}; int row;
                        if (e2 == 0) { ga = (pm % st == 0) ? z : *(const f32x4*)(Ep - 6 * DFF + 3 * DFF); gb = *(const f32x4*)(Ep); gc = *(const f32x4*)(Ep + DFF); up = *(const f32x4*)(Ep + 4 * DFF); row = pm * 256; }
                        else { ga = *(const f32x4*)(Ep + 2 * DFF); gb = *(const f32x4*)(Ep + 3 * DFF); gc = (pm % st == st - 1) ? z : *(const f32x4*)(Ep + 6 * DFF); up = *(const f32x4*)(Ep + 5 * DFF); row = pm * 256 + 255; }
                        const f32x4 cv = cbv + w0 * ga + w1 * gb + w2 * gc;
                        *(unsigned*)((unsigned char*)HMID + (size_t)row * DFF + j) = cvt4_fp8(gelu_erf(cv[0]) * up[0] * 16.f, gelu_erf(cv[1]) * up[1] * 16.f, gelu_erf(cv[2]) * up[2] * 16.f, gelu_erf(cv[3]) * up[3] * 16.f);
                    }
                }
                asm volatile("s_waitcnt vmcnt(0)" ::: "memory");
                __syncthreads();
            }
            EpiRes<false> E{VB, VB, ST1, args.ln1_g + l * DM, args.ln1_b + l * DM, ST2, (LAS f32x2*)(lds + EPI_LDS), (LAS f32x2*)(lds + EPI_LDS + 8192), nullptr, 1.0f / 1024.0f, l == 0 ? XB : nullptr};
            pg8::gemm_phase<EpiRes<false>, pg8::StaticOrder, true>(lds, g, S, E);
        }
    }
#if PROBE_TYPES
    { const unsigned long long tn = __builtin_amdgcn_s_memrealtime(); if ((PROBE_TYPES >> ptype) & 1) tsel += tn - tprev;
      if (blockIdx.x == 0 && threadIdx.x == 0) { while (__builtin_amdgcn_s_memrealtime() - tn < tsel) __builtin_amdgcn_s_sleep(8); } }
#endif
}

extern "C" void kernel_launch(void* const* d_in, const int* in_sizes, int n_in, void* d_out, int out_size, void* d_ws, size_t ws_size, hipStream_t stream) {
    static int grid = 0;
    if (grid == 0) {
        if (n_in != 19 || ws_size < WS_END) { fprintf(stderr, "kernel_launch: unexpected n_in %d / ws %zu\n", n_in, ws_size); grid = -1; return; }
        int dev = 0, cus = 0, per_cu = 0;
        hipGetDevice(&dev); hipDeviceGetAttribute(&cus, hipDeviceAttributeMultiprocessorCount, dev);
        if (hipFuncSetAttribute((const void*)fwd, hipFuncAttributeMaxDynamicSharedMemorySize, LDS_BYTES) != hipSuccess) { fprintf(stderr, "kernel_launch: hipFuncSetAttribute failed\n"); grid = -1; return; }
        hipOccupancyMaxActiveBlocksPerMultiprocessor(&per_cu, (const void*)fwd, 512, LDS_BYTES);
        (void)hipGetLastError();
        if (per_cu < 1) per_cu = 1;
        grid = cus;
    }
    if (grid < 0) return;
    hipMemsetAsync((char*)d_ws + WS_CTL, 0, CTL_BYTES, stream);
    Args a{};
    a.xin[0] = (const float*)d_in[0]; a.xin[1] = (const float*)d_in[1]; a.w_in = (const float*)d_in[2]; a.gate_bias = (const float*)d_in[3];
    a.lam_q1 = (const float*)d_in[4]; a.lam_k1 = (const float*)d_in[5]; a.lam_q2 = (const float*)d_in[6]; a.lam_k2 = (const float*)d_in[7];
    a.att_g = (const float*)d_in[8]; a.lstm_g = (const float*)d_in[9]; a.w_out = (const float*)d_in[10]; a.ln1_g = (const float*)d_in[11]; a.ln1_b = (const float*)d_in[12];
    a.w_gu = (const float*)d_in[13]; a.conv_w = (const float*)d_in[14]; a.conv_b = (const float*)d_in[15]; a.w_down = (const float*)d_in[16]; a.ln2_g = (const float*)d_in[17]; a.ln2_b = (const float*)d_in[18];
    a.out = (float*)d_out; a.ws = (unsigned char*)d_ws;
#if MK_MULTI
    for (int ph = 0; ph < NPHASE; ++ph) { a.ph_lo = ph; a.ph_hi = ph + 1; hipLaunchKernelGGL(fwd, dim3(grid), dim3(512), LDS_BYTES, stream, a); }
#else
    a.ph_lo = 0; a.ph_hi = NPHASE;
    void* kargs[] = {&a};
    hipError_t e = hipLaunchCooperativeKernel((const void*)fwd, dim3(grid), dim3(512), kargs, LDS_BYTES, stream);
    if (e != hipSuccess) fprintf(stderr, "kernel_launch: cooperative launch failed: %s (grid %d)\n", hipGetErrorString(e), grid);
#endif
}
```

```cpp
#include <hip/hip_runtime.h>
#include <hip/hip_cooperative_groups.h>
#include <cstdio>
#include <cstdint>
namespace cg = cooperative_groups;

#ifndef PHMASK
#define PHMASK 0xffff
#endif
#ifndef PROBE_TYPES
#define PROBE_TYPES 0
#endif
#ifndef MK_MULTI
#define MK_MULTI 0
#endif

#define LAS __attribute__((address_space(3)))
typedef unsigned short bf16_t;
typedef short bf16x8 __attribute__((ext_vector_type(8)));
typedef short s16x4 __attribute__((ext_vector_type(4)));
typedef float f32x2 __attribute__((ext_vector_type(2)));
typedef float f32x4 __attribute__((ext_vector_type(4)));
typedef float f32x8 __attribute__((ext_vector_type(8)));
typedef float f32x16 __attribute__((ext_vector_type(16)));
typedef _Float16 h16x8 __attribute__((ext_vector_type(8)));
typedef unsigned u32x2 __attribute__((ext_vector_type(2)));
typedef unsigned u32x4 __attribute__((ext_vector_type(4)));

constexpr int DM = 1024, NPROJ = 3072, NPROJ_PAD = 3328, NIN = 3088, DFF = 2816, NGU = 5632;
constexpr int MT = 65536;
constexpr float ALPHA = 1.4142135623730951f, EPS = 1e-5f;
constexpr int LDS_BYTES = 147456;
constexpr int EPI_LDS = 131072;

constexpr size_t MiB = 1u << 20;
constexpr size_t WS_CTL = 0, CTL_BYTES = 1 * MiB;
constexpr size_t CTL_FLAG = 40960;
constexpr size_t CTL_XBAR = 262144;
constexpr size_t CTL_KMAX = 32768;
constexpr size_t CTL_C1IN = 65536, CTL_C2IN = 81920, CTL_C1GU = 98304, CTL_C2GU = 147456;
constexpr size_t WS_LAM = 1 * MiB;
constexpr size_t WS_WIN = 2 * MiB, WS_WOUT = 15 * MiB, WS_WGU = 19 * MiB, WS_WDN = 41 * MiB;
constexpr size_t WS_ST1 = 52 * MiB, WS_ST2 = 54 * MiB, WS_GATES = 56 * MiB, WS_EDGE = 60 * MiB;
constexpr size_t WS_XB = 80 * MiB, WS_MIXED = 208 * MiB, WS_PROJ = 336 * MiB, WS_HDIR = 720 * MiB, WS_VB = 848 * MiB, WS_END = 976 * MiB;

__device__ __forceinline__ unsigned cvt_pk_bf16(float lo, float hi) { unsigned r; asm volatile("v_cvt_pk_bf16_f32 %0, %1, %2" : "=v"(r) : "v"(lo), "v"(hi)); return r; }
__device__ __forceinline__ unsigned cvt4_fp8(float a, float b, float c, float d) { int w = 0; w = __builtin_amdgcn_cvt_pk_fp8_f32(a, b, w, false); w = __builtin_amdgcn_cvt_pk_fp8_f32(c, d, w, true); return (unsigned)w; }
__device__ __forceinline__ float bf2f(bf16_t b) { return __uint_as_float(((unsigned)b) << 16); }
__device__ __forceinline__ bf16_t f2bf(float f) { return (bf16_t)(cvt_pk_bf16(f, 0.f) & 0xffffu); }
__device__ __forceinline__ float gelu_erf(float v) {
    const float av = fabsf(v), t = __builtin_amdgcn_rcpf(av * 0.2316418882f + 1.0f);
    float q = t * 0.5307027145f + (-0.7265760135f); q = q * t + 0.7107068705f; q = q * t + (-0.142248368f); q = q * t + 0.127414796f; q = q * t;
    const float e = __builtin_amdgcn_exp2f((v * v) * (-0.72134752044f));
    const float m = v * (q * e);
    return v < 0.f ? m : v - m;
}
__device__ __forceinline__ int crow(int r, int hi) { return (r & 3) + 8 * (r >> 2) + 4 * hi; }
#define EPI_BAR() do { asm volatile("s_waitcnt lgkmcnt(0)" ::: "memory"); __builtin_amdgcn_s_barrier(); asm volatile("" ::: "memory"); } while (0)
#define SBAR() __builtin_amdgcn_sched_barrier(0)
__device__ __forceinline__ int opaque_tid() { int t = threadIdx.x; asm volatile("" : "+v"(t)); return t; }

namespace pg8 {
constexpr int BM = 256, BK = 64, HALF = 128, HTB = HALF * BK * 2, STAGE_BYTES = 8 * HTB, NXCD = 8, WGM = 8;
__host__ __device__ __forceinline__ int lds_byte(int r, int c) { const int st = (r >> 4) * 2 + (c >> 5), rr = r & 15, cc = c & 31, ob = rr * 64 + cc * 2; return st * 1024 + (ob ^ (((ob >> 9) & 1) << 5)); }
__host__ __device__ __forceinline__ void stage_rc(int b, int& R, int& C) { const int st = b / 1024, sb = b % 1024, swz = sb ^ (((sb >> 9) & 1) << 5); R = (st >> 1) * 16 + swz / 64; C = (st & 1) * 32 + (swz % 64) / 2; }
__host__ __device__ __forceinline__ int perm32(int rho) { const int n = rho >> 4, i = rho & 15; return 8 * (i >> 2) + 4 * n + (i & 3); }
struct Unit { int pm, pn; };
struct Gemm { const void* A; const void* Bt; int M, N, K; };
typedef int i32x8 __attribute__((ext_vector_type(8)));
struct StaticOrder {
    int nM, nN, nwg, G, c;
    __host__ __device__ void init(int M, int N, int G_, int c_) { nM = M / BM; nN = N / BM; nwg = nM * nN; G = G_; c = c_; }
    __host__ __device__ bool next(int i, Unit& u) const {
        const long L = (long)i * G + c; if (L >= nwg) return false;
        int wgid = (int)L; { const int q = nwg / NXCD, r = nwg % NXCD, xcd = wgid % NXCD, off = wgid / NXCD; wgid = (xcd < r ? xcd * (q + 1) : r * (q + 1) + (xcd - r) * q) + off; }
        const int nig = WGM * nN, gid = wgid / nig, fm = gid * WGM, gsz = (nM - fm) < WGM ? (nM - fm) : WGM;
        u.pm = fm + ((wgid % nig) % gsz); u.pn = (wgid % nig) / gsz; return true;
    }
    __device__ __forceinline__ void a_ready(const Unit&) const {}
    __device__ __forceinline__ void done(const Unit&) const {}
};

template <class Epi, class Sched, bool FP8 = false>
__device__ __forceinline__ void gemm_phase(LAS unsigned char* lds, const Gemm g, const Sched& S, const Epi& E) {
    const int tid = opaque_tid(), wid = __builtin_amdgcn_readfirstlane(tid >> 6), lane = tid & 63, wr = wid >> 2, wc = wid & 3, fr = lane & 15, fq = lane >> 4;
    const int pitch = FP8 ? g.K : 2 * g.K, nt = pitch / 128;
    unsigned voffA[2], voffB[2];
#pragma unroll
    for (int i = 0; i < 2; ++i) { int R, C; stage_rc(tid * 16 + i * 8192, R, C); const int Rb = Epi::PERM ? ((R & ~31) + perm32(R & 31)) : R;
        voffA[i] = (unsigned)(R * pitch + 2 * C); voffB[i] = (unsigned)(Rb * pitch + 2 * C); }
    const size_t kstep = (size_t)128;
    const size_t hstep = (size_t)HALF * pitch;
    const size_t tstep = 2 * hstep;
    const unsigned ldsw = (unsigned)wid * 1024u;
    const int aoff0 = FP8 ? lds_byte(wr * 64 + fr, 16 * fq) : lds_byte(wr * 64 + fr, fq * 8), aoff1 = aoff0 + (FP8 ? 16 : 1024);
    const int boff0 = FP8 ? lds_byte(wc * 32 + fr, 16 * fq) : lds_byte(wc * 32 + fr, fq * 8), boff1 = boff0 + (FP8 ? 16 : 1024);
#define PG8_SA(b, h) (((b) * 2 + (h)) * HTB)
#define PG8_SB(b, h) ((4 + (b) * 2 + (h)) * HTB)
#define PG8_STAGE(bufoff, gbase, voff) do { _Pragma("unroll") for (int _i = 0; _i < 2; ++_i) \
        __builtin_amdgcn_global_load_lds((const unsigned*)((const char*)(gbase) + (voff)[_i]), (LAS unsigned*)(lds + (bufoff) + ldsw + _i * 8192), 16, 0, 0); } while (0)
#define PG8_RD16(off) (*(const LAS bf16x8*)(lds + (off)))
#define PG8_CAT8(lo, hi) __builtin_bit_cast(i32x8, __builtin_shufflevector((lo), (hi), 0, 1, 2, 3, 4, 5, 6, 7, 8, 9, 10, 11, 12, 13, 14, 15))
#define PG8_LDA(dst, b, h) do { _Pragma("unroll") for (int m = 0; m < 4; ++m) { \
        if constexpr (FP8) { const bf16x8 lo_ = PG8_RD16(PG8_SA(b, h) + aoff0 + m * 2048), hi_ = PG8_RD16(PG8_SA(b, h) + aoff1 + m * 2048); dst##8[m] = PG8_CAT8(lo_, hi_); } \
        else { dst[m][0] = PG8_RD16(PG8_SA(b, h) + aoff0 + m * 2048); dst[m][1] = PG8_RD16(PG8_SA(b, h) + aoff1 + m * 2048); } } } while (0)
#define PG8_LDB(dst, b, h) do { _Pragma("unroll") for (int n = 0; n < 2; ++n) { \
        if constexpr (FP8) { const bf16x8 lo_ = PG8_RD16(PG8_SB(b, h) + boff0 + n * 2048), hi_ = PG8_RD16(PG8_SB(b, h) + boff1 + n * 2048); dst##8[n] = PG8_CAT8(lo_, hi_); } \
        else { dst[n][0] = PG8_RD16(PG8_SB(b, h) + boff0 + n * 2048); dst[n][1] = PG8_RD16(PG8_SB(b, h) + boff1 + n * 2048); } } } while (0)
#define PG8_MMA(ai, bj, At, Bt) do { __builtin_amdgcn_s_setprio(1); _Pragma("unroll") for (int m = 0; m < 4; ++m) _Pragma("unroll") for (int n = 0; n < 2; ++n) { \
        if constexpr (FP8) asm volatile("v_mfma_f32_16x16x128_f8f6f4 %0, %1, %2, %0" : "+v"(acc[ai][bj][m][n]) : "v"(Bt##8[n]), "v"(At##8[m]));   \
        else { _Pragma("unroll") for (int k = 0; k < 2; ++k) acc[ai][bj][m][n] = __builtin_amdgcn_mfma_f32_16x16x32_bf16(Bt[n][k], At[m][k], acc[ai][bj][m][n], 0, 0, 0); } } \
        __builtin_amdgcn_s_setprio(0); } while (0)
#define PG8_WAIT_V(n) asm volatile("s_waitcnt vmcnt(" #n ")" ::: "memory")
#define PG8_WAIT_L(n) asm volatile("s_waitcnt lgkmcnt(" #n ")" ::: "memory")
#define PG8_BAR __builtin_amdgcn_s_barrier()
#define PG8_SCHED __builtin_amdgcn_sched_barrier(0)
    Unit cur, nxt; int ui = 0;
    if (!S.next(0, cur)) return;
    f32x4 acc[2][2][4][2];
#pragma unroll
    for (int a = 0; a < 2; ++a)
#pragma unroll
        for (int b = 0; b < 2; ++b)
#pragma unroll
            for (int m = 0; m < 4; ++m)
#pragma unroll
                for (int n = 0; n < 2; ++n) acc[a][b][m][n] = (f32x4){0.f, 0.f, 0.f, 0.f};
    bf16x8 At[4][2], B0[2][2], B1[2][2]; i32x8 At8[4], B08[2], B18[2];
    const char* cA = (const char*)g.A + (size_t)cur.pm * tstep; const char* cB = (const char*)g.Bt + (size_t)cur.pn * tstep;
    PG8_STAGE(PG8_SB(0, 0), cB, voffB); PG8_STAGE(PG8_SB(0, 1), cB + hstep, voffB); PG8_STAGE(PG8_SA(0, 0), cA, voffA); PG8_STAGE(PG8_SA(0, 1), cA + hstep, voffA);
    if (wr == 1) PG8_BAR;
    PG8_WAIT_V(2); PG8_BAR;
    PG8_STAGE(PG8_SB(1, 0), cB + kstep, voffB); PG8_STAGE(PG8_SA(1, 0), cA + kstep, voffA); PG8_STAGE(PG8_SB(1, 1), cB + hstep + kstep, voffB);
    PG8_WAIT_V(6); PG8_BAR;
    for (;;) {
        const bool has_next = S.next(ui + 1, nxt);
        const char* nA = has_next ? (const char*)g.A + (size_t)nxt.pm * tstep : cA; const char* nB = has_next ? (const char*)g.Bt + (size_t)nxt.pn * tstep : cB;
#pragma unroll 1
        for (int t = 0; t < nt; t += 2) {
            const bool last = (t == nt - 2);
            const char* a1 = cA + (size_t)(t + 1) * kstep;
            const char* a2 = last ? nA : cA + (size_t)(t + 2) * kstep; const char* b2 = last ? nB : cB + (size_t)(t + 2) * kstep;
            const char* a3 = a2 + kstep; const char* b3 = b2 + kstep;
            PG8_LDB(B0, 0, 0); PG8_LDB(B1, 0, 1); PG8_SCHED; PG8_LDA(At, 0, 0); PG8_STAGE(PG8_SA(1, 1), a1 + hstep, voffA);
            PG8_WAIT_V(8); PG8_WAIT_L(0); PG8_BAR; PG8_MMA(0, 0, At, B0); PG8_MMA(0, 1, At, B1); PG8_BAR; PG8_SCHED;
            PG8_LDA(At, 0, 1); PG8_STAGE(PG8_SB(0, 0), b2, voffB); PG8_STAGE(PG8_SB(0, 1), b2 + hstep, voffB); PG8_STAGE(PG8_SA(0, 0), a2, voffA);
            PG8_WAIT_V(8); PG8_WAIT_L(0); PG8_BAR; PG8_MMA(1, 0, At, B0); PG8_MMA(1, 1, At, B1); PG8_BAR; PG8_SCHED;
            PG8_LDB(B0, 1, 0); PG8_LDB(B1, 1, 1); PG8_SCHED; PG8_LDA(At, 1, 0); PG8_STAGE(PG8_SA(0, 1), a2 + hstep, voffA);
            PG8_WAIT_V(8); PG8_WAIT_L(0); PG8_BAR; PG8_MMA(0, 0, At, B0); PG8_MMA(0, 1, At, B1); PG8_BAR; PG8_SCHED;
            PG8_LDA(At, 1, 1); PG8_STAGE(PG8_SB(1, 0), b3, voffB); PG8_STAGE(PG8_SB(1, 1), b3 + hstep, voffB); PG8_STAGE(PG8_SA(1, 0), a3, voffA);
            PG8_WAIT_V(8); PG8_WAIT_L(0); PG8_BAR; PG8_MMA(1, 0, At, B0); PG8_MMA(1, 1, At, B1); PG8_BAR; PG8_SCHED;
        }
        if (wr == 0) PG8_BAR;
        if constexpr (FP8) asm volatile("s_nop 15\n\ts_nop 15" ::: "memory");
        E(acc, cur, wr, wc, fr, fq);
        if (!has_next) break;
#pragma unroll
        for (int a = 0; a < 2; ++a)
#pragma unroll
            for (int b = 0; b < 2; ++b)
#pragma unroll
                for (int m = 0; m < 4; ++m)
#pragma unroll
                    for (int n = 0; n < 2; ++n) acc[a][b][m][n] = (f32x4){0.f, 0.f, 0.f, 0.f};
        cur = nxt; cA = nA; cB = nB; ++ui;
        if (wr == 1) PG8_BAR;
    }
    PG8_WAIT_V(0);
    PG8_BAR;
#undef PG8_SA
#undef PG8_SB
#undef PG8_STAGE
#undef PG8_LDA
#undef PG8_LDB
#undef PG8_MMA
#undef PG8_CAT8
#undef PG8_RD16
#undef PG8_WAIT_V
#undef PG8_WAIT_L
#undef PG8_BAR
#undef PG8_SCHED
}
}

__device__ __forceinline__ f32x2 gelu_pk(f32x2 v) {
    const f32x2 av = __builtin_elementwise_abs(v), d = av * 0.2316418882f + 1.0f;
    f32x2 t; t.x = __builtin_amdgcn_rcpf(d.x); t.y = __builtin_amdgcn_rcpf(d.y);
    f32x2 q = t * 0.5307027145f + (-0.7265760135f); q = q * t + 0.7107068705f; q = q * t + (-0.142248368f); q = q * t + 0.127414796f; q = q * t;
    const f32x2 s = (v * v) * (-0.72134752044f);
    f32x2 e; e.x = __builtin_amdgcn_exp2f(s.x); e.y = __builtin_amdgcn_exp2f(s.y);
    const f32x2 m = v * (q * e), r = v - m;
    f32x2 o; o.x = v.x < 0.f ? m.x : r.x; o.y = v.y < 0.f ? m.y : r.y; return o;
}
__device__ __forceinline__ void row_stats(const f32x2* st, int row, float& mu, float& rstd) {
    const f32x4 a = *(const f32x4*)(st + (size_t)row * 4), b = *(const f32x4*)(st + (size_t)row * 4 + 2);
    const float s = (a[0] + a[2]) + (b[0] + b[2]), q = (a[1] + a[3]) + (b[1] + b[3]);
    mu = s * (1.f / 1024.f); const float var = fmaxf(q * (1.f / 1024.f) - mu * mu, 0.f); rstd = rsqrtf(var + EPS);
}

__device__ __forceinline__ void tile_stats_to_lds(const f32x2* st, int row0, LAS f32x2* S, int tid) {
    if (tid < 256) { float mu, rstd; row_stats(st, row0 + tid, mu, rstd); S[tid] = (f32x2){mu, rstd}; }
    EPI_BAR();
}
struct EpiProj {
    static constexpr bool PERM = true;
    bf16_t* O; float* gates; const float* gate_bias; const f32x2* stats; const float* c1; const float* c2; LAS f32x2* S;
    __device__ __forceinline__ void operator()(f32x4 (&acc)[2][2][4][2], const pg8::Unit& u, int wr, int wc, int fr, int fq) const {
        asm volatile("" : "+v"(fr), "+v"(fq));
        const int colt = u.pn * 256 + wc * 32 + 8 * fq;
        if (stats) tile_stats_to_lds(stats, u.pm * 256, S, (wr * 4 + wc) * 64 + fq * 16 + fr);
        f32x4 c1v[2][2], c2v[2][2];
#pragma unroll
        for (int bj = 0; bj < 2; ++bj)
#pragma unroll
            for (int n = 0; n < 2; ++n) {
                if (stats) { c1v[bj][n] = *(const f32x4*)(c1 + colt + bj * 128 + 4 * n); c2v[bj][n] = *(const f32x4*)(c2 + colt + bj * 128 + 4 * n); }
                else { c1v[bj][n] = (f32x4){0.f, 0.f, 0.f, 0.f}; c2v[bj][n] = (f32x4){0.f, 0.f, 0.f, 0.f}; } }
        const float sc = (u.pn < 2 || u.pn == 7) ? 0.125f : 1.0f;
#pragma unroll
        for (int ai = 0; ai < 2; ++ai)
#pragma unroll
            for (int m = 0; m < 4; ++m) {
                const int row = u.pm * 256 + ai * 128 + wr * 64 + m * 16 + fr;
                float mu = 0.f, rstd = 1.f; if (stats) { const f32x2 sr = S[ai * 128 + wr * 64 + m * 16 + fr]; mu = sr.x; rstd = sr.y; }
                if (u.pn < 12) {
#pragma unroll
                    for (int bj = 0; bj < 2; ++bj) {
                        const f32x4 v0 = ((acc[ai][bj][m][0] - mu * c1v[bj][0]) * rstd + c2v[bj][0]) * sc, v1 = ((acc[ai][bj][m][1] - mu * c1v[bj][1]) * rstd + c2v[bj][1]) * sc;
                        u32x4 w; w.x = cvt_pk_bf16(v0[0], v0[1]); w.y = cvt_pk_bf16(v0[2], v0[3]); w.z = cvt_pk_bf16(v1[0], v1[1]); w.w = cvt_pk_bf16(v1[2], v1[3]);
                        *(u32x4*)(O + (size_t)row * NPROJ + colt + bj * 128) = w; }
                } else if (wc == 0 && fq < 2) {
#pragma unroll
                    for (int n = 0; n < 2; ++n) {
                        const f32x4 gb = *(const f32x4*)(gate_bias + 8 * fq + 4 * n);
                        *(f32x4*)(gates + (size_t)row * 16 + 8 * fq + 4 * n) = (acc[ai][0][m][n] - mu * c1v[0][n]) * rstd + c2v[0][n] + gb; }
                }
            }
    }
};

__device__ __forceinline__ unsigned pkh2(float a, float b) { return (unsigned)__builtin_bit_cast(unsigned short, (_Float16)a) | ((unsigned)__builtin_bit_cast(unsigned short, (_Float16)b) << 16); }
__device__ __forceinline__ f32x4 unph4(unsigned x, unsigned y) { return (f32x4){(float)__builtin_bit_cast(_Float16, (unsigned short)(x & 0xffffu)), (float)__builtin_bit_cast(_Float16, (unsigned short)(x >> 16)),
                                                                                (float)__builtin_bit_cast(_Float16, (unsigned short)(y & 0xffffu)), (float)__builtin_bit_cast(_Float16, (unsigned short)(y >> 16))}; }
__device__ __forceinline__ f32x4 unpk4(u32x2 p) { return (f32x4){__uint_as_float(p.x << 16), __uint_as_float(p.x & 0xffff0000u), __uint_as_float(p.y << 16), __uint_as_float(p.y & 0xffff0000u)}; }
template <bool SRC_BF16> struct EpiRes {
    static constexpr bool PERM = true;
    const bf16_t* src; bf16_t* dst; const f32x2* st_in; const float* g_in; const float* b_in; f32x2* st_out; LAS f32x2* P; LAS f32x2* S; unsigned char* xb8; float accs; bf16_t* xb;
    __device__ __forceinline__ void operator()(f32x4 (&acc)[2][2][4][2], const pg8::Unit& u, int wr, int wc, int fr, int fq) const {
        asm volatile("" : "+v"(fr), "+v"(fq));
        const int colb = u.pn * 256 + wc * 32 + 8 * fq;
        u32x2 pk[2][2][4][2];
#pragma unroll
        for (int ai = 0; ai < 2; ++ai)
#pragma unroll
            for (int bj = 0; bj < 2; ++bj)
#pragma unroll
                for (int m = 0; m < 4; ++m)
#pragma unroll
                    for (int n = 0; n < 2; ++n) { const f32x4 a = acc[ai][bj][m][n] * accs; pk[ai][bj][m][n] = (u32x2){cvt_pk_bf16(a[0], a[1]), cvt_pk_bf16(a[2], a[3])}; }
        u32x4 xr[2][4][2];
#pragma unroll
        for (int ai = 0; ai < 2; ++ai)
#pragma unroll
            for (int m = 0; m < 4; ++m)
#pragma unroll
                for (int bj = 0; bj < 2; ++bj) xr[ai][m][bj] = *(const u32x4*)(src + (size_t)(u.pm * 256 + ai * 128 + wr * 64 + m * 16 + fr) * DM + colb + bj * 128);
        if (st_in) tile_stats_to_lds(st_in, u.pm * 256, S, (wr * 4 + wc) * 64 + fq * 16 + fr);
        f32x4 gv[2][2], bv[2][2];
#pragma unroll
        for (int bj = 0; bj < 2; ++bj)
#pragma unroll
            for (int n = 0; n < 2; ++n) {
                if (st_in) { gv[bj][n] = *(const f32x4*)(g_in + colb + bj * 128 + n * 4); bv[bj][n] = *(const f32x4*)(b_in + colb + bj * 128 + n * 4); }
                else { gv[bj][n] = (f32x4){1.f, 1.f, 1.f, 1.f}; bv[bj][n] = (f32x4){0.f, 0.f, 0.f, 0.f}; } }
        SBAR();
#pragma unroll
        for (int ai = 0; ai < 2; ++ai) {
#pragma unroll
            for (int m = 0; m < 4; ++m) {
                const int rl = ai * 128 + wr * 64 + m * 16 + fr; const int row = u.pm * 256 + rl;
                float mu = 0.f, rstd = 1.f; if (st_in) { const f32x2 sr = S[rl]; mu = sr.x; rstd = sr.y; }
                float s = 0.f, q = 0.f;
#pragma unroll
                for (int bj = 0; bj < 2; ++bj) {
                    const size_t off = (size_t)row * DM + colb + bj * 128;
                    const u32x4 xw = xr[ai][m][bj];
                    f32x4 x0, x1;
                    if constexpr (!SRC_BF16) { x0 = unph4(xw.x, xw.y); x1 = unph4(xw.z, xw.w); }
                    else { x0 = unpk4((u32x2){xw.x, xw.y}); x1 = unpk4((u32x2){xw.z, xw.w}); }
                    const f32x4 o0 = ((x0 - mu) * rstd * gv[bj][0] + bv[bj][0]) * ALPHA + unpk4(pk[ai][bj][m][0]);
                    const f32x4 o1 = ((x1 - mu) * rstd * gv[bj][1] + bv[bj][1]) * ALPHA + unpk4(pk[ai][bj][m][1]);
                    { u32x4 w; w.x = pkh2(o0[0], o0[1]); w.y = pkh2(o0[2], o0[3]); w.z = pkh2(o1[0], o1[1]); w.w = pkh2(o1[2], o1[3]); *(u32x4*)(dst + off) = w; }
                    if (xb) { u32x4 w; w.x = cvt_pk_bf16(o0[0], o0[1]); w.y = cvt_pk_bf16(o0[2], o0[3]); w.z = cvt_pk_bf16(o1[0], o1[1]); w.w = cvt_pk_bf16(o1[2], o1[3]); *(u32x4*)(xb + off) = w; }
                    if (xb8) { u32x2 w; w.x = cvt4_fp8(o0[0], o0[1], o0[2], o0[3]); w.y = cvt4_fp8(o1[0], o1[1], o1[2], o1[3]); *(u32x2*)(xb8 + off) = w; }
                    s += ((o0[0] + o0[1]) + (o0[2] + o0[3])) + ((o1[0] + o1[1]) + (o1[2] + o1[3]));
                    q += ((o0[0] * o0[0] + o0[1] * o0[1]) + (o0[2] * o0[2] + o0[3] * o0[3])) + ((o1[0] * o1[0] + o1[1] * o1[1]) + (o1[2] * o1[2] + o1[3] * o1[3]));
                }
                s += __shfl_xor(s, 16); s += __shfl_xor(s, 32); q += __shfl_xor(q, 16); q += __shfl_xor(q, 32);
                if (fq == 0) P[rl * 4 + wc] = (f32x2){s, q};
            }
            SBAR();
        }
        EPI_BAR();
        const int tid = (wr * 4 + wc) * 64 + fq * 16 + fr;
        if (tid < 256) {
            const f32x2 a = P[tid * 4 + 0], b = P[tid * 4 + 1], c = P[tid * 4 + 2], d = P[tid * 4 + 3];
            st_out[(size_t)(u.pm * 256 + tid) * 4 + u.pn] = (f32x2){(a.x + b.x) + (c.x + d.x), (a.y + b.y) + (c.y + d.y)};
        }
    }
};

struct EpiGU {
    static constexpr bool PERM = false;
    unsigned char* hmid  ; float* edge; const f32x2* stats; const float* c1; const float* c2; const float* cw; const float* cb; LAS float* halo; LAS f32x2* S;
    __device__ __forceinline__ void operator()(f32x4 (&acc)[2][2][4][2], const pg8::Unit& u, int wr, int wc, int fr, int fq) const {
        asm volatile("" : "+v"(fr), "+v"(fq));
        const int colb = wc * 32 + 4 * fq; const int lane = fq * 16 + fr;
        const int jch0 = u.pn * 128 + colb;
        tile_stats_to_lds(stats, u.pm * 256, S, (wr * 4 + wc) * 64 + lane);
        u32x2 gk[2][4][2], uk[2][4][2];
        {
            f32x4 c1v[2][2], c2v[2][2];
#pragma unroll
            for (int bj = 0; bj < 2; ++bj)
#pragma unroll
                for (int n = 0; n < 2; ++n) { c1v[bj][n] = *(const f32x4*)(c1 + u.pn * 256 + bj * 128 + colb + 16 * n); c2v[bj][n] = *(const f32x4*)(c2 + u.pn * 256 + bj * 128 + colb + 16 * n); }
#pragma unroll
            for (int ai = 0; ai < 2; ++ai)
#pragma unroll
                for (int m = 0; m < 4; ++m) {
                    const f32x2 sr = S[ai * 128 + wr * 64 + m * 16 + fr]; const float mu = sr.x, rstd = sr.y;
                    const int blk = ai * 2 + wr;
#pragma unroll
                    for (int n = 0; n < 2; ++n) {
                        const f32x4 gv = (acc[ai][0][m][n] * (1.0f / 64.0f) - mu * c1v[0][n]) * rstd + c2v[0][n];
                        const f32x4 uv = (acc[ai][1][m][n] * (1.0f / 64.0f) - mu * c1v[1][n]) * rstd + c2v[1][n];
                        gk[ai][m][n].x = cvt_pk_bf16(gv[0], gv[1]); gk[ai][m][n].y = cvt_pk_bf16(gv[2], gv[3]);
                        uk[ai][m][n].x = cvt_pk_bf16(uv[0], uv[1]); uk[ai][m][n].y = cvt_pk_bf16(uv[2], uv[3]);
                        if (m == 0) {
                            if (fr == 0) *(LAS u32x2*)(halo + (blk * 2 + 0) * 128 + (colb + 16 * n) / 2) = gk[ai][m][n];
                            if (ai == 0 && wr == 0 && fr <= 1) *(f32x4*)(edge + ((size_t)u.pm * 6 + fr) * DFF + jch0 + 16 * n) = gv;
                            if (ai == 0 && wr == 0 && fr == 0) *(f32x4*)(edge + ((size_t)u.pm * 6 + 4) * DFF + jch0 + 16 * n) = uv;
                        }
                        if (m == 3) {
                            if (fr == 15) *(LAS u32x2*)(halo + (blk * 2 + 1) * 128 + (colb + 16 * n) / 2) = gk[ai][m][n];
                            if (ai == 1 && wr == 1 && fr >= 14) *(f32x4*)(edge + ((size_t)u.pm * 6 + 2 + (fr - 14)) * DFF + jch0 + 16 * n) = gv;
                            if (ai == 1 && wr == 1 && fr == 15) *(f32x4*)(edge + ((size_t)u.pm * 6 + 5) * DFF + jch0 + 16 * n) = uv;
                        }
                    }
                    SBAR();
                }
        }
        EPI_BAR(); SBAR();
#define BLO(x) __uint_as_float((x) << 16)
#define BHI(x) __uint_as_float((x) & 0xffff0000u)
#pragma unroll
        for (int n = 0; n < 2; ++n) {
            const f32x4 w0 = *(const f32x4*)(cw + jch0 + 16 * n), w1 = *(const f32x4*)(cw + DFF + jch0 + 16 * n), w2 = *(const f32x4*)(cw + 2 * DFF + jch0 + 16 * n), cbv = *(const f32x4*)(cb + jch0 + 16 * n);
#pragma unroll
            for (int ai = 0; ai < 2; ++ai) {
                const int blk = ai * 2 + wr;
                u32x2 top = (u32x2){0u, 0u}, bot = (u32x2){0u, 0u};
                if (blk > 0) top = *(const LAS u32x2*)(halo + ((blk - 1) * 2 + 1) * 128 + (colb + 16 * n) / 2);
                if (blk < 3) bot = *(const LAS u32x2*)(halo + ((blk + 1) * 2 + 0) * 128 + (colb + 16 * n) / 2);
                u32x2 hk[4];
#pragma unroll
                for (int w = 0; w < 2; ++w) {
                    unsigned a_[4], c_[4];
#pragma unroll
                    for (int m = 0; m < 4; ++m) { const unsigned gv = gk[ai][m][n][w];
                        a_[m] = (unsigned)__builtin_amdgcn_update_dpp(0, (int)gv, 0x121, 0xf, 0xf, false);
                        c_[m] = (unsigned)__builtin_amdgcn_update_dpp(0, (int)gv, 0x12f, 0xf, 0xf, false); }
                    const f32x2 cb2 = (f32x2){cbv[2 * w], cbv[2 * w + 1]}, w02 = (f32x2){w0[2 * w], w0[2 * w + 1]}, w12 = (f32x2){w1[2 * w], w1[2 * w + 1]}, w22 = (f32x2){w2[2 * w], w2[2 * w + 1]};
#pragma unroll
                    for (int m = 0; m < 4; ++m) {
                        const unsigned prev = (fr > 0) ? a_[m] : (m > 0 ? a_[m > 0 ? m - 1 : 0] : top[w]);
                        const unsigned next = (fr < 15) ? c_[m] : (m < 3 ? c_[m < 3 ? m + 1 : 3] : bot[w]);
                        const unsigned cur = gk[ai][m][n][w], upw = uk[ai][m][n][w];
                        const f32x2 cv = cb2 + w02 * (f32x2){BLO(prev), BHI(prev)} + w12 * (f32x2){BLO(cur), BHI(cur)} + w22 * (f32x2){BLO(next), BHI(next)};
                        const f32x2 hv2 = gelu_pk(cv) * (f32x2){BLO(upw), BHI(upw)};
                        hk[m][w] = cvt_pk_bf16(hv2.x, hv2.y);
                    }
                    SBAR();
                }
#pragma unroll
                for (int m = 0; m < 4; ++m) {
                    const int rl = ai * 128 + wr * 64 + m * 16 + fr;
                    if (rl != 0 && rl != 255) *(unsigned*)(hmid + (size_t)(u.pm * 256 + rl) * DFF + jch0 + 16 * n) = cvt4_fp8(BLO(hk[m].x) * 16.f, BHI(hk[m].x) * 16.f, BLO(hk[m].y) * 16.f, BHI(hk[m].y) * 16.f);
                }
                SBAR();
            }
        }
#undef BLO
#undef BHI
    }
};

namespace att {
constexpr int KVBLK = 64, SHM_V = 16384, SHM_K = 16384, WS_OFF = 73728, OB_PITCH = 132;
#define KSWZ(row, colB) ((row) * 256 + ((colB) ^ (((row) & 7) << 4)))
__device__ __forceinline__ void alibi(f32x16& p0, f32x16& p1, float t0, float nslope) {
#pragma unroll
    for (int r = 0; r < 16; ++r) { const float kr = (float)((r & 3) + 8 * (r >> 2));
        p0[r] = fmaf(nslope, fabsf(t0 - kr), p0[r]); p1[r] = fmaf(nslope, fabsf(t0 - kr - 32.f), p1[r]); }
}
__device__ __forceinline__ void partialSM(f32x16& p0, f32x16& p1, float mC) {
    constexpr float C = 1.4426950408889634f;
#pragma unroll
    for (int r = 0; r < 16; ++r) p0[r] = fmaf(p0[r], C, mC);
#pragma unroll
    for (int r = 0; r < 16; ++r) p1[r] = fmaf(p1[r], C, mC);
#pragma unroll
    for (int r = 0; r < 16; ++r) p0[r] = __builtin_amdgcn_exp2f(p0[r]);
}
__device__ __forceinline__ void finishSM(f32x16& p0, f32x16& p1, float& l_reg, bf16x8& pa0, bf16x8& pa1, bf16x8& pa2, bf16x8& pa3) {
#pragma unroll
    for (int r = 0; r < 16; ++r) p1[r] = __builtin_amdgcn_exp2f(p1[r]);
    float ps = 0;
#pragma unroll
    for (int r = 0; r < 16; ++r) ps += p0[r];
#pragma unroll
    for (int r = 0; r < 16; ++r) ps += p1[r];
    { auto rr = __builtin_amdgcn_permlane32_swap(__float_as_uint(ps), __float_as_uint(ps), false, false);
      ps = __uint_as_float(rr[0]) + __uint_as_float(rr[1]); }
    l_reg += ps;
#define PK4(P, BASE, OUT) do { unsigned a0 = cvt_pk_bf16(P[BASE + 0], P[BASE + 1]), a1 = cvt_pk_bf16(P[BASE + 2], P[BASE + 3]);   \
    unsigned b0 = cvt_pk_bf16(P[BASE + 4], P[BASE + 5]), b1 = cvt_pk_bf16(P[BASE + 6], P[BASE + 7]);                              \
    auto r0 = __builtin_amdgcn_permlane32_swap(a0, b0, false, false); auto r1 = __builtin_amdgcn_permlane32_swap(a1, b1, false, false); \
    u32x4 w = {r0[0], r1[0], r0[1], r1[1]}; OUT = *reinterpret_cast<bf16x8*>(&w); } while (0)
    PK4(p0, 0, pa0); PK4(p0, 8, pa1); PK4(p1, 0, pa2); PK4(p1, 8, pa3);
#undef PK4
}
__device__ __forceinline__ void qkt(f32x16& p0, f32x16& p1, const LAS char* Ks, const bf16x8* qr, int r32, int hi, int c) {
    p0 = f32x16{}; p1 = f32x16{};
#pragma unroll
    for (int d0 = 0; d0 < 4; ++d0) { const int cb = ((c * 4 + d0) * 16 + hi * 8) * 2;
        const bf16x8 b0 = *reinterpret_cast<const LAS bf16x8*>(Ks + KSWZ(r32, cb));
        const bf16x8 b1 = *reinterpret_cast<const LAS bf16x8*>(Ks + KSWZ(32 + r32, cb));
        p0 = __builtin_amdgcn_mfma_f32_32x32x16_bf16(b0, qr[d0], p0, 0, 0, 0);
        p1 = __builtin_amdgcn_mfma_f32_32x32x16_bf16(b1, qr[d0], p1, 0, 0, 0); }
}
__device__ __forceinline__ int v_st(int k, int c) { const int kk = (k & ~0xC) | ((k & 4) << 1) | ((k & 8) >> 1); return ((kk >> 3) * 4 + (c >> 5)) * 512 + ((kk & 7) * 32 + (c & 31)) * 2; }
__device__ __forceinline__ int v_rd_base(int lane) { return ((lane & 3) << 3) | (((lane >> 2) & 3) << 6) | (((lane >> 4) & 1) << 5) | (((lane >> 5) & 1) << 8); }
constexpr int v_rd_off(int d0, int ks, int half) { return d0 * 512 + ks * 4096 + half * 2048; }
template <int OFF> __device__ __forceinline__ s16x4 tr_read(int vb) {
    s16x4 r; asm volatile("ds_read_b64_tr_b16 %0, %1 offset:%2" : "=&v"(r) : "v"(vb), "i"(OFF) : "memory"); return r;
}
template <int D0> __device__ __forceinline__ void pv_one(f32x16& od, int vb, bf16x8 pa0, bf16x8 pa1, bf16x8 pa2, bf16x8 pa3) {
    const s16x4 l0 = tr_read<v_rd_off(D0, 0, 0)>(vb), h0 = tr_read<v_rd_off(D0, 0, 1)>(vb), l1 = tr_read<v_rd_off(D0, 1, 0)>(vb), h1 = tr_read<v_rd_off(D0, 1, 1)>(vb);
    const s16x4 l2 = tr_read<v_rd_off(D0, 2, 0)>(vb), h2 = tr_read<v_rd_off(D0, 2, 1)>(vb), l3 = tr_read<v_rd_off(D0, 3, 0)>(vb), h3 = tr_read<v_rd_off(D0, 3, 1)>(vb);
    asm volatile("s_waitcnt lgkmcnt(0)" ::: "memory"); SBAR();
#define PK(L, H) (bf16x8){L[0], L[1], L[2], L[3], H[0], H[1], H[2], H[3]}
    od = __builtin_amdgcn_mfma_f32_32x32x16_bf16(pa0, PK(l0, h0), od, 0, 0, 0);
    od = __builtin_amdgcn_mfma_f32_32x32x16_bf16(pa1, PK(l1, h1), od, 0, 0, 0);
    od = __builtin_amdgcn_mfma_f32_32x32x16_bf16(pa2, PK(l2, h2), od, 0, 0, 0);
    od = __builtin_amdgcn_mfma_f32_32x32x16_bf16(pa3, PK(l3, h3), od, 0, 0, 0);
#undef PK
}
__device__ __forceinline__ void pv_d0(f32x16* o, int vb, bf16x8 pa0, bf16x8 pa1, bf16x8 pa2, bf16x8 pa3) {
    pv_one<0>(o[0], vb, pa0, pa1, pa2, pa3); pv_one<1>(o[1], vb, pa0, pa1, pa2, pa3); pv_one<2>(o[2], vb, pa0, pa1, pa2, pa3); pv_one<3>(o[3], vb, pa0, pa1, pa2, pa3);
}

__device__ __forceinline__ void attn_unit(const bf16_t* __restrict__ proj, bf16_t* __restrict__ mixed, const float* __restrict__ att_g,
                                          int seq, long row0, int h, int qb, float lam, float nslope, float oscale, float kmax2, LAS char* lds) {
    const int tid = opaque_tid(), wid = tid >> 6, lane = tid & 63, r32 = lane & 31, hi = lane >> 5, c = wid >> 2, wq = wid & 3;
    LAS char* V_lds = lds; LAS char* K_lds = lds + 2 * SHM_V;
    LAS float* ws = (LAS float*)(lds + WS_OFF) + wid * 64; LAS float* li_l = ws;
    float l_reg = 0; f32x16 o[4] = {}; bf16x8 qr[4];
    const int qrow = qb * 128 + wq * 32 + r32;
    const bf16_t* Qw = proj + (size_t)(row0 + qrow) * NPROJ + h * 128 + c * 64 + hi * 8;
#pragma unroll
    for (int d0 = 0; d0 < 4; ++d0) qr[d0] = *reinterpret_cast<const bf16x8*>(Qw + d0 * 16);
    int tlo, NT; float mC;
    {
        float qs = 0.f;
#pragma unroll
        for (int d0 = 0; d0 < 4; ++d0)
#pragma unroll
            for (int e = 0; e < 8; ++e) { const float qv = bf2f((bf16_t)qr[d0][e]); qs += qv * qv; }
        qs += __shfl_xor(qs, 32);
        mC = -fminf(sqrtf(qs * kmax2) * 1.01f + 1e-3f, 60.0f) * 1.4426950408889634f;
#pragma unroll
        for (int o = 1; o < 32; o <<= 1) qs = fmaxf(qs, __shfl_xor(qs, o));
        if (lane == 0) ws[0] = qs;
        __syncthreads();
        float qm = 0.f;
#pragma unroll
        for (int w = 0; w < 8; ++w) qm = fmaxf(qm, ((LAS float*)(lds + WS_OFF))[w * 64]);
        const float smax = sqrtf(qm * kmax2) * 1.01f + 1e-3f;
        const float dstar = (30.0f + 2.0f * smax) / (-nslope);
        const int ntall = seq / KVBLK;
        int lo = (int)floorf(((float)(qb * 128) - dstar) * (1.0f / 64.0f)), hi_t = (int)floorf(((float)(qb * 128 + 127) + dstar) * (1.0f / 64.0f));
        lo = lo < 0 ? 0 : lo; hi_t = hi_t > ntall - 1 ? ntall - 1 : hi_t;
        if (((hi_t - lo + 1) & 1) != 0) { if (hi_t < ntall - 1) ++hi_t; else --lo; }
        tlo = lo; NT = hi_t - lo + 1;
    }
    const bf16_t* Kh = proj + (size_t)(row0 + tlo * KVBLK) * NPROJ + 512 + h * 128; const bf16_t* Vh = proj + (size_t)(row0 + tlo * KVBLK) * NPROJ + 1024 + h * 128;
    const int sr = tid >> 4, sc = (tid & 15) * 8, vst0 = v_st(sr, sc), vst1 = v_st(32 + sr, sc);
    const int vb0 = (int)(uintptr_t)V_lds + v_rd_base(lane);
    const float qposf = (float)(qrow - 4 * hi - tlo * KVBLK);
    struct { bf16x8 vs0, vs1, ks0, ks1; } sr_[2];
#define SLOAD(i, k0) do { sr_[i].vs0 = *reinterpret_cast<const bf16x8*>(&Vh[(size_t)((k0) + sr) * NPROJ + sc]); sr_[i].vs1 = *reinterpret_cast<const bf16x8*>(&Vh[(size_t)((k0) + 32 + sr) * NPROJ + sc]); \
    sr_[i].ks0 = *reinterpret_cast<const bf16x8*>(&Kh[(size_t)((k0) + sr) * NPROJ + sc]); sr_[i].ks1 = *reinterpret_cast<const bf16x8*>(&Kh[(size_t)((k0) + 32 + sr) * NPROJ + sc]); } while (0)
#define SWRITE(b, i) do { *(LAS bf16x8*)(V_lds + (b) * SHM_V + vst0) = sr_[i].vs0;          \
    *(LAS bf16x8*)(V_lds + (b) * SHM_V + vst1) = sr_[i].vs1; const int kc = sc * 2;               \
    *(LAS bf16x8*)(K_lds + (b) * SHM_K + KSWZ(sr, kc)) = sr_[i].ks0;                       \
    *(LAS bf16x8*)(K_lds + (b) * SHM_K + KSWZ(32 + sr, kc)) = sr_[i].ks1; } while (0)
#define SWAIT() asm volatile("s_waitcnt vmcnt(4)" ::: "memory")
    f32x16 pA0, pA1, pB0, pB1; bf16x8 pa0, pa1, pa2, pa3;
    constexpr int SE = 0, SO = 1;
    SLOAD(SE, 0); asm volatile("s_waitcnt vmcnt(0)" ::: "memory"); SWRITE(0, SE); __syncthreads();
    qkt(pA0, pA1, K_lds, qr, r32, hi, c); alibi(pA0, pA1, qposf, nslope); partialSM(pA0, pA1, mC);
    SLOAD(SO, KVBLK); if (2 < NT) SLOAD(SE, 2 * KVBLK);
    SWAIT(); SWRITE(1, SO); __syncthreads();
    for (int j = 1; j + 1 < NT; j += 2) {
        SBAR(); qkt(pB0, pB1, K_lds + SHM_K, qr, r32, hi, c);
        finishSM(pA0, pA1, l_reg, pa0, pa1, pa2, pa3); SBAR();
        SLOAD(SO, (j + 2) * KVBLK); SBAR();
        pv_d0(o, vb0, pa0, pa1, pa2, pa3); alibi(pB0, pB1, qposf - (float)(j * KVBLK), nslope); partialSM(pB0, pB1, mC);
        __syncthreads(); SWAIT(); SWRITE(0, SE);
        __syncthreads();
        SBAR(); qkt(pA0, pA1, K_lds, qr, r32, hi, c);
        finishSM(pB0, pB1, l_reg, pa0, pa1, pa2, pa3); SBAR();
        if (j + 3 < NT) SLOAD(SE, (j + 3) * KVBLK); SBAR();
        pv_d0(o, vb0 + SHM_V, pa0, pa1, pa2, pa3); alibi(pA0, pA1, qposf - (float)((j + 1) * KVBLK), nslope); partialSM(pA0, pA1, mC);
        __syncthreads(); SWAIT(); SWRITE(1, SO);
        __syncthreads();
    }
    SBAR(); qkt(pB0, pB1, K_lds + SHM_K, qr, r32, hi, c);
    finishSM(pA0, pA1, l_reg, pa0, pa1, pa2, pa3); SBAR();
    pv_d0(o, vb0, pa0, pa1, pa2, pa3); alibi(pB0, pB1, qposf - (float)((NT - 1) * KVBLK), nslope); partialSM(pB0, pB1, mC);
    __syncthreads();
    finishSM(pB0, pB1, l_reg, pa0, pa1, pa2, pa3); SBAR();
    pv_d0(o, vb0 + SHM_V, pa0, pa1, pa2, pa3);
    if (hi == 0) li_l[r32] = l_reg; asm volatile("s_waitcnt lgkmcnt(0)" ::: "memory");
    float rli[16];
#pragma unroll
    for (int r = 0; r < 16; ++r) rli[r] = __builtin_amdgcn_rcpf(li_l[crow(r, hi)]);
    __syncthreads();
    LAS float* OB = (LAS float*)lds;
    if (c == 1) {
#pragma unroll
        for (int r = 0; r < 16; ++r) { const int orow = wq * 32 + crow(r, hi);
#pragma unroll
            for (int d0 = 0; d0 < 4; ++d0) OB[orow * OB_PITCH + d0 * 32 + r32] = o[d0][r] * rli[r]; }
    }
    __syncthreads();
    if (c == 0) {
        float gcol[4];
#pragma unroll
        for (int d0 = 0; d0 < 4; ++d0) gcol[d0] = att_g[h * 128 + d0 * 32 + r32] * oscale;
#pragma unroll
        for (int r = 0; r < 16; ++r) { const int orow = wq * 32 + crow(r, hi);
            float dv[4]; float ss = 0.f;
#pragma unroll
            for (int d0 = 0; d0 < 4; ++d0) { dv[d0] = o[d0][r] * rli[r] - lam * OB[orow * OB_PITCH + d0 * 32 + r32]; ss += dv[d0] * dv[d0]; }
            ss += __shfl_xor(ss, 1); ss += __shfl_xor(ss, 2); ss += __shfl_xor(ss, 4); ss += __shfl_xor(ss, 8); ss += __shfl_xor(ss, 16);
            const float rs = rsqrtf(ss * (1.f / 128.f) + EPS);
            bf16_t* orp = mixed + (size_t)(row0 + qb * 128 + orow) * DM + h * 128 + r32;
#pragma unroll
            for (int d0 = 0; d0 < 4; ++d0) orp[d0 * 32] = f2bf(dv[d0] * rs * gcol[d0]); }
    }
    __syncthreads();
#undef SLOAD
#undef SWRITE
#undef SWAIT
}
}

namespace ml {
constexpr int QP = 192, VP = 320, SP = 272, CP = 320;
constexpr int OFF_Q = 0, OFF_K = 24576, OFF_KE = 49152, OFF_V = 73728, OFF_C = 114688, OFF_VEC = 135168;
constexpr int V_U = 0, V_MX = 128, V_EINT = 256, V_EEND = 384, V_EMO = 512, V_QN = 640, V_RS = 768, V_GI = 896, V_GF = 1024, V_NST = 1152, V_NPART = 1216, V_SCAL = 1728;
constexpr int HS_PITCH = 132;
__device__ __forceinline__ s16x4 trr(unsigned addr) { s16x4 r; asm volatile("ds_read_b64_tr_b16 %0, %1" : "=&v"(r) : "v"(addr) : "memory"); return r; }
#define TRWAIT4(a, b, c, d) asm volatile("s_waitcnt lgkmcnt(0)" : "+v"(a), "+v"(b), "+v"(c), "+v"(d) :: "memory")
#define TRWAIT8(a, b, c, d, e, f, g, h) asm volatile("s_waitcnt lgkmcnt(0)" : "+v"(a), "+v"(b), "+v"(c), "+v"(d), "+v"(e), "+v"(f), "+v"(g), "+v"(h) :: "memory")
#define CAT(L, H) (bf16x8){L[0], L[1], L[2], L[3], H[0], H[1], H[2], H[3]}
__device__ __forceinline__ float logsig(float x) { return fminf(x, 0.f) - __logf(1.0f + __expf(-fabsf(x))); }

__device__ __forceinline__ void mlstm_dir(const bf16_t* __restrict__ proj, const float* __restrict__ gates, bf16_t* __restrict__ hdir,
                                          int seq, long row0, int h, int dir, LAS unsigned char* lds) {
    const int tid0 = opaque_tid();
    LAS float* vec = (LAS float*)(lds + OFF_VEC);
    const unsigned lbase = (unsigned)(uintptr_t)lds;
    const int nc = seq / 128;
    constexpr float L2E = 1.4426950408889634f;
    f32x16 Cst = {};
    if (tid0 < 64) vec[V_NST + tid0] = 0.f;
    float m_state = 0.f;
    bf16x8 pq[2], pk[2], pv[4]; float pgi = 0.f, pgf = 0.f;
#define POSB(cb_, j) ((cb_) + (dir ? 127 - (j) : (j)))
#define PREFETCH(cidx) do { const long cb_ = row0 + (long)(cidx) * 128; \
        _Pragma("unroll") for (int i = 0; i < 2; ++i) { const int chunk = tid0 + 512 * i, j = chunk >> 3, c8 = chunk & 7; const bf16_t* src = proj + (size_t)POSB(cb_, j) * NPROJ + h * 64 + c8 * 8; \
            pq[i] = *(const bf16x8*)(src + 1536); pk[i] = *(const bf16x8*)(src + 1792); } \
        _Pragma("unroll") for (int i = 0; i < 4; ++i) { const int chunk = tid0 + 512 * i, j = chunk >> 4, c16 = chunk & 15; \
            pv[i] = *(const bf16x8*)(proj + (size_t)POSB(cb_, j) * NPROJ + 2048 + h * 128 + c16 * 8); } \
        if (tid0 < 128) { const float* gp = gates + (size_t)POSB(cb_, tid0) * 16; pgi = gp[(dir ? 8 : 0) + h]; pgf = gp[(dir ? 12 : 4) + h]; } } while (0)
    PREFETCH(dir ? nc - 1 : 0);
    __syncthreads();
    for (int cc = 0; cc < nc; ++cc) {
        int tid = tid0; asm volatile("" : "+v"(tid));
        const int wid = tid >> 6, lane = tid & 63, r = lane & 31, hh = lane >> 5, i16 = lane & 15, q4 = i16 >> 2, p4 = i16 & 3, blk = (lane >> 4) & 1;
        const int rb = wid >> 1, ch = wid & 1, db = wid >> 2, eb = wid & 3;
        const int c = dir ? nc - 1 - cc : cc;
        const long cbase = row0 + (long)c * 128;
#pragma unroll
        for (int i = 0; i < 2; ++i) { const int chunk = tid + 512 * i, j = chunk >> 3, c8 = chunk & 7;
            *(LAS bf16x8*)(lds + OFF_Q + j * QP + c8 * 16) = pq[i]; *(LAS bf16x8*)(lds + OFF_K + j * QP + c8 * 16) = pk[i]; }
#pragma unroll
        for (int i = 0; i < 4; ++i) { const int chunk = tid + 512 * i, j = chunk >> 4, c16 = chunk & 15; *(LAS bf16x8*)(lds + OFF_V + j * VP + c16 * 16) = pv[i]; }
        if (tid < 128) { vec[V_GI + tid] = pgi; vec[V_GF + tid] = pgf; }
#pragma unroll
        for (int i = 0; i < 16; ++i) *(LAS bf16_t*)(lds + OFF_C + (32 * db + crow(i, hh)) * CP + (32 * eb + r) * 2) = f2bf(Cst[i]);
        __syncthreads();
        if (cc + 1 < nc) PREFETCH(dir ? nc - 2 - cc : cc + 1);
        if (wid == 0) {
            const float gf0 = vec[V_GF + 2 * lane], gf1 = vec[V_GF + 2 * lane + 1], gi0 = vec[V_GI + 2 * lane], gi1 = vec[V_GI + 2 * lane + 1];
            const float lf0 = logsig(gf0), lf1 = logsig(gf1);
            float incl = lf0 + lf1;
#pragma unroll
            for (int d = 1; d < 64; d <<= 1) { const float t = __shfl_up(incl, d); if (lane >= d) incl += t; }
            const float b1 = incl, b0 = incl - lf1, g = __shfl(incl, 63);
            const float u0 = gi0 - b0, u1 = gi1 - b1;
            float cm = fmaxf(u0, u1);
#pragma unroll
            for (int d = 1; d < 64; d <<= 1) { const float t = __shfl_up(cm, d); if (lane >= d) cm = fmaxf(cm, t); }
            float excl = __shfl_up(cm, 1); if (lane == 0) excl = -INFINITY;
            const float cmx0 = fmaxf(excl, u0), cmx1 = cm, umax = __shfl(cm, 63);
            const float mp = m_state, mx0 = fmaxf(mp, cmx0), mx1 = fmaxf(mp, cmx1);
            vec[V_U + 2 * lane] = u0; vec[V_U + 2 * lane + 1] = u1; vec[V_MX + 2 * lane] = mx0; vec[V_MX + 2 * lane + 1] = mx1;
            vec[V_EINT + 2 * lane] = __expf(mp - mx0); vec[V_EINT + 2 * lane + 1] = __expf(mp - mx1);
            vec[V_EEND + 2 * lane] = __expf(u0 - umax); vec[V_EEND + 2 * lane + 1] = __expf(u1 - umax);
            vec[V_EMO + 2 * lane] = __expf(-(b0 + mx0)); vec[V_EMO + 2 * lane + 1] = __expf(-(b1 + mx1));
            const float m_loc = g + umax, m_new = fmaxf(g + mp, m_loc);
            if (lane == 0) { vec[V_SCAL] = __expf(g + mp - m_new); vec[V_SCAL + 1] = __expf(m_loc - m_new); }
            m_state = m_new;
        }
        bf16x8 qa[4];
#pragma unroll
        for (int ks = 0; ks < 4; ++ks) qa[ks] = *(const LAS bf16x8*)(lds + OFF_Q + (32 * rb + r) * QP + (16 * ks + 8 * hh) * 2);
        f32x16 Sv[2] = {}, Ov[2] = {};
#pragma unroll
        for (int t = 0; t < 2; ++t) {
            if (2 * ch + t <= rb) {
#pragma unroll
                for (int ks = 0; ks < 4; ++ks) { const bf16x8 kb = *(const LAS bf16x8*)(lds + OFF_K + (64 * ch + 32 * t + r) * QP + (16 * ks + 8 * hh) * 2);
                    Sv[t] = __builtin_amdgcn_mfma_f32_32x32x16_bf16(qa[ks], kb, Sv[t], 0, 0, 0); } }
        }
#pragma unroll
        for (int t = 0; t < 2; ++t) {
            const unsigned a0 = lbase + OFF_C + (8 * hh + q4) * CP + (64 * ch + 32 * t + 16 * blk + 4 * p4) * 2;
            s16x4 l0 = trr(a0), h0 = trr(a0 + 4 * CP), l1 = trr(a0 + 16 * CP), h1 = trr(a0 + 20 * CP), l2 = trr(a0 + 32 * CP), h2 = trr(a0 + 36 * CP), l3 = trr(a0 + 48 * CP), h3 = trr(a0 + 52 * CP);
            TRWAIT8(l0, h0, l1, h1, l2, h2, l3, h3);
            Ov[t] = __builtin_amdgcn_mfma_f32_32x32x16_bf16(qa[0], CAT(l0, h0), Ov[t], 0, 0, 0);
            Ov[t] = __builtin_amdgcn_mfma_f32_32x32x16_bf16(qa[1], CAT(l1, h1), Ov[t], 0, 0, 0);
            Ov[t] = __builtin_amdgcn_mfma_f32_32x32x16_bf16(qa[2], CAT(l2, h2), Ov[t], 0, 0, 0);
            Ov[t] = __builtin_amdgcn_mfma_f32_32x32x16_bf16(qa[3], CAT(l3, h3), Ov[t], 0, 0, 0);
        }
        { const int j = tid >> 2, part = tid & 3; float s = 0.f;
#pragma unroll
          for (int k2 = 0; k2 < 2; ++k2) { const bf16x8 qv = *(const LAS bf16x8*)(lds + OFF_Q + j * QP + (16 * part + 8 * k2) * 2);
#pragma unroll
              for (int e = 0; e < 8; ++e) s += bf2f((bf16_t)qv[e]) * vec[V_NST + 16 * part + 8 * k2 + e]; }
          s += __shfl_xor(s, 1); s += __shfl_xor(s, 2); if (part == 0) vec[V_QN + j] = s; }
        __syncthreads();
#pragma unroll
        for (int i = 0; i < 2; ++i) { const int chunk = tid + 512 * i, j = chunk >> 3, c8 = chunk & 7; const float ee = vec[V_EEND + j];
            const bf16x8 kv = *(const LAS bf16x8*)(lds + OFF_K + j * QP + c8 * 16); u32x4 w;
            w.x = cvt_pk_bf16(bf2f((bf16_t)kv[0]) * ee, bf2f((bf16_t)kv[1]) * ee); w.y = cvt_pk_bf16(bf2f((bf16_t)kv[2]) * ee, bf2f((bf16_t)kv[3]) * ee);
            w.z = cvt_pk_bf16(bf2f((bf16_t)kv[4]) * ee, bf2f((bf16_t)kv[5]) * ee); w.w = cvt_pk_bf16(bf2f((bf16_t)kv[6]) * ee, bf2f((bf16_t)kv[7]) * ee);
            *(LAS u32x4*)(lds + OFF_KE + j * QP + c8 * 16) = w; }
        {
            const float us0 = vec[V_U + 64 * ch + r] * L2E, us1 = vec[V_U + 64 * ch + 32 + r] * L2E;
#pragma unroll
            for (int i = 0; i < 16; ++i) { const int j = 32 * rb + crow(i, hh); const float mxj = vec[V_MX + j] * L2E, ei = vec[V_EINT + j];
                const int s0 = 64 * ch + r, s1 = s0 + 32;
                Sv[0][i] = (s0 <= j) ? Sv[0][i] * __builtin_amdgcn_exp2f(us0 - mxj) : 0.f;
                Sv[1][i] = (s1 <= j) ? Sv[1][i] * __builtin_amdgcn_exp2f(us1 - mxj) : 0.f;
                Ov[0][i] *= ei; Ov[1][i] *= ei; }
        }
        __syncthreads();
#pragma unroll
        for (int t = 0; t < 2; ++t)
#pragma unroll
            for (int i = 0; i < 16; ++i) *(LAS bf16_t*)(lds + OFF_Q + (32 * rb + crow(i, hh)) * SP + (64 * ch + 32 * t + r) * 2) = f2bf(Sv[t][i]);
        __syncthreads();
#pragma unroll 1
        for (int kp = 0; kp <= rb; ++kp) {
            const bf16x8 a0v = *(const LAS bf16x8*)(lds + OFF_Q + (32 * rb + r) * SP + (32 * kp + 8 * hh) * 2), a1v = *(const LAS bf16x8*)(lds + OFF_Q + (32 * rb + r) * SP + (32 * kp + 16 + 8 * hh) * 2);
            const unsigned a0 = lbase + OFF_V + (32 * kp + 8 * hh + q4) * VP + (64 * ch + 16 * blk + 4 * p4) * 2;
            s16x4 l0 = trr(a0), h0 = trr(a0 + 4 * VP), l1 = trr(a0 + 64), h1 = trr(a0 + 4 * VP + 64);
            s16x4 l2 = trr(a0 + 16 * VP), h2 = trr(a0 + 20 * VP), l3 = trr(a0 + 16 * VP + 64), h3 = trr(a0 + 20 * VP + 64);
            TRWAIT8(l0, h0, l1, h1, l2, h2, l3, h3);
            Ov[0] = __builtin_amdgcn_mfma_f32_32x32x16_bf16(a0v, CAT(l0, h0), Ov[0], 0, 0, 0);
            Ov[1] = __builtin_amdgcn_mfma_f32_32x32x16_bf16(a0v, CAT(l1, h1), Ov[1], 0, 0, 0);
            Ov[0] = __builtin_amdgcn_mfma_f32_32x32x16_bf16(a1v, CAT(l2, h2), Ov[0], 0, 0, 0);
            Ov[1] = __builtin_amdgcn_mfma_f32_32x32x16_bf16(a1v, CAT(l3, h3), Ov[1], 0, 0, 0);
        }
        { const int j = tid >> 2, part = tid & 3; float s = 0.f;
#pragma unroll
          for (int k4 = 0; k4 < 4; ++k4) { const bf16x8 sv = *(const LAS bf16x8*)(lds + OFF_Q + j * SP + (32 * part + 8 * k4) * 2);
#pragma unroll
              for (int e = 0; e < 8; ++e) s += bf2f((bf16_t)sv[e]); }
          s += __shfl_xor(s, 1); s += __shfl_xor(s, 2); if (part == 0) vec[V_RS + j] = s; }
        f32x16 Cl = {};
#pragma unroll 1
        for (int kp = 0; kp < 4; ++kp) {
            const unsigned aa = lbase + OFF_KE + (32 * kp + 8 * hh + q4) * QP + (32 * db + 16 * blk + 4 * p4) * 2;
            const unsigned ab = lbase + OFF_V + (32 * kp + 8 * hh + q4) * VP + (32 * eb + 16 * blk + 4 * p4) * 2;
            s16x4 la = trr(aa), ha = trr(aa + 4 * QP), lb = trr(ab), hb = trr(ab + 4 * VP), la2 = trr(aa + 16 * QP), ha2 = trr(aa + 20 * QP), lb2 = trr(ab + 16 * VP), hb2 = trr(ab + 20 * VP);
            TRWAIT8(la, ha, lb, hb, la2, ha2, lb2, hb2);
            Cl = __builtin_amdgcn_mfma_f32_32x32x16_bf16(CAT(la, ha), CAT(lb, hb), Cl, 0, 0, 0);
            Cl = __builtin_amdgcn_mfma_f32_32x32x16_bf16(CAT(la2, ha2), CAT(lb2, hb2), Cl, 0, 0, 0);
        }
        const float sa = vec[V_SCAL], sb = vec[V_SCAL + 1];
#pragma unroll
        for (int i = 0; i < 16; ++i) Cst[i] = sa * Cst[i] + sb * Cl[i];
        { const int d = tid & 63, part = tid >> 6; float s = 0.f;
#pragma unroll
          for (int k = 0; k < 16; ++k) s += bf2f(*(const LAS bf16_t*)(lds + OFF_KE + (16 * part + k) * QP + d * 2));
          vec[V_NPART + part * 64 + d] = s; }
        __syncthreads();
        if (tid < 64) { float nl = 0.f;
#pragma unroll
            for (int p = 0; p < 8; ++p) nl += vec[V_NPART + p * 64 + tid];
            vec[V_NST + tid] = sa * vec[V_NST + tid] + sb * nl; }
#pragma unroll
        for (int i = 0; i < 16; ++i) { const int j = 32 * rb + crow(i, hh);
            const float den = vec[V_EINT + j] * vec[V_QN + j] + vec[V_RS + j];
            const float scl = 1.0f / fmaxf(fabsf(den), vec[V_EMO + j]);
            *(unsigned*)(hdir + (size_t)POSB(cbase, j) * 512 + h * 128 + ch * 64 + r * 2) = cvt_pk_bf16(Ov[0][i] * scl, Ov[1][i] * scl); }
        __syncthreads();
    }
#undef POSB
#undef PREFETCH
}

__device__ __forceinline__ void mlstm_combine(const bf16_t* __restrict__ proj, const bf16_t* hf, const bf16_t* hb, bf16_t* __restrict__ mixed, const float* __restrict__ lstm_g, int seq, long row0, int h) {
    const int tid = opaque_tid(), part = tid & 3, base0 = 64 * (part >> 1) + 16 * (part & 1);
    const float* gp = lstm_g + h * 128 + base0;
    for (int r0 = 0; r0 < seq; r0 += 128) {
        const size_t row = (size_t)(row0 + r0 + (tid >> 2));
        const bf16_t* fp = hf + row * 512 + h * 128 + 32 * part; const bf16_t* bp = hb + row * 512 + h * 128 + 32 * part;
        const bf16_t* lop = proj + row * NPROJ + 2560 + h * 128 + base0; bf16_t* op = mixed + row * DM + 512 + h * 128 + base0;
        float hs[32]; float ss = 0.f;
#pragma unroll
        for (int k = 0; k < 4; ++k) { const bf16x8 a = *(const bf16x8*)(fp + 8 * k), b = *(const bf16x8*)(bp + 8 * k);
#pragma unroll
            for (int e = 0; e < 8; ++e) { const float x = bf2f((bf16_t)a[e]) + bf2f((bf16_t)b[e]); hs[8 * k + e] = x; ss += x * x; } }
        ss += __shfl_xor(ss, 1); ss += __shfl_xor(ss, 2);
        const float rs = rsqrtf(ss * (1.f / 128.f) + EPS);
#pragma unroll
        for (int t = 0; t < 2; ++t)
#pragma unroll
            for (int k = 0; k < 2; ++k) { const bf16x8 lo8 = *(const bf16x8*)(lop + 32 * t + 8 * k); float ov[8];
#pragma unroll
                for (int e = 0; e < 8; ++e) { const float lg = bf2f((bf16_t)lo8[e]); const float sg = 1.0f / (1.0f + __expf(-lg)); ov[e] = sg * hs[2 * (8 * k + e) + t] * rs * gp[32 * t + 8 * k + e]; }
                u32x4 w; w.x = cvt_pk_bf16(ov[0], ov[1]); w.y = cvt_pk_bf16(ov[2], ov[3]); w.z = cvt_pk_bf16(ov[4], ov[5]); w.w = cvt_pk_bf16(ov[6], ov[7]);
                *(u32x4*)(op + 32 * t + 8 * k) = w; }
    }
}
}

#define XB_TMO      128
#define XB_XCNT(j)  (256  + 64 * (j))
#define XB_XSUB(j)  (1280 + 64 * (j))
#define XB_XGEN(j)  (2304 + 64 * (j))
#define XB_TOP      3328
#define XB_TOPGEN   3392
#define XCD_BAR_WORDS 3456
#define XB_SPIN_CAP (1u << 22)
__device__ __forceinline__ unsigned xb_ld(unsigned* p)              { return __hip_atomic_load(p, __ATOMIC_RELAXED, __HIP_MEMORY_SCOPE_AGENT); }
__device__ __forceinline__ unsigned xb_add(unsigned* p, unsigned v) { return __hip_atomic_fetch_add(p, v, __ATOMIC_RELAXED, __HIP_MEMORY_SCOPE_AGENT); }
__device__ __forceinline__ unsigned xb_xcc_id() { return (unsigned)__builtin_amdgcn_s_getreg((3 << 11) | 20) & 0xFu; }
#define XB_SPIN(cond, bar) do { unsigned _sp = 0; while (cond) { __builtin_amdgcn_s_sleep(1); \
    if ((++_sp & 255u) == 0u) { if (xb_ld(&(bar)[XB_TMO])) break; if (_sp > XB_SPIN_CAP) { atomicAdd(&(bar)[XB_TMO], 1u); break; } } } } while (0)
__device__ __forceinline__ void xcd_barrier_complete(unsigned* bar, unsigned x, unsigned& nloc, unsigned& nx) {
    const unsigned G = gridDim.x * gridDim.y * gridDim.z;
    unsigned sum, cnt, mine, sp = 0u;
    for (;;) {
        sum = 0u; cnt = 0u; mine = 0u;
#pragma unroll
        for (unsigned j = 0; j < 16; ++j) { const unsigned c = xb_ld(&bar[XB_XCNT(j)]); sum += c; cnt += (c > 0u) ? 1u : 0u; mine = (j == x) ? c : mine; }
        if (sum == G) break;
        __builtin_amdgcn_s_sleep(1);
        if ((++sp & 255u) == 0u) { if (xb_ld(&bar[XB_TMO])) break; if (sp > XB_SPIN_CAP) { atomicAdd(&bar[XB_TMO], 1u); break; } }
    }
    nloc = mine > 0u ? mine : 1u; nx = cnt > 0u ? cnt : 1u;
}
__device__ __forceinline__ void xcd_barrier(unsigned* bar, volatile LAS unsigned* st) {
    asm volatile("s_waitcnt vmcnt(0)" ::: "memory");
    __syncthreads();
    if (threadIdx.x == 0) {
        const unsigned x = xb_xcc_id();
        __builtin_amdgcn_s_waitcnt(0);
        unsigned nloc = st[0], nx = st[1];
        if (nloc == 0u) { xcd_barrier_complete(bar, x, nloc, nx); st[0] = nloc; st[1] = nx; }
        const unsigned old = xb_add(&bar[XB_XSUB(x)], 1u);
        const unsigned gen = old / nloc;
        if (old + 1u == (gen + 1u) * nloc) {
            __builtin_amdgcn_fence(__ATOMIC_RELEASE, "agent");
            asm volatile("s_waitcnt vmcnt(0)" ::: "memory");
            const unsigned og = xb_add(&bar[XB_TOP], 1u);
            const unsigned tg = og / nx;
            if (og + 1u == (tg + 1u) * nx) xb_add(&bar[XB_TOPGEN], 1u);
            else XB_SPIN(xb_ld(&bar[XB_TOPGEN]) == tg, bar);
            __builtin_amdgcn_fence(__ATOMIC_ACQUIRE, "agent");
            xb_add(&bar[XB_XGEN(x)], 1u);
            asm volatile("s_waitcnt vmcnt(0)" ::: "memory");
        } else {
            XB_SPIN(xb_ld(&bar[XB_XGEN(x)]) == gen, bar);
            __builtin_amdgcn_fence(__ATOMIC_ACQUIRE, "agent");
            asm volatile("s_waitcnt vmcnt(0)" ::: "memory");
        }
    }
    __syncthreads();
}

struct Args {
    const float* xin[2]; const float* w_in; const float* gate_bias; const float* lam_q1; const float* lam_k1; const float* lam_q2; const float* lam_k2;
    const float* att_g; const float* lstm_g; const float* w_out; const float* ln1_g; const float* ln1_b; const float* w_gu; const float* conv_w; const float* conv_b;
    const float* w_down; const float* ln2_g; const float* ln2_b; float* out; unsigned char* ws; int ph_lo, ph_hi;
};
constexpr int NPHASE = 31;

__device__ __forceinline__ void transpose_item_fp8(const float* W, int K, int N, unsigned char* WT, int gu_map, const float* g, const float* b, float* c1, float* c2, LAS float* scr, int item, int lane) {
    const int nblk = N / 32, kb = item / nblk, nb = item % nblk, k0 = 64 * kb, n0 = 32 * nb;
    const int ncol = n0 + (lane & 31);
    float a1 = 0.f, a2 = 0.f;
#pragma unroll 8
    for (int i = 0; i < 32; ++i) { const int kk = 2 * i + (lane >> 5); float w = W[(size_t)(k0 + kk) * N + ncol];
        if (g) { a2 += w * b[k0 + kk]; w *= g[k0 + kk]; }
        w *= 64.0f;
        if (g) { const int q8 = __builtin_amdgcn_cvt_pk_fp8_f32(w, 0.f, 0, false); a1 += __builtin_amdgcn_cvt_f32_fp8(q8, 0); }
        scr[kk * 33 + (lane & 31)] = w; }
    asm volatile("s_waitcnt lgkmcnt(0)" ::: "memory");
    if (g) { a1 += __shfl_xor(a1, 32); a2 += __shfl_xor(a2, 32); }
    const int c = lane & 7;
#pragma unroll
    for (int j = 0; j < 4; ++j) { const int nl = (lane >> 3) + 8 * j; const int n = n0 + nl; const LAS float* s = scr + (8 * c) * 33 + nl;
        u32x2 o; o.x = cvt4_fp8(s[0 * 33], s[1 * 33], s[2 * 33], s[3 * 33]); o.y = cvt4_fp8(s[4 * 33], s[5 * 33], s[6 * 33], s[7 * 33]);
        int rowm = n; if (gu_map) { const int n2 = n < DFF ? n : n - DFF; rowm = 256 * (n2 >> 7) + (n < DFF ? 0 : 128) + (n2 & 127); }
        *(u32x2*)(WT + (size_t)rowm * K + k0 + 8 * c) = o; }
    if (g && lane < 32) { const int n2 = ncol < DFF ? ncol : ncol - DFF; const int rowm = 256 * (n2 >> 7) + (ncol < DFF ? 0 : 128) + (n2 & 127);
        atomicAdd(c1 + rowm, a1 * (1.0f / 64.0f)); atomicAdd(c2 + rowm, a2); }
    asm volatile("s_waitcnt lgkmcnt(0)" ::: "memory");
}
__device__ __forceinline__ void transpose_item(const float* W, int K, int N, bf16_t* WT, int gu_map, const float* g, const float* b, float* c1, float* c2, LAS float* scr, int item, int lane) {
    const int nblk = (N + 31) / 32, kb = item / nblk, nb = item % nblk, k0 = 64 * kb, n0 = 32 * nb;
    const int ncol = n0 + (lane & 31); const bool okc = ncol < N;
    float a1 = 0.f, a2 = 0.f;
#pragma unroll 8
    for (int i = 0; i < 32; ++i) { const int kk = 2 * i + (lane >> 5); float w = okc ? W[(size_t)(k0 + kk) * N + ncol] : 0.f;
        if (g) { a2 += w * b[k0 + kk]; w *= g[k0 + kk]; a1 += bf2f(f2bf(w)); }
        scr[kk * 33 + (lane & 31)] = w; }
    asm volatile("s_waitcnt lgkmcnt(0)" ::: "memory");
    if (g) { a1 += __shfl_xor(a1, 32); a2 += __shfl_xor(a2, 32); }
    const int c = lane & 7;
#pragma unroll
    for (int j = 0; j < 4; ++j) { const int nl = (lane >> 3) + 8 * j; const int n = n0 + nl; const LAS float* s = scr + (8 * c) * 33 + nl;
        u32x4 o; o.x = cvt_pk_bf16(s[0 * 33], s[1 * 33]); o.y = cvt_pk_bf16(s[2 * 33], s[3 * 33]); o.z = cvt_pk_bf16(s[4 * 33], s[5 * 33]); o.w = cvt_pk_bf16(s[6 * 33], s[7 * 33]);
        if (n < N) { int rowm = n; if (gu_map) { const int n2 = n < DFF ? n : n - DFF; rowm = 256 * (n2 >> 7) + (n < DFF ? 0 : 128) + (n2 & 127); }
            *(u32x4*)(WT + (size_t)rowm * K + k0 + 8 * c) = o; } }
    if (g && lane < 32 && okc) { int rowm = ncol; if (gu_map) { const int n2 = ncol < DFF ? ncol : ncol - DFF; rowm = 256 * (n2 >> 7) + (ncol < DFF ? 0 : 128) + (n2 & 127); }
        atomicAdd(c1 + rowm, a1); atomicAdd(c2 + rowm, a2); }
    asm volatile("s_waitcnt lgkmcnt(0)" ::: "memory");
}

__device__ __forceinline__ void cvt_rows(const float* x, bf16_t* xb, int gtid, int nthr) {
    for (size_t i = gtid; i < (size_t)MT * DM / 8; i += nthr) {
        const f32x4 a = *(const f32x4*)(x + i * 8), b = *(const f32x4*)(x + i * 8 + 4);
        u32x4 w; w.x = cvt_pk_bf16(a[0], a[1]); w.y = cvt_pk_bf16(a[2], a[3]); w.z = cvt_pk_bf16(b[0], b[1]); w.w = cvt_pk_bf16(b[2], b[3]);
        *(u32x4*)(xb + i * 8) = w; }
}

__global__ void __launch_bounds__(512, 2) fwd(Args args) {
    extern __shared__ __attribute__((aligned(16))) unsigned char lds_raw[];
    LAS unsigned char* lds = (LAS unsigned char*)lds_raw;
#if PROBE_TYPES
    unsigned long long tprev = __builtin_amdgcn_s_memrealtime(), tsel = 0; int ptype = 0;
#endif
    volatile LAS unsigned* xst = (volatile LAS unsigned*)(lds + LDS_BYTES - 32);
    if (threadIdx.x == 0) { xst[0] = 0u; xst[1] = 0u; (void)xb_add((unsigned*)(args.ws + CTL_XBAR) + XB_XCNT(xb_xcc_id()), 1u); }
    __syncthreads();
    for (int ph = args.ph_lo; ph < args.ph_hi; ++ph) {
        if (ph == args.ph_lo + 1) cg::this_grid().sync();
        else if (ph > args.ph_lo) xcd_barrier((unsigned*)(args.ws + CTL_XBAR), xst);
#if PROBE_TYPES
        { const unsigned long long tn = __builtin_amdgcn_s_memrealtime(); if (ph > args.ph_lo && ((PROBE_TYPES >> ptype) & 1)) tsel += tn - tprev; tprev = tn;
          if (ph == 0) ptype = 0; else { const int pp_ = (ph - 1) % 15; ptype = pp_ == 14 ? 8 : 1 + (pp_ % 7); } }
#endif
        const int tid = opaque_tid(), lane = tid & 63, wave = __builtin_amdgcn_readfirstlane(tid >> 6);
        const int G = gridDim.x, gtid = blockIdx.x * 512 + tid, nthr = G * 512;
        size_t wsoff = 0; asm volatile("" : "+s"(wsoff));
        unsigned char* ws = args.ws + wsoff;
        bf16_t* VB = (bf16_t*)(ws + WS_VB); unsigned char* XB8 = ws + WS_HDIR;
        bf16_t* XB = (bf16_t*)(ws + WS_XB); bf16_t* MIXED = (bf16_t*)(ws + WS_MIXED); bf16_t* PROJ = (bf16_t*)(ws + WS_PROJ); bf16_t* HMID = PROJ;
        float* GATES = (float*)(ws + WS_GATES); float* EDGE = (float*)(ws + WS_EDGE);
        f32x2* ST1 = (f32x2*)(ws + WS_ST1); f32x2* ST2 = (f32x2*)(ws + WS_ST2);
        float* LAMV = (float*)(ws + WS_LAM);
        float* C1IN = (float*)(ws + CTL_C1IN); float* C2IN = (float*)(ws + CTL_C2IN); float* C1GU = (float*)(ws + CTL_C1GU); float* C2GU = (float*)(ws + CTL_C2GU);
        unsigned* QCNT = (unsigned*)(ws + WS_CTL);
        if ((PHMASK & 1) && ph == 0) {
            LAS float* scr = (LAS float*)(lds + wave * 8448);
            const int gw = blockIdx.x * 8 + wave, NGW = G * 8;
            constexpr int I_IN = 16 * 97, I_OUT = 16 * 32, I_GU = 16 * 176, I_DN = 44 * 32, I_L = I_IN + I_OUT + I_GU + I_DN;
            for (int it = gw; it < 2 * I_L; it += NGW) {
                const int l = it / I_L; int r = it % I_L;
                if (r < I_IN) { transpose_item(args.w_in + (size_t)l * DM * NIN, DM, NIN, (bf16_t*)(ws + WS_WIN) + (size_t)l * NPROJ_PAD * DM, 0,
                                               l ? args.ln2_g : nullptr, l ? args.ln2_b : nullptr, C1IN, C2IN, scr, r, lane); continue; } r -= I_IN;
                if (r < I_OUT) { transpose_item(args.w_out + (size_t)l * DM * DM, DM, DM, (bf16_t*)(ws + WS_WOUT) + (size_t)l * DM * DM, 0, nullptr, nullptr, nullptr, nullptr, scr, r, lane); continue; } r -= I_OUT;
                if (r < I_GU) { transpose_item_fp8(args.w_gu + (size_t)l * DM * NGU, DM, NGU, (unsigned char*)(ws + WS_WGU) + (size_t)l * NGU * DM, 1,
                                                   args.ln1_g + l * DM, args.ln1_b + l * DM, C1GU + l * NGU, C2GU + l * NGU, scr, r, lane); continue; } r -= I_GU;
                transpose_item_fp8(args.w_down + (size_t)l * DFF * DM, DFF, DM, (unsigned char*)(ws + WS_WDN) + (size_t)l * DM * DFF, 0, nullptr, nullptr, nullptr, nullptr, scr, r, lane);
            }
            for (int i = gtid; i < 2 * (NPROJ_PAD - NIN) * DM / 8; i += nthr) { const int l = i / ((NPROJ_PAD - NIN) * DM / 8), o = i % ((NPROJ_PAD - NIN) * DM / 8);
                *(u32x4*)((bf16_t*)(ws + WS_WIN) + (size_t)l * NPROJ_PAD * DM + (size_t)NIN * DM + (size_t)o * 8) = (u32x4){0u, 0u, 0u, 0u}; }
            if (blockIdx.x == 0 && wave == 0) {
                for (int l = 0; l < 2; ++l) {
                    float s1 = args.lam_q1[l * 64 + lane] * args.lam_k1[l * 64 + lane], s2 = args.lam_q2[l * 64 + lane] * args.lam_k2[l * 64 + lane];
#pragma unroll
                    for (int o = 1; o < 64; o <<= 1) { s1 += __shfl_xor(s1, o); s2 += __shfl_xor(s2, o); }
                    const float lam_init = 0.8f - 0.6f * expf(-0.3f * (float)l);
                    if (lane == 0) LAMV[l] = expf(s1) - expf(s2) + lam_init;
                }
            }
            cvt_rows(args.xin[0], XB, gtid, nthr);
            continue;
        }
        const int trunk = (ph - 1) / 15, pp = (ph - 1) % 15;
        const int seq = trunk ? 2048 : 4096, nseq = trunk ? 32 : 16;
        float* V = args.out + (size_t)trunk * MT * DM;
        if ((PHMASK & 256) && pp == 14) {
            const float* g = args.ln2_g + DM; const float* b = args.ln2_b + DM;
            for (size_t i = gtid; i < (size_t)MT * DM / 8; i += nthr) { const int row = (int)(i >> 7), col = (int)(i & 127) * 8;
                float mu, rstd; row_stats(ST2, row, mu, rstd);
                const u32x4 xw = *(const u32x4*)(VB + i * 8);
                const f32x4 x0 = unph4(xw.x, xw.y), x1 = unph4(xw.z, xw.w);
                const f32x4 g0 = *(const f32x4*)(g + col), g1 = *(const f32x4*)(g + col + 4), b0 = *(const f32x4*)(b + col), b1 = *(const f32x4*)(b + col + 4);
                *(f32x4*)(V + i * 8) = (x0 - mu) * rstd * g0 + b0; *(f32x4*)(V + i * 8 + 4) = (x1 - mu) * rstd * g1 + b1; }
            if (trunk == 0) cvt_rows(args.xin[1], XB, gtid, nthr);
            continue;
        }
        const int l = pp / 7, sp0 = pp % 7, sp = sp0 == 0 ? 0 : sp0 - 1;
        unsigned* KMAX = (unsigned*)(ws + CTL_KMAX) + (trunk * 2 + l) * 128;
        if (sp0 == 1) {
            const int gw = blockIdx.x * 8 + wave, NGW = G * 8;
            for (int chunk = gw; chunk < MT / 32; chunk += NGW) {
                float mx = 0.f;
                for (int i = 0; i < 32; ++i) { const bf16x8 kv = *(const bf16x8*)(PROJ + (size_t)(chunk * 32 + i) * NPROJ + 512 + lane * 8); float ss = 0.f;
#pragma unroll
                    for (int e = 0; e < 8; ++e) { const float x = bf2f((bf16_t)kv[e]); ss += x * x; }
                    ss += __shfl_xor(ss, 1); ss += __shfl_xor(ss, 2); ss += __shfl_xor(ss, 4); mx = fmaxf(mx, ss); }
                if ((lane & 7) == 0) atomicMax(KMAX + ((chunk * 32) / seq) * 4 + (lane >> 4), __float_as_uint(mx));
            }
        } else if ((PHMASK & 2) && sp == 0) {
            pg8::Gemm g{XB, (const bf16_t*)(ws + WS_WIN) + (size_t)l * NPROJ_PAD * DM, MT, NPROJ_PAD, DM};
            pg8::StaticOrder S; S.init(MT, NPROJ_PAD, G, (int)blockIdx.x);
            EpiProj E{PROJ, GATES, args.gate_bias + l * 16, l ? ST2 : nullptr, C1IN, C2IN, (LAS f32x2*)(lds + EPI_LDS + 8192)};
            pg8::gemm_phase<EpiProj, pg8::StaticOrder>(lds, g, S, E);
        } else if ((PHMASK & 12) && sp == 1) {
            unsigned* qc = QCNT + (size_t)((trunk * 2 + l) * 8) * 64;
            const int myx = (int)(__builtin_amdgcn_s_getreg((3 << 11) | 20) & 7);
            const int npair = nseq / 2, nqb = seq / 128, nitems = npair * (2 + nqb);
            unsigned* FLAG = (unsigned*)(ws + CTL_FLAG) + (trunk * 2 + l) * 128;
            bf16_t* HDIR = (bf16_t*)(ws + WS_HDIR);
            const float lam = LAMV[l]; const float lam_init = 0.8f - 0.6f * expf(-0.3f * (float)l);
            LAS int* sitem = (LAS int*)(lds + LDS_BYTES - 64);
            for (int qq = 0; qq < 8; ++qq) {
                const int x = (myx + qq) & 7;
                for (;;) {
                    if (tid == 0) sitem[0] = (int)atomicAdd(qc + 64 * x, 1u);
                    __syncthreads();
                    const int item = sitem[0];
                    __syncthreads();
                    if (item >= nitems) break;
                    const int nbh = nseq / 8;
                    if ((PHMASK & 4) && item < 2 * npair) {
                        const int pi = item >> 1, dir = item & 1, h = 3 - pi / nbh, b = ((x - 2 * h) & 7) + 8 * (pi % nbh);
                        ml::mlstm_dir(PROJ, GATES, HDIR + (size_t)dir * MT * 512, seq, (long)b * seq, h, dir, lds);
                        __threadfence();
                        __syncthreads();
                        if (tid == 0) sitem[1] = (int)atomicAdd(FLAG + b * 4 + h, 1u);
                        __syncthreads();
                        const int old = sitem[1];
                        if (old == 1) { __threadfence(); ml::mlstm_combine(PROJ, HDIR, HDIR + (size_t)MT * 512, MIXED, args.lstm_g + l * 512, seq, (long)b * seq, h); }
                        __syncthreads();
                    } else if (PHMASK & 8) {
                        const int a = item - 2 * npair, pi = a / nqb, qb = a % nqb, h = 3 - pi / nbh, b = ((x - 2 * h) & 7) + 8 * (pi % nbh);
                        const float slope = exp2f(-2.0f * (float)(h + 1));
                        att::attn_unit(PROJ, MIXED, args.att_g + l * 512, seq, (long)b * seq, h, qb, lam, -slope, 1.0f - lam_init, __uint_as_float(KMAX[b * 4 + h]), (LAS char*)lds);
                    }
                }
            }
        } else if ((PHMASK & 16) && sp == 2) {
            pg8::Gemm g{MIXED, (const bf16_t*)(ws + WS_WOUT) + (size_t)l * DM * DM, MT, DM, DM};
            pg8::StaticOrder S; S.init(MT, DM, G, (int)blockIdx.x);
            if (l == 0) { EpiRes<true> E{XB, VB, nullptr, args.ln2_g, args.ln2_b, ST1, (LAS f32x2*)(lds + EPI_LDS), (LAS f32x2*)(lds + EPI_LDS + 8192), XB8, 1.0f, nullptr};
                          pg8::gemm_phase<EpiRes<true>, pg8::StaticOrder>(lds, g, S, E); }
            else { EpiRes<false> E{VB, VB, ST2, args.ln2_g, args.ln2_b, ST1, (LAS f32x2*)(lds + EPI_LDS), (LAS f32x2*)(lds + EPI_LDS + 8192), XB8, 1.0f, nullptr};
                   pg8::gemm_phase<EpiRes<false>, pg8::StaticOrder>(lds, g, S, E); }
        } else if ((PHMASK & 32) && sp == 3) {
            pg8::Gemm g{XB8, (const unsigned char*)(ws + WS_WGU) + (size_t)l * NGU * DM, MT, NGU, DM};
            pg8::StaticOrder S; S.init(MT, NGU, G, (int)blockIdx.x);
            EpiGU E{(unsigned char*)HMID, EDGE, ST1, C1GU + l * NGU, C2GU + l * NGU, args.conv_w + (size_t)l * 3 * DFF, args.conv_b + (size_t)l * DFF, (LAS float*)(lds + EPI_LDS), (LAS f32x2*)(lds + EPI_LDS + 8192)};
            pg8::gemm_phase<EpiGU, pg8::StaticOrder, true>(lds, g, S, E);
        } else if ((PHMASK & 64) && sp == 4) {
            const float* cw = args.conv_w + (size_t)l * 3 * DFF; const float* cb = args.conv_b + (size_t)l * DFF; const int st = seq / 256;
            for (int i = gtid; i < 256 * 2 * (DFF / 4); i += nthr) {
                const int grp = i % (DFF / 4), e2 = (i / (DFF / 4)) & 1, pm = i / (2 * (DFF / 4)), j = grp * 4;
                const float* Ep = EDGE + (size_t)pm * 6 * DFF + j;
                const f32x4 w0 = *(const f32x4*)(cw + j), w1 = *(const f32x4*)(cw + DFF + j), w2 = *(const f32x4*)(cw + 2 * DFF + j), cbv = *(const f32x4*)(cb + j);
                f32x4 ga, gb, gc, up; const f32x4 z = (f32x4){0.f, 0.f, 0.f, 0.f}; int row;
                if (e2 == 0) { ga = (pm % st == 0) ? z : *(const f32x4*)(Ep - 6 * DFF + 3 * DFF); gb = *(const f32x4*)(Ep); gc = *(const f32x4*)(Ep + DFF); up = *(const f32x4*)(Ep + 4 * DFF); row = pm * 256; }
                else { ga = *(const f32x4*)(Ep + 2 * DFF); gb = *(const f32x4*)(Ep + 3 * DFF); gc = (pm % st == st - 1) ? z : *(const f32x4*)(Ep + 6 * DFF); up = *(const f32x4*)(Ep + 5 * DFF); row = pm * 256 + 255; }
                const f32x4 cv = cbv + w0 * ga + w1 * gb + w2 * gc;
                *(unsigned*)((unsigned char*)HMID + (size_t)row * DFF + j) = cvt4_fp8(gelu_erf(cv[0]) * up[0] * 16.f, gelu_erf(cv[1]) * up[1] * 16.f, gelu_erf(cv[2]) * up[2] * 16.f, gelu_erf(cv[3]) * up[3] * 16.f); }
        } else if (PHMASK & 128) {
            pg8::Gemm g{HMID, (const unsigned char*)(ws + WS_WDN) + (size_t)l * DM * DFF, MT, DM, DFF};
            pg8::StaticOrder S; S.init(MT, DM, G, (int)blockIdx.x);
            EpiRes<false> E{VB, VB, ST1, args.ln1_g + l * DM, args.ln1_b + l * DM, ST2, (LAS f32x2*)(lds + EPI_LDS), (LAS f32x2*)(lds + EPI_LDS + 8192), nullptr, 1.0f / 1024.0f, l == 0 ? XB : nullptr};
            pg8::gemm_phase<EpiRes<false>, pg8::StaticOrder, true>(lds, g, S, E);
        }
    }
#if PROBE_TYPES
    { const unsigned long long tn = __builtin_amdgcn_s_memrealtime(); if ((PROBE_TYPES >> ptype) & 1) tsel += tn - tprev;
      if (blockIdx.x == 0 && threadIdx.x == 0) { while (__builtin_amdgcn_s_memrealtime() - tn < tsel) __builtin_amdgcn_s_sleep(8); } }
#endif
}

extern "C" void kernel_launch(void* const* d_in, const int* in_sizes, int n_in, void* d_out, int out_size, void* d_ws, size_t ws_size, hipStream_t stream) {
    static int grid = 0;
    if (grid == 0) {
        if (n_in != 19 || ws_size < WS_END) { fprintf(stderr, "kernel_launch: unexpected n_in %d / ws %zu\n", n_in, ws_size); grid = -1; return; }
        int dev = 0, cus = 0, per_cu = 0;
        hipGetDevice(&dev); hipDeviceGetAttribute(&cus, hipDeviceAttributeMultiprocessorCount, dev);
        if (hipFuncSetAttribute((const void*)fwd, hipFuncAttributeMaxDynamicSharedMemorySize, LDS_BYTES) != hipSuccess) { fprintf(stderr, "kernel_launch: hipFuncSetAttribute failed\n"); grid = -1; return; }
        hipOccupancyMaxActiveBlocksPerMultiprocessor(&per_cu, (const void*)fwd, 512, LDS_BYTES);
        (void)hipGetLastError();
        if (per_cu < 1) per_cu = 1;
        grid = cus;
    }
    if (grid < 0) return;
    hipMemsetAsync((char*)d_ws + WS_CTL, 0, CTL_BYTES, stream);
    Args a{};
    a.xin[0] = (const float*)d_in[0]; a.xin[1] = (const float*)d_in[1]; a.w_in = (const float*)d_in[2]; a.gate_bias = (const float*)d_in[3];
    a.lam_q1 = (const float*)d_in[4]; a.lam_k1 = (const float*)d_in[5]; a.lam_q2 = (const float*)d_in[6]; a.lam_k2 = (const float*)d_in[7];
    a.att_g = (const float*)d_in[8]; a.lstm_g = (const float*)d_in[9]; a.w_out = (const float*)d_in[10]; a.ln1_g = (const float*)d_in[11]; a.ln1_b = (const float*)d_in[12];
    a.w_gu = (const float*)d_in[13]; a.conv_w = (const float*)d_in[14]; a.conv_b = (const float*)d_in[15]; a.w_down = (const float*)d_in[16]; a.ln2_g = (const float*)d_in[17]; a.ln2_b = (const float*)d_in[18];
    a.out = (float*)d_out; a.ws = (unsigned char*)d_ws;
#if MK_MULTI
    for (int ph = 0; ph < NPHASE; ++ph) { a.ph_lo = ph; a.ph_hi = ph + 1; hipLaunchKernelGGL(fwd, dim3(grid), dim3(512), LDS_BYTES, stream, a); }
#else
    a.ph_lo = 0; a.ph_hi = NPHASE;
    void* kargs[] = {&a};
    hipError_t e = hipLaunchCooperativeKernel((const void*)fwd, dim3(grid), dim3(512), kargs, LDS_BYTES, stream);
    if (e != hipSuccess) fprintf(stderr, "kernel_launch: cooperative launch failed: %s (grid %d)\n", hipGetErrorString(e), grid);
#endif
}
```

```cpp
#include <hip/hip_runtime.h>
#include <hip/hip_cooperative_groups.h>
#include <cstdio>
#include <cstdint>
namespace cg = cooperative_groups;

#ifndef PHMASK
#define PHMASK 0xffff
#endif
#ifndef PROBE_TYPES
#define PROBE_TYPES 0
#endif
#ifndef MK_MULTI
#define MK_MULTI 0
#endif

#define LAS __attribute__((address_space(3)))
typedef unsigned short bf16_t;
typedef short bf16x8 __attribute__((ext_vector_type(8)));
typedef short s16x4 __attribute__((ext_vector_type(4)));
typedef float f32x2 __attribute__((ext_vector_type(2)));
typedef float f32x4 __attribute__((ext_vector_type(4)));
typedef float f32x8 __attribute__((ext_vector_type(8)));
typedef float f32x16 __attribute__((ext_vector_type(16)));
typedef _Float16 h16x8 __attribute__((ext_vector_type(8)));
typedef unsigned u32x2 __attribute__((ext_vector_type(2)));
typedef unsigned u32x4 __attribute__((ext_vector_type(4)));

constexpr int DM = 1024, NPROJ = 3072, NPROJ_PAD = 3328, NIN = 3088, DFF = 2816, NGU = 5632;
constexpr int MT = 65536;
constexpr float ALPHA = 1.4142135623730951f, EPS = 1e-5f;
constexpr int LDS_BYTES = 147456;
constexpr int EPI_LDS = 131072;

constexpr size_t MiB = 1u << 20;
constexpr size_t WS_CTL = 0, CTL_BYTES = 1 * MiB;
constexpr size_t CTL_FLAG = 40960;
constexpr size_t CTL_XBAR = 262144;
constexpr size_t CTL_KMAX = 32768;
constexpr size_t CTL_C1IN = 65536, CTL_C2IN = 81920, CTL_C1GU = 98304, CTL_C2GU = 147456;
constexpr size_t WS_LAM = 1 * MiB;
constexpr size_t WS_WIN = 2 * MiB, WS_WOUT = 15 * MiB, WS_WGU = 19 * MiB, WS_WDN = 41 * MiB;
constexpr size_t WS_ST1 = 52 * MiB, WS_ST2 = 54 * MiB, WS_GATES = 56 * MiB, WS_EDGE = 60 * MiB;
constexpr size_t WS_XB = 80 * MiB, WS_MIXED = 208 * MiB, WS_PROJ = 336 * MiB, WS_HDIR = 720 * MiB, WS_VB = 848 * MiB, WS_END = 976 * MiB;

__device__ __forceinline__ unsigned cvt_pk_bf16(float lo, float hi) { unsigned r; asm volatile("v_cvt_pk_bf16_f32 %0, %1, %2" : "=v"(r) : "v"(lo), "v"(hi)); return r; }
__device__ __forceinline__ unsigned cvt4_fp8(float a, float b, float c, float d) { int w = 0; w = __builtin_amdgcn_cvt_pk_fp8_f32(a, b, w, false); w = __builtin_amdgcn_cvt_pk_fp8_f32(c, d, w, true); return (unsigned)w; }
__device__ __forceinline__ float bf2f(bf16_t b) { return __uint_as_float(((unsigned)b) << 16); }
__device__ __forceinline__ bf16_t f2bf(float f) { return (bf16_t)(cvt_pk_bf16(f, 0.f) & 0xffffu); }
__device__ __forceinline__ float gelu_erf(float v) {
    const float av = fabsf(v), t = __builtin_amdgcn_rcpf(av * 0.2316418882f + 1.0f);
    float q = t * 0.5307027145f + (-0.7265760135f); q = q * t + 0.7107068705f; q = q * t + (-0.142248368f); q = q * t + 0.127414796f; q = q * t;
    const float e = __builtin_amdgcn_exp2f((v * v) * (-0.72134752044f));
    const float m = v * (q * e);
    return v < 0.f ? m : v - m;
}
__device__ __forceinline__ int crow(int r, int hi) { return (r & 3) + 8 * (r >> 2) + 4 * hi; }
#define EPI_BAR() do { asm volatile("s_waitcnt lgkmcnt(0)" ::: "memory"); __builtin_amdgcn_s_barrier(); asm volatile("" ::: "memory"); } while (0)
#define SBAR() __builtin_amdgcn_sched_barrier(0)
__device__ __forceinline__ int opaque_tid() { int t = threadIdx.x; asm volatile("" : "+v"(t)); return t; }

namespace pg8 {
constexpr int BM = 256, BK = 64, HALF = 128, HTB = HALF * BK * 2, STAGE_BYTES = 8 * HTB, NXCD = 8, WGM = 8;
__host__ __device__ __forceinline__ int lds_byte(int r, int c) { const int st = (r >> 4) * 2 + (c >> 5), rr = r & 15, cc = c & 31, ob = rr * 64 + cc * 2; return st * 1024 + (ob ^ (((ob >> 9) & 1) << 5)); }
__host__ __device__ __forceinline__ void stage_rc(int b, int& R, int& C) { const int st = b / 1024, sb = b % 1024, swz = sb ^ (((sb >> 9) & 1) << 5); R = (st >> 1) * 16 + swz / 64; C = (st & 1) * 32 + (swz % 64) / 2; }
__host__ __device__ __forceinline__ int perm32(int rho) { const int n = rho >> 4, i = rho & 15; return 8 * (i >> 2) + 4 * n + (i & 3); }
struct Unit { int pm, pn; };
struct Gemm { const void* A; const void* Bt; int M, N, K; };
typedef int i32x8 __attribute__((ext_vector_type(8)));
struct StaticOrder {
    int nM, nN, nwg, G, c;
    __host__ __device__ void init(int M, int N, int G_, int c_) { nM = M / BM; nN = N / BM; nwg = nM * nN; G = G_; c = c_; }
    __host__ __device__ bool next(int i, Unit& u) const {
        const long L = (long)i * G + c; if (L >= nwg) return false;
        int wgid = (int)L; { const int q = nwg / NXCD, r = nwg % NXCD, xcd = wgid % NXCD, off = wgid / NXCD; wgid = (xcd < r ? xcd * (q + 1) : r * (q + 1) + (xcd - r) * q) + off; }
        const int nig = WGM * nN, gid = wgid / nig, fm = gid * WGM, gsz = (nM - fm) < WGM ? (nM - fm) : WGM;
        u.pm = fm + ((wgid % nig) % gsz); u.pn = (wgid % nig) / gsz; return true;
    }
    __device__ __forceinline__ void a_ready(const Unit&) const {}
    __device__ __forceinline__ void done(const Unit&) const {}
};

template <class Epi, class Sched, bool FP8 = false>
__device__ __forceinline__ void gemm_phase(LAS unsigned char* lds, const Gemm g, const Sched& S, const Epi& E) {
    const int tid = opaque_tid(), wid = __builtin_amdgcn_readfirstlane(tid >> 6), lane = tid & 63, wr = wid >> 2, wc = wid & 3, fr = lane & 15, fq = lane >> 4;
    const int pitch = FP8 ? g.K : 2 * g.K, nt = pitch / 128;
    unsigned voffA[2], voffB[2];
#pragma unroll
    for (int i = 0; i < 2; ++i) { int R, C; stage_rc(tid * 16 + i * 8192, R, C); const int Rb = Epi::PERM ? ((R & ~31) + perm32(R & 31)) : R;
        voffA[i] = (unsigned)(R * pitch + 2 * C); voffB[i] = (unsigned)(Rb * pitch + 2 * C); }
    const size_t kstep = (size_t)128;
    const size_t hstep = (size_t)HALF * pitch;
    const size_t tstep = 2 * hstep;
    const unsigned ldsw = (unsigned)wid * 1024u;
    const int aoff0 = FP8 ? lds_byte(wr * 64 + fr, 16 * fq) : lds_byte(wr * 64 + fr, fq * 8), aoff1 = aoff0 + (FP8 ? 16 : 1024);
    const int boff0 = FP8 ? lds_byte(wc * 32 + fr, 16 * fq) : lds_byte(wc * 32 + fr, fq * 8), boff1 = boff0 + (FP8 ? 16 : 1024);
#define PG8_SA(b, h) (((b) * 2 + (h)) * HTB)
#define PG8_SB(b, h) ((4 + (b) * 2 + (h)) * HTB)
#define PG8_STAGE(bufoff, gbase, voff) do { _Pragma("unroll") for (int _i = 0; _i < 2; ++_i) \
        __builtin_amdgcn_global_load_lds((const unsigned*)((const char*)(gbase) + (voff)[_i]), (LAS unsigned*)(lds + (bufoff) + ldsw + _i * 8192), 16, 0, 0); } while (0)
#define PG8_RD16(off) (*(const LAS bf16x8*)(lds + (off)))
#define PG8_CAT8(lo, hi) __builtin_bit_cast(i32x8, __builtin_shufflevector((lo), (hi), 0, 1, 2, 3, 4, 5, 6, 7, 8, 9, 10, 11, 12, 13, 14, 15))
#define PG8_LDA(dst, b, h) do { _Pragma("unroll") for (int m = 0; m < 4; ++m) { \
        if constexpr (FP8) { const bf16x8 lo_ = PG8_RD16(PG8_SA(b, h) + aoff0 + m * 2048), hi_ = PG8_RD16(PG8_SA(b, h) + aoff1 + m * 2048); dst##8[m] = PG8_CAT8(lo_, hi_); } \
        else { dst[m][0] = PG8_RD16(PG8_SA(b, h) + aoff0 + m * 2048); dst[m][1] = PG8_RD16(PG8_SA(b, h) + aoff1 + m * 2048); } } } while (0)
#define PG8_LDB(dst, b, h) do { _Pragma("unroll") for (int n = 0; n < 2; ++n) { \
        if constexpr (FP8) { const bf16x8 lo_ = PG8_RD16(PG8_SB(b, h) + boff0 + n * 2048), hi_ = PG8_RD16(PG8_SB(b, h) + boff1 + n * 2048); dst##8[n] = PG8_CAT8(lo_, hi_); } \
        else { dst[n][0] = PG8_RD16(PG8_SB(b, h) + boff0 + n * 2048); dst[n][1] = PG8_RD16(PG8_SB(b, h) + boff1 + n * 2048); } } } while (0)
#define PG8_MMA(ai, bj, At, Bt) do { __builtin_amdgcn_s_setprio(1); _Pragma("unroll") for (int m = 0; m < 4; ++m) _Pragma("unroll") for (int n = 0; n < 2; ++n) { \
        if constexpr (FP8) asm volatile("v_mfma_f32_16x16x128_f8f6f4 %0, %1, %2, %0" : "+v"(acc[ai][bj][m][n]) : "v"(Bt##8[n]), "v"(At##8[m]));   \
        else { _Pragma("unroll") for (int k = 0; k < 2; ++k) acc[ai][bj][m][n] = __builtin_amdgcn_mfma_f32_16x16x32_bf16(Bt[n][k], At[m][k], acc[ai][bj][m][n], 0, 0, 0); } } \
        __builtin_amdgcn_s_setprio(0); } while (0)
#define PG8_WAIT_V(n) asm volatile("s_waitcnt vmcnt(" #n ")" ::: "memory")
#define PG8_WAIT_L(n) asm volatile("s_waitcnt lgkmcnt(" #n ")" ::: "memory")
#define PG8_BAR __builtin_amdgcn_s_barrier()
#define PG8_SCHED __builtin_amdgcn_sched_barrier(0)
    Unit cur, nxt; int ui = 0;
    if (!S.next(0, cur)) return;
    f32x4 acc[2][2][4][2];
#pragma unroll
    for (int a = 0; a < 2; ++a)
#pragma unroll
        for (int b = 0; b < 2; ++b)
#pragma unroll
            for (int m = 0; m < 4; ++m)
#pragma unroll
                for (int n = 0; n < 2; ++n) acc[a][b][m][n] = (f32x4){0.f, 0.f, 0.f, 0.f};
    bf16x8 At[4][2], B0[2][2], B1[2][2]; i32x8 At8[4], B08[2], B18[2];
    const char* cA = (const char*)g.A + (size_t)cur.pm * tstep; const char* cB = (const char*)g.Bt + (size_t)cur.pn * tstep;
    PG8_STAGE(PG8_SB(0, 0), cB, voffB); PG8_STAGE(PG8_SB(0, 1), cB + hstep, voffB); PG8_STAGE(PG8_SA(0, 0), cA, voffA); PG8_STAGE(PG8_SA(0, 1), cA + hstep, voffA);
    if (wr == 1) PG8_BAR;
    PG8_WAIT_V(2); PG8_BAR;
    PG8_STAGE(PG8_SB(1, 0), cB + kstep, voffB); PG8_STAGE(PG8_SA(1, 0), cA + kstep, voffA); PG8_STAGE(PG8_SB(1, 1), cB + hstep + kstep, voffB);
    PG8_WAIT_V(6); PG8_BAR;
    for (;;) {
        const bool has_next = S.next(ui + 1, nxt);
        const char* nA = has_next ? (const char*)g.A + (size_t)nxt.pm * tstep : cA; const char* nB = has_next ? (const char*)g.Bt + (size_t)nxt.pn * tstep : cB;
#pragma unroll 1
        for (int t = 0; t < nt; t += 2) {
            const bool last = (t == nt - 2);
            const char* a1 = cA + (size_t)(t + 1) * kstep;
            const char* a2 = last ? nA : cA + (size_t)(t + 2) * kstep; const char* b2 = last ? nB : cB + (size_t)(t + 2) * kstep;
            const char* a3 = a2 + kstep; const char* b3 = b2 + kstep;
            PG8_LDB(B0, 0, 0); PG8_LDB(B1, 0, 1); PG8_SCHED; PG8_LDA(At, 0, 0); PG8_STAGE(PG8_SA(1, 1), a1 + hstep, voffA);
            PG8_WAIT_V(8); PG8_WAIT_L(0); PG8_BAR; PG8_MMA(0, 0, At, B0); PG8_MMA(0, 1, At, B1); PG8_BAR; PG8_SCHED;
            PG8_LDA(At, 0, 1); PG8_STAGE(PG8_SB(0, 0), b2, voffB); PG8_STAGE(PG8_SB(0, 1), b2 + hstep, voffB); PG8_STAGE(PG8_SA(0, 0), a2, voffA);
            PG8_WAIT_V(8); PG8_WAIT_L(0); PG8_BAR; PG8_MMA(1, 0, At, B0); PG8_MMA(1, 1, At, B1); PG8_BAR; PG8_SCHED;
            PG8_LDB(B0, 1, 0); PG8_LDB(B1, 1, 1); PG8_SCHED; PG8_LDA(At, 1, 0); PG8_STAGE(PG8_SA(0, 1), a2 + hstep, voffA);
            PG8_WAIT_V(8); PG8_WAIT_L(0); PG8_BAR; PG8_MMA(0, 0, At, B0); PG8_MMA(0, 1, At, B1); PG8_BAR; PG8_SCHED;
            PG8_LDA(At, 1, 1); PG8_STAGE(PG8_SB(1, 0), b3, voffB); PG8_STAGE(PG8_SB(1, 1), b3 + hstep, voffB); PG8_STAGE(PG8_SA(1, 0), a3, voffA);
            PG8_WAIT_V(8); PG8_WAIT_L(0); PG8_BAR; PG8_MMA(1, 0, At, B0); PG8_MMA(1, 1, At, B1); PG8_BAR; PG8_SCHED;
        }
        if (wr == 0) PG8_BAR;
        if constexpr (FP8) asm volatile("s_nop 15\n\ts_nop 15" ::: "memory");
        E(acc, cur, wr, wc, fr, fq);
        if (!has_next) break;
#pragma unroll
        for (int a = 0; a < 2; ++a)
#pragma unroll
            for (int b = 0; b < 2; ++b)
#pragma unroll
                for (int m = 0; m < 4; ++m)
#pragma unroll
                    for (int n = 0; n < 2; ++n) acc[a][b][m][n] = (f32x4){0.f, 0.f, 0.f, 0.f};
        cur = nxt; cA = nA; cB = nB; ++ui;
        if (wr == 1) PG8_BAR;
    }
    PG8_WAIT_V(0);
    PG8_BAR;
#undef PG8_SA
#undef PG8_SB
#undef PG8_STAGE
#undef PG8_LDA
#undef PG8_LDB
#undef PG8_MMA
#undef PG8_CAT8
#undef PG8_RD16
#undef PG8_WAIT_V
#undef PG8_WAIT_L
#undef PG8_BAR
#undef PG8_SCHED
}
}

__device__ __forceinline__ f32x2 gelu_pk(f32x2 v) {
    const f32x2 av = __builtin_elementwise_abs(v), d = av * 0.2316418882f + 1.0f;
    f32x2 t; t.x = __builtin_amdgcn_rcpf(d.x); t.y = __builtin_amdgcn_rcpf(d.y);
    f32x2 q = t * 0.5307027145f + (-0.7265760135f); q = q * t + 0.7107068705f; q = q * t + (-0.142248368f); q = q * t + 0.127414796f; q = q * t;
    const f32x2 s = (v * v) * (-0.72134752044f);
    f32x2 e; e.x = __builtin_amdgcn_exp2f(s.x); e.y = __builtin_amdgcn_exp2f(s.y);
    const f32x2 m = v * (q * e), r = v - m;
    f32x2 o; o.x = v.x < 0.f ? m.x : r.x; o.y = v.y < 0.f ? m.y : r.y; return o;
}
__device__ __forceinline__ void row_stats(const f32x2* st, int row, float& mu, float& rstd) {
    const f32x4 a = *(const f32x4*)(st + (size_t)row * 4), b = *(const f32x4*)(st + (size_t)row * 4 + 2);
    const float s = (a[0] + a[2]) + (b[0] + b[2]), q = (a[1] + a[3]) + (b[1] + b[3]);
    mu = s * (1.f / 1024.f); const float var = fmaxf(q * (1.f / 1024.f) - mu * mu, 0.f); rstd = rsqrtf(var + EPS);
}

__device__ __forceinline__ void tile_stats_to_lds(const f32x2* st, int row0, LAS f32x2* S, int tid) {
    if (tid < 256) { float mu, rstd; row_stats(st, row0 + tid, mu, rstd); S[tid] = (f32x2){mu, rstd}; }
    EPI_BAR();
}
struct EpiProj {
    static constexpr bool PERM = true;
    bf16_t* O; float* gates; const float* gate_bias; const f32x2* stats; const float* c1; const float* c2; LAS f32x2* S;
    __device__ __forceinline__ void operator()(f32x4 (&acc)[2][2][4][2], const pg8::Unit& u, int wr, int wc, int fr, int fq) const {
        asm volatile("" : "+v"(fr), "+v"(fq));
        const int colt = u.pn * 256 + wc * 32 + 8 * fq;
        if (stats) tile_stats_to_lds(stats, u.pm * 256, S, (wr * 4 + wc) * 64 + fq * 16 + fr);
        f32x4 c1v[2][2], c2v[2][2];
#pragma unroll
        for (int bj = 0; bj < 2; ++bj)
#pragma unroll
            for (int n = 0; n < 2; ++n) {
                if (stats) { c1v[bj][n] = *(const f32x4*)(c1 + colt + bj * 128 + 4 * n); c2v[bj][n] = *(const f32x4*)(c2 + colt + bj * 128 + 4 * n); }
                else { c1v[bj][n] = (f32x4){0.f, 0.f, 0.f, 0.f}; c2v[bj][n] = (f32x4){0.f, 0.f, 0.f, 0.f}; } }
        const float sc = (u.pn < 2 || u.pn == 7) ? 0.125f : 1.0f;
#pragma unroll
        for (int ai = 0; ai < 2; ++ai)
#pragma unroll
            for (int m = 0; m < 4; ++m) {
                const int row = u.pm * 256 + ai * 128 + wr * 64 + m * 16 + fr;
                float mu = 0.f, rstd = 1.f; if (stats) { const f32x2 sr = S[ai * 128 + wr * 64 + m * 16 + fr]; mu = sr.x; rstd = sr.y; }
                if (u.pn < 12) {
#pragma unroll
                    for (int bj = 0; bj < 2; ++bj) {
                        const f32x4 v0 = ((acc[ai][bj][m][0] - mu * c1v[bj][0]) * rstd + c2v[bj][0]) * sc, v1 = ((acc[ai][bj][m][1] - mu * c1v[bj][1]) * rstd + c2v[bj][1]) * sc;
                        u32x4 w; w.x = cvt_pk_bf16(v0[0], v0[1]); w.y = cvt_pk_bf16(v0[2], v0[3]); w.z = cvt_pk_bf16(v1[0], v1[1]); w.w = cvt_pk_bf16(v1[2], v1[3]);
                        *(u32x4*)(O + (size_t)row * NPROJ + colt + bj * 128) = w; }
                } else if (wc == 0 && fq < 2) {
#pragma unroll
                    for (int n = 0; n < 2; ++n) {
                        const f32x4 gb = *(const f32x4*)(gate_bias + 8 * fq + 4 * n);
                        *(f32x4*)(gates + (size_t)row * 16 + 8 * fq + 4 * n) = (acc[ai][0][m][n] - mu * c1v[0][n]) * rstd + c2v[0][n] + gb; }
                }
            }
    }
};

__device__ __forceinline__ unsigned pkh2(float a, float b) { return (unsigned)__builtin_bit_cast(unsigned short, (_Float16)a) | ((unsigned)__builtin_bit_cast(unsigned short, (_Float16)b) << 16); }
__device__ __forceinline__ f32x4 unph4(unsigned x, unsigned y) { return (f32x4){(float)__builtin_bit_cast(_Float16, (unsigned short)(x & 0xffffu)), (float)__builtin_bit_cast(_Float16, (unsigned short)(x >> 16)),
                                                                                (float)__builtin_bit_cast(_Float16, (unsigned short)(y & 0xffffu)), (float)__builtin_bit_cast(_Float16, (unsigned short)(y >> 16))}; }
__device__ __forceinline__ f32x4 unpk4(u32x2 p) { return (f32x4){__uint_as_float(p.x << 16), __uint_as_float(p.x & 0xffff0000u), __uint_as_float(p.y << 16), __uint_as_float(p.y & 0xffff0000u)}; }
template <bool SRC_BF16> struct EpiRes {
    static constexpr bool PERM = true;
    const bf16_t* src; bf16_t* dst; const f32x2* st_in; const float* g_in; const float* b_in; f32x2* st_out; LAS f32x2* P; LAS f32x2* S; unsigned char* xb8; float accs; bf16_t* xb;
    __device__ __forceinline__ void operator()(f32x4 (&acc)[2][2][4][2], const pg8::Unit& u, int wr, int wc, int fr, int fq) const {
        asm volatile("" : "+v"(fr), "+v"(fq));
        const int colb = u.pn * 256 + wc * 32 + 8 * fq;
        u32x2 pk[2][2][4][2];
#pragma unroll
        for (int ai = 0; ai < 2; ++ai)
#pragma unroll
            for (int bj = 0; bj < 2; ++bj)
#pragma unroll
                for (int m = 0; m < 4; ++m)
#pragma unroll
                    for (int n = 0; n < 2; ++n) { const f32x4 a = acc[ai][bj][m][n] * accs; pk[ai][bj][m][n] = (u32x2){cvt_pk_bf16(a[0], a[1]), cvt_pk_bf16(a[2], a[3])}; }
        u32x4 xr[2][4][2];
#pragma unroll
        for (int ai = 0; ai < 2; ++ai)
#pragma unroll
            for (int m = 0; m < 4; ++m)
#pragma unroll
                for (int bj = 0; bj < 2; ++bj) xr[ai][m][bj] = *(const u32x4*)(src + (size_t)(u.pm * 256 + ai * 128 + wr * 64 + m * 16 + fr) * DM + colb + bj * 128);
        if (st_in) tile_stats_to_lds(st_in, u.pm * 256, S, (wr * 4 + wc) * 64 + fq * 16 + fr);
        f32x4 gv[2][2], bv[2][2];
#pragma unroll
        for (int bj = 0; bj < 2; ++bj)
#pragma unroll
            for (int n = 0; n < 2; ++n) {
                if (st_in) { gv[bj][n] = *(const f32x4*)(g_in + colb + bj * 128 + n * 4); bv[bj][n] = *(const f32x4*)(b_in + colb + bj * 128 + n * 4); }
                else { gv[bj][n] = (f32x4){1.f, 1.f, 1.f, 1.f}; bv[bj][n] = (f32x4){0.f, 0.f, 0.f, 0.f}; } }
        SBAR();
#pragma unroll
        for (int ai = 0; ai < 2; ++ai) {
#pragma unroll
            for (int m = 0; m < 4; ++m) {
                const int rl = ai * 128 + wr * 64 + m * 16 + fr; const int row = u.pm * 256 + rl;
                float mu = 0.f, rstd = 1.f; if (st_in) { const f32x2 sr = S[rl]; mu = sr.x; rstd = sr.y; }
                float s = 0.f, q = 0.f;
#pragma unroll
                for (int bj = 0; bj < 2; ++bj) {
                    const size_t off = (size_t)row * DM + colb + bj * 128;
                    const u32x4 xw = xr[ai][m][bj];
                    f32x4 x0, x1;
                    if constexpr (!SRC_BF16) { x0 = unph4(xw.x, xw.y); x1 = unph4(xw.z, xw.w); }
                    else { x0 = unpk4((u32x2){xw.x, xw.y}); x1 = unpk4((u32x2){xw.z, xw.w}); }
                    const f32x4 o0 = ((x0 - mu) * rstd * gv[bj][0] + bv[bj][0]) * ALPHA + unpk4(pk[ai][bj][m][0]);
                    const f32x4 o1 = ((x1 - mu) * rstd * gv[bj][1] + bv[bj][1]) * ALPHA + unpk4(pk[ai][bj][m][1]);
                    { u32x4 w; w.x = pkh2(o0[0], o0[1]); w.y = pkh2(o0[2], o0[3]); w.z = pkh2(o1[0], o1[1]); w.w = pkh2(o1[2], o1[3]); *(u32x4*)(dst + off) = w; }
                    if (xb) { u32x4 w; w.x = cvt_pk_bf16(o0[0], o0[1]); w.y = cvt_pk_bf16(o0[2], o0[3]); w.z = cvt_pk_bf16(o1[0], o1[1]); w.w = cvt_pk_bf16(o1[2], o1[3]); *(u32x4*)(xb + off) = w; }
                    if (xb8) { u32x2 w; w.x = cvt4_fp8(o0[0], o0[1], o0[2], o0[3]); w.y = cvt4_fp8(o1[0], o1[1], o1[2], o1[3]); *(u32x2*)(xb8 + off) = w; }
                    s += ((o0[0] + o0[1]) + (o0[2] + o0[3])) + ((o1[0] + o1[1]) + (o1[2] + o1[3]));
                    q += ((o0[0] * o0[0] + o0[1] * o0[1]) + (o0[2] * o0[2] + o0[3] * o0[3])) + ((o1[0] * o1[0] + o1[1] * o1[1]) + (o1[2] * o1[2] + o1[3] * o1[3]));
                }
                s += __shfl_xor(s, 16); s += __shfl_xor(s, 32); q += __shfl_xor(q, 16); q += __shfl_xor(q, 32);
                if (fq == 0) P[rl * 4 + wc] = (f32x2){s, q};
            }
            SBAR();
        }
        EPI_BAR();
        const int tid = (wr * 4 + wc) * 64 + fq * 16 + fr;
        if (tid < 256) {
            const f32x2 a = P[tid * 4 + 0], b = P[tid * 4 + 1], c = P[tid * 4 + 2], d = P[tid * 4 + 3];
            st_out[(size_t)(u.pm * 256 + tid) * 4 + u.pn] = (f32x2){(a.x + b.x) + (c.x + d.x), (a.y + b.y) + (c.y + d.y)};
        }
    }
};

struct EpiGU {
    static constexpr bool PERM = false;
    unsigned char* hmid  ; float* edge; const f32x2* stats; const float* c1; const float* c2; const float* cw; const float* cb; LAS float* halo; LAS f32x2* S;
    __device__ __forceinline__ void operator()(f32x4 (&acc)[2][2][4][2], const pg8::Unit& u, int wr, int wc, int fr, int fq) const {
        asm volatile("" : "+v"(fr), "+v"(fq));
        const int colb = wc * 32 + 4 * fq; const int lane = fq * 16 + fr;
        const int jch0 = u.pn * 128 + colb;
        tile_stats_to_lds(stats, u.pm * 256, S, (wr * 4 + wc) * 64 + lane);
        u32x2 gk[2][4][2], uk[2][4][2];
        {
            f32x4 c1v[2][2], c2v[2][2];
#pragma unroll
            for (int bj = 0; bj < 2; ++bj)
#pragma unroll
                for (int n = 0; n < 2; ++n) { c1v[bj][n] = *(const f32x4*)(c1 + u.pn * 256 + bj * 128 + colb + 16 * n); c2v[bj][n] = *(const f32x4*)(c2 + u.pn * 256 + bj * 128 + colb + 16 * n); }
#pragma unroll
            for (int ai = 0; ai < 2; ++ai)
#pragma unroll
                for (int m = 0; m < 4; ++m) {
                    const f32x2 sr = S[ai * 128 + wr * 64 + m * 16 + fr]; const float mu = sr.x, rstd = sr.y;
                    const int blk = ai * 2 + wr;
#pragma unroll
                    for (int n = 0; n < 2; ++n) {
                        const f32x4 gv = (acc[ai][0][m][n] * (1.0f / 64.0f) - mu * c1v[0][n]) * rstd + c2v[0][n];
                        const f32x4 uv = (acc[ai][1][m][n] * (1.0f / 64.0f) - mu * c1v[1][n]) * rstd + c2v[1][n];
                        gk[ai][m][n].x = cvt_pk_bf16(gv[0], gv[1]); gk[ai][m][n].y = cvt_pk_bf16(gv[2], gv[3]);
                        uk[ai][m][n].x = cvt_pk_bf16(uv[0], uv[1]); uk[ai][m][n].y = cvt_pk_bf16(uv[2], uv[3]);
                        if (m == 0) {
                            if (fr == 0) *(LAS u32x2*)(halo + (blk * 2 + 0) * 128 + (colb + 16 * n) / 2) = gk[ai][m][n];
                            if (ai == 0 && wr == 0 && fr <= 1) *(f32x4*)(edge + ((size_t)u.pm * 6 + fr) * DFF + jch0 + 16 * n) = gv;
                            if (ai == 0 && wr == 0 && fr == 0) *(f32x4*)(edge + ((size_t)u.pm * 6 + 4) * DFF + jch0 + 16 * n) = uv;
                        }
                        if (m == 3) {
                            if (fr == 15) *(LAS u32x2*)(halo + (blk * 2 + 1) * 128 + (colb + 16 * n) / 2) = gk[ai][m][n];
                            if (ai == 1 && wr == 1 && fr >= 14) *(f32x4*)(edge + ((size_t)u.pm * 6 + 2 + (fr - 14)) * DFF + jch0 + 16 * n) = gv;
                            if (ai == 1 && wr == 1 && fr == 15) *(f32x4*)(edge + ((size_t)u.pm * 6 + 5) * DFF + jch0 + 16 * n) = uv;
                        }
                    }
                    SBAR();
                }
        }
        EPI_BAR(); SBAR();
#define BLO(x) __uint_as_float((x) << 16)
#define BHI(x) __uint_as_float((x) & 0xffff0000u)
#pragma unroll
        for (int n = 0; n < 2; ++n) {
            const f32x4 w0 = *(const f32x4*)(cw + jch0 + 16 * n), w1 = *(const f32x4*)(cw + DFF + jch0 + 16 * n), w2 = *(const f32x4*)(cw + 2 * DFF + jch0 + 16 * n), cbv = *(const f32x4*)(cb + jch0 + 16 * n);
#pragma unroll
            for (int ai = 0; ai < 2; ++ai) {
                const int blk = ai * 2 + wr;
                u32x2 top = (u32x2){0u, 0u}, bot = (u32x2){0u, 0u};
                if (blk > 0) top = *(const LAS u32x2*)(halo + ((blk - 1) * 2 + 1) * 128 + (colb + 16 * n) / 2);
                if (blk < 3) bot = *(const LAS u32x2*)(halo + ((blk + 1) * 2 + 0) * 128 + (colb + 16 * n) / 2);
                u32x2 hk[4];
#pragma unroll
                for (int w = 0; w < 2; ++w) {
                    unsigned a_[4], c_[4];
#pragma unroll
                    for (int m = 0; m < 4; ++m) { const unsigned gv = gk[ai][m][n][w];
                        a_[m] = (unsigned)__builtin_amdgcn_update_dpp(0, (int)gv, 0x121, 0xf, 0xf, false);
                        c_[m] = (unsigned)__builtin_amdgcn_update_dpp(0, (int)gv, 0x12f, 0xf, 0xf, false); }
                    const f32x2 cb2 = (f32x2){cbv[2 * w], cbv[2 * w + 1]}, w02 = (f32x2){w0[2 * w], w0[2 * w + 1]}, w12 = (f32x2){w1[2 * w], w1[2 * w + 1]}, w22 = (f32x2){w2[2 * w], w2[2 * w + 1]};
#pragma unroll
                    for (int m = 0; m < 4; ++m) {
                        const unsigned prev = (fr > 0) ? a_[m] : (m > 0 ? a_[m > 0 ? m - 1 : 0] : top[w]);
                        const unsigned next = (fr < 15) ? c_[m] : (m < 3 ? c_[m < 3 ? m + 1 : 3] : bot[w]);
                        const unsigned cur = gk[ai][m][n][w], upw = uk[ai][m][n][w];
                        const f32x2 cv = cb2 + w02 * (f32x2){BLO(prev), BHI(prev)} + w12 * (f32x2){BLO(cur), BHI(cur)} + w22 * (f32x2){BLO(next), BHI(next)};
                        const f32x2 hv2 = gelu_pk(cv) * (f32x2){BLO(upw), BHI(upw)};
                        hk[m][w] = cvt_pk_bf16(hv2.x, hv2.y);
                    }
                    SBAR();
                }
#pragma unroll
                for (int m = 0; m < 4; ++m) {
                    const int rl = ai * 128 + wr * 64 + m * 16 + fr;
                    if (rl != 0 && rl != 255) *(unsigned*)(hmid + (size_t)(u.pm * 256 + rl) * DFF + jch0 + 16 * n) = cvt4_fp8(BLO(hk[m].x) * 16.f, BHI(hk[m].x) * 16.f, BLO(hk[m].y) * 16.f, BHI(hk[m].y) * 16.f);
                }
                SBAR();
            }
        }
#undef BLO
#undef BHI
    }
};

namespace att {
constexpr int KVBLK = 64, SHM_V = 16384, SHM_K = 16384, WS_OFF = 73728, OB_PITCH = 132;
#define KSWZ(row, colB) ((row) * 256 + ((colB) ^ (((row) & 7) << 4)))
__device__ __forceinline__ void alibi(f32x16& p0, f32x16& p1, float t0, float nslope) {
#pragma unroll
    for (int r = 0; r < 16; ++r) { const float kr = (float)((r & 3) + 8 * (r >> 2));
        p0[r] = fmaf(nslope, fabsf(t0 - kr), p0[r]); p1[r] = fmaf(nslope, fabsf(t0 - kr - 32.f), p1[r]); }
}
__device__ __forceinline__ void partialSM(f32x16& p0, f32x16& p1, float mC) {
    constexpr float C = 1.4426950408889634f;
#pragma unroll
    for (int r = 0; r < 16; ++r) p0[r] = fmaf(p0[r], C, mC);
#pragma unroll
    for (int r = 0; r < 16; ++r) p1[r] = fmaf(p1[r], C, mC);
#pragma unroll
    for (int r = 0; r < 16; ++r) p0[r] = __builtin_amdgcn_exp2f(p0[r]);
}
__device__ __forceinline__ void finishSM(f32x16& p0, f32x16& p1, float& l_reg, bf16x8& pa0, bf16x8& pa1, bf16x8& pa2, bf16x8& pa3) {
#pragma unroll
    for (int r = 0; r < 16; ++r) p1[r] = __builtin_amdgcn_exp2f(p1[r]);
    float ps = 0;
#pragma unroll
    for (int r = 0; r < 16; ++r) ps += p0[r];
#pragma unroll
    for (int r = 0; r < 16; ++r) ps += p1[r];
    { auto rr = __builtin_amdgcn_permlane32_swap(__float_as_uint(ps), __float_as_uint(ps), false, false);
      ps = __uint_as_float(rr[0]) + __uint_as_float(rr[1]); }
    l_reg += ps;
#define PK4(P, BASE, OUT) do { unsigned a0 = cvt_pk_bf16(P[BASE + 0], P[BASE + 1]), a1 = cvt_pk_bf16(P[BASE + 2], P[BASE + 3]);   \
    unsigned b0 = cvt_pk_bf16(P[BASE + 4], P[BASE + 5]), b1 = cvt_pk_bf16(P[BASE + 6], P[BASE + 7]);                              \
    auto r0 = __builtin_amdgcn_permlane32_swap(a0, b0, false, false); auto r1 = __builtin_amdgcn_permlane32_swap(a1, b1, false, false); \
    u32x4 w = {r0[0], r1[0], r0[1], r1[1]}; OUT = *reinterpret_cast<bf16x8*>(&w); } while (0)
    PK4(p0, 0, pa0); PK4(p0, 8, pa1); PK4(p1, 0, pa2); PK4(p1, 8, pa3);
#undef PK4
}
__device__ __forceinline__ void qkt(f32x16& p0, f32x16& p1, const LAS char* Ks, const bf16x8* qr, int r32, int hi, int c) {
    p0 = f32x16{}; p1 = f32x16{};
#pragma unroll
    for (int d0 = 0; d0 < 4; ++d0) { const int cb = ((c * 4 + d0) * 16 + hi * 8) * 2;
        const bf16x8 b0 = *reinterpret_cast<const LAS bf16x8*>(Ks + KSWZ(r32, cb));
        const bf16x8 b1 = *reinterpret_cast<const LAS bf16x8*>(Ks + KSWZ(32 + r32, cb));
        p0 = __builtin_amdgcn_mfma_f32_32x32x16_bf16(b0, qr[d0], p0, 0, 0, 0);
        p1 = __builtin_amdgcn_mfma_f32_32x32x16_bf16(b1, qr[d0], p1, 0, 0, 0); }
}
__device__ __forceinline__ int v_st(int k, int c) { const int kk = (k & ~0xC) | ((k & 4) << 1) | ((k & 8) >> 1); return ((kk >> 3) * 4 + (c >> 5)) * 512 + ((kk & 7) * 32 + (c & 31)) * 2; }
__device__ __forceinline__ int v_rd_base(int lane) { return ((lane & 3) << 3) | (((lane >> 2) & 3) << 6) | (((lane >> 4) & 1) << 5) | (((lane >> 5) & 1) << 8); }
constexpr int v_rd_off(int d0, int ks, int half) { return d0 * 512 + ks * 4096 + half * 2048; }
template <int OFF> __device__ __forceinline__ s16x4 tr_read(int vb) {
    s16x4 r; asm volatile("ds_read_b64_tr_b16 %0, %1 offset:%2" : "=&v"(r) : "v"(vb), "i"(OFF) : "memory"); return r;
}
template <int D0> __device__ __forceinline__ void pv_one(f32x16& od, int vb, bf16x8 pa0, bf16x8 pa1, bf16x8 pa2, bf16x8 pa3) {
    const s16x4 l0 = tr_read<v_rd_off(D0, 0, 0)>(vb), h0 = tr_read<v_rd_off(D0, 0, 1)>(vb), l1 = tr_read<v_rd_off(D0, 1, 0)>(vb), h1 = tr_read<v_rd_off(D0, 1, 1)>(vb);
    const s16x4 l2 = tr_read<v_rd_off(D0, 2, 0)>(vb), h2 = tr_read<v_rd_off(D0, 2, 1)>(vb), l3 = tr_read<v_rd_off(D0, 3, 0)>(vb), h3 = tr_read<v_rd_off(D0, 3, 1)>(vb);
    asm volatile("s_waitcnt lgkmcnt(0)" ::: "memory"); SBAR();
#define PK(L, H) (bf16x8){L[0], L[1], L[2], L[3], H[0], H[1], H[2], H[3]}
    od = __builtin_amdgcn_mfma_f32_32x32x16_bf16(pa0, PK(l0, h0), od, 0, 0, 0);
    od = __builtin_amdgcn_mfma_f32_32x32x16_bf16(pa1, PK(l1, h1), od, 0, 0, 0);
    od = __builtin_amdgcn_mfma_f32_32x32x16_bf16(pa2, PK(l2, h2), od, 0, 0, 0);
    od = __builtin_amdgcn_mfma_f32_32x32x16_bf16(pa3, PK(l3, h3), od, 0, 0, 0);
#undef PK
}
__device__ __forceinline__ void pv_d0(f32x16* o, int vb, bf16x8 pa0, bf16x8 pa1, bf16x8 pa2, bf16x8 pa3) {
    pv_one<0>(o[0], vb, pa0, pa1, pa2, pa3); pv_one<1>(o[1], vb, pa0, pa1, pa2, pa3); pv_one<2>(o[2], vb, pa0, pa1, pa2, pa3); pv_one<3>(o[3], vb, pa0, pa1, pa2, pa3);
}

__device__ __forceinline__ void attn_unit(const bf16_t* __restrict__ proj, bf16_t* __restrict__ mixed, const float* __restrict__ att_g,
                                          int seq, long row0, int h, int qb, float lam, float nslope, float oscale, float kmax2, LAS char* lds) {
    const int tid = opaque_tid(), wid = tid >> 6, lane = tid & 63, r32 = lane & 31, hi = lane >> 5, c = wid >> 2, wq = wid & 3;
    LAS char* V_lds = lds; LAS char* K_lds = lds + 2 * SHM_V;
    LAS float* ws = (LAS float*)(lds + WS_OFF) + wid * 64; LAS float* li_l = ws;
    float l_reg = 0; f32x16 o[4] = {}; bf16x8 qr[4];
    const int qrow = qb * 128 + wq * 32 + r32;
    const bf16_t* Qw = proj + (size_t)(row0 + qrow) * NPROJ + h * 128 + c * 64 + hi * 8;
#pragma unroll
    for (int d0 = 0; d0 < 4; ++d0) qr[d0] = *reinterpret_cast<const bf16x8*>(Qw + d0 * 16);
    int tlo, NT; float mC;
    {
        const bf16_t* Kd = proj + (size_t)(row0 + qrow) * NPROJ + 512 + h * 128 + c * 64 + hi * 8;
        float qs = 0.f, sd = 0.f;
#pragma unroll
        for (int d0 = 0; d0 < 4; ++d0) { const bf16x8 kd = *reinterpret_cast<const bf16x8*>(Kd + d0 * 16);
#pragma unroll
            for (int e = 0; e < 8; ++e) { const float qv = bf2f((bf16_t)qr[d0][e]); qs += qv * qv; sd += qv * bf2f((bf16_t)kd[e]); } }
        qs += __shfl_xor(qs, 32); sd += __shfl_xor(sd, 32);
        const float sb = sqrtf(qs * kmax2) * 1.01f + 1e-3f;
        mC = -fminf(sb, 60.0f) * 1.4426950408889634f;
        float tb = sb - sd;
#pragma unroll
        for (int o = 1; o < 32; o <<= 1) tb = fmaxf(tb, __shfl_xor(tb, o));
        if (lane == 0) ws[0] = tb;
        __syncthreads();
        float tm = 0.f;
#pragma unroll
        for (int w = 0; w < 8; ++w) tm = fmaxf(tm, ((LAS float*)(lds + WS_OFF))[w * 64]);
        const float dstar = (30.0f + tm) / (-nslope);
        const int ntall = seq / KVBLK;
        int lo = (int)floorf(((float)(qb * 128) - dstar) * (1.0f / 64.0f)), hi_t = (int)floorf(((float)(qb * 128 + 127) + dstar) * (1.0f / 64.0f));
        lo = lo < 0 ? 0 : lo; hi_t = hi_t > ntall - 1 ? ntall - 1 : hi_t;
        if (((hi_t - lo + 1) & 1) != 0) { if (hi_t < ntall - 1) ++hi_t; else --lo; }
        tlo = lo; NT = hi_t - lo + 1;
    }
    const bf16_t* Kh = proj + (size_t)(row0 + tlo * KVBLK) * NPROJ + 512 + h * 128; const bf16_t* Vh = proj + (size_t)(row0 + tlo * KVBLK) * NPROJ + 1024 + h * 128;
    const int sr = tid >> 4, sc = (tid & 15) * 8, vst0 = v_st(sr, sc), vst1 = v_st(32 + sr, sc);
    const int vb0 = (int)(uintptr_t)V_lds + v_rd_base(lane);
    const float qposf = (float)(qrow - 4 * hi - tlo * KVBLK);
    struct { bf16x8 vs0, vs1, ks0, ks1; } sr_[2];
#define SLOAD(i, k0) do { sr_[i].vs0 = *reinterpret_cast<const bf16x8*>(&Vh[(size_t)((k0) + sr) * NPROJ + sc]); sr_[i].vs1 = *reinterpret_cast<const bf16x8*>(&Vh[(size_t)((k0) + 32 + sr) * NPROJ + sc]); \
    sr_[i].ks0 = *reinterpret_cast<const bf16x8*>(&Kh[(size_t)((k0) + sr) * NPROJ + sc]); sr_[i].ks1 = *reinterpret_cast<const bf16x8*>(&Kh[(size_t)((k0) + 32 + sr) * NPROJ + sc]); } while (0)
#define SWRITE(b, i) do { *(LAS bf16x8*)(V_lds + (b) * SHM_V + vst0) = sr_[i].vs0;          \
    *(LAS bf16x8*)(V_lds + (b) * SHM_V + vst1) = sr_[i].vs1; const int kc = sc * 2;               \
    *(LAS bf16x8*)(K_lds + (b) * SHM_K + KSWZ(sr, kc)) = sr_[i].ks0;                       \
    *(LAS bf16x8*)(K_lds + (b) * SHM_K + KSWZ(32 + sr, kc)) = sr_[i].ks1; } while (0)
#define SWAIT() asm volatile("s_waitcnt vmcnt(4)" ::: "memory")
    f32x16 pA0, pA1, pB0, pB1; bf16x8 pa0, pa1, pa2, pa3;
    constexpr int SE = 0, SO = 1;
    SLOAD(SE, 0); asm volatile("s_waitcnt vmcnt(0)" ::: "memory"); SWRITE(0, SE); __syncthreads();
    qkt(pA0, pA1, K_lds, qr, r32, hi, c); alibi(pA0, pA1, qposf, nslope); partialSM(pA0, pA1, mC);
    SLOAD(SO, KVBLK); if (2 < NT) SLOAD(SE, 2 * KVBLK);
    SWAIT(); SWRITE(1, SO); __syncthreads();
    for (int j = 1; j + 1 < NT; j += 2) {
        SBAR(); qkt(pB0, pB1, K_lds + SHM_K, qr, r32, hi, c);
        finishSM(pA0, pA1, l_reg, pa0, pa1, pa2, pa3); SBAR();
        SLOAD(SO, (j + 2) * KVBLK); SBAR();
        pv_d0(o, vb0, pa0, pa1, pa2, pa3); alibi(pB0, pB1, qposf - (float)(j * KVBLK), nslope); partialSM(pB0, pB1, mC);
        __syncthreads(); SWAIT(); SWRITE(0, SE);
        __syncthreads();
        SBAR(); qkt(pA0, pA1, K_lds, qr, r32, hi, c);
        finishSM(pB0, pB1, l_reg, pa0, pa1, pa2, pa3); SBAR();
        if (j + 3 < NT) SLOAD(SE, (j + 3) * KVBLK); SBAR();
        pv_d0(o, vb0 + SHM_V, pa0, pa1, pa2, pa3); alibi(pA0, pA1, qposf - (float)((j + 1) * KVBLK), nslope); partialSM(pA0, pA1, mC);
        __syncthreads(); SWAIT(); SWRITE(1, SO);
        __syncthreads();
    }
    SBAR(); qkt(pB0, pB1, K_lds + SHM_K, qr, r32, hi, c);
    finishSM(pA0, pA1, l_reg, pa0, pa1, pa2, pa3); SBAR();
    pv_d0(o, vb0, pa0, pa1, pa2, pa3); alibi(pB0, pB1, qposf - (float)((NT - 1) * KVBLK), nslope); partialSM(pB0, pB1, mC);
    __syncthreads();
    finishSM(pB0, pB1, l_reg, pa0, pa1, pa2, pa3); SBAR();
    pv_d0(o, vb0 + SHM_V, pa0, pa1, pa2, pa3);
    if (hi == 0) li_l[r32] = l_reg; asm volatile("s_waitcnt lgkmcnt(0)" ::: "memory");
    float rli[16];
#pragma unroll
    for (int r = 0; r < 16; ++r) rli[r] = __builtin_amdgcn_rcpf(li_l[crow(r, hi)]);
    __syncthreads();
    LAS float* OB = (LAS float*)lds;
    if (c == 1) {
#pragma unroll
        for (int r = 0; r < 16; ++r) { const int orow = wq * 32 + crow(r, hi);
#pragma unroll
            for (int d0 = 0; d0 < 4; ++d0) OB[orow * OB_PITCH + d0 * 32 + r32] = o[d0][r] * rli[r]; }
    }
    __syncthreads();
    if (c == 0) {
        float gcol[4];
#pragma unroll
        for (int d0 = 0; d0 < 4; ++d0) gcol[d0] = att_g[h * 128 + d0 * 32 + r32] * oscale;
#pragma unroll
        for (int r = 0; r < 16; ++r) { const int orow = wq * 32 + crow(r, hi);
            float dv[4]; float ss = 0.f;
#pragma unroll
            for (int d0 = 0; d0 < 4; ++d0) { dv[d0] = o[d0][r] * rli[r] - lam * OB[orow * OB_PITCH + d0 * 32 + r32]; ss += dv[d0] * dv[d0]; }
            ss += __shfl_xor(ss, 1); ss += __shfl_xor(ss, 2); ss += __shfl_xor(ss, 4); ss += __shfl_xor(ss, 8); ss += __shfl_xor(ss, 16);
            const float rs = rsqrtf(ss * (1.f / 128.f) + EPS);
            bf16_t* orp = mixed + (size_t)(row0 + qb * 128 + orow) * DM + h * 128 + r32;
#pragma unroll
            for (int d0 = 0; d0 < 4; ++d0) orp[d0 * 32] = f2bf(dv[d0] * rs * gcol[d0]); }
    }
    __syncthreads();
#undef SLOAD
#undef SWRITE
#undef SWAIT
}
}

namespace ml {
constexpr int QP = 192, VP = 320, SP = 272, CP = 320;
constexpr int OFF_Q = 0, OFF_K = 24576, OFF_KE = 49152, OFF_V = 73728, OFF_C = 114688, OFF_VEC = 135168;
constexpr int V_U = 0, V_MX = 128, V_EINT = 256, V_EEND = 384, V_EMO = 512, V_QN = 640, V_RS = 768, V_GI = 896, V_GF = 1024, V_NST = 1152, V_NPART = 1216, V_SCAL = 1728;
constexpr int HS_PITCH = 132;
__device__ __forceinline__ s16x4 trr(unsigned addr) { s16x4 r; asm volatile("ds_read_b64_tr_b16 %0, %1" : "=&v"(r) : "v"(addr) : "memory"); return r; }
#define TRWAIT4(a, b, c, d) asm volatile("s_waitcnt lgkmcnt(0)" : "+v"(a), "+v"(b), "+v"(c), "+v"(d) :: "memory")
#define TRWAIT8(a, b, c, d, e, f, g, h) asm volatile("s_waitcnt lgkmcnt(0)" : "+v"(a), "+v"(b), "+v"(c), "+v"(d), "+v"(e), "+v"(f), "+v"(g), "+v"(h) :: "memory")
#define CAT(L, H) (bf16x8){L[0], L[1], L[2], L[3], H[0], H[1], H[2], H[3]}
__device__ __forceinline__ float logsig(float x) { return fminf(x, 0.f) - __logf(1.0f + __expf(-fabsf(x))); }

__device__ __forceinline__ void mlstm_dir(const bf16_t* __restrict__ proj, const float* __restrict__ gates, bf16_t* __restrict__ hdir,
                                          int seq, long row0, int h, int dir, LAS unsigned char* lds) {
    const int tid0 = opaque_tid();
    LAS float* vec = (LAS float*)(lds + OFF_VEC);
    const unsigned lbase = (unsigned)(uintptr_t)lds;
    const int nc = seq / 128;
    constexpr float L2E = 1.4426950408889634f;
    f32x16 Cst = {};
    if (tid0 < 64) vec[V_NST + tid0] = 0.f;
    float m_state = 0.f;
    bf16x8 pq[2], pk[2], pv[4]; float pgi = 0.f, pgf = 0.f;
#define POSB(cb_, j) ((cb_) + (dir ? 127 - (j) : (j)))
#define PREFETCH(cidx) do { const long cb_ = row0 + (long)(cidx) * 128; \
        _Pragma("unroll") for (int i = 0; i < 2; ++i) { const int chunk = tid0 + 512 * i, j = chunk >> 3, c8 = chunk & 7; const bf16_t* src = proj + (size_t)POSB(cb_, j) * NPROJ + h * 64 + c8 * 8; \
            pq[i] = *(const bf16x8*)(src + 1536); pk[i] = *(const bf16x8*)(src + 1792); } \
        _Pragma("unroll") for (int i = 0; i < 4; ++i) { const int chunk = tid0 + 512 * i, j = chunk >> 4, c16 = chunk & 15; \
            pv[i] = *(const bf16x8*)(proj + (size_t)POSB(cb_, j) * NPROJ + 2048 + h * 128 + c16 * 8); } \
        if (tid0 < 128) { const float* gp = gates + (size_t)POSB(cb_, tid0) * 16; pgi = gp[(dir ? 8 : 0) + h]; pgf = gp[(dir ? 12 : 4) + h]; } } while (0)
    PREFETCH(dir ? nc - 1 : 0);
    __syncthreads();
    for (int cc = 0; cc < nc; ++cc) {
        int tid = tid0; asm volatile("" : "+v"(tid));
        const int wid = tid >> 6, lane = tid & 63, r = lane & 31, hh = lane >> 5, i16 = lane & 15, q4 = i16 >> 2, p4 = i16 & 3, blk = (lane >> 4) & 1;
        const int rb = wid >> 1, ch = wid & 1, db = wid >> 2, eb = wid & 3;
        const int c = dir ? nc - 1 - cc : cc;
        const long cbase = row0 + (long)c * 128;
#pragma unroll
        for (int i = 0; i < 2; ++i) { const int chunk = tid + 512 * i, j = chunk >> 3, c8 = chunk & 7;
            *(LAS bf16x8*)(lds + OFF_Q + j * QP + c8 * 16) = pq[i]; *(LAS bf16x8*)(lds + OFF_K + j * QP + c8 * 16) = pk[i]; }
#pragma unroll
        for (int i = 0; i < 4; ++i) { const int chunk = tid + 512 * i, j = chunk >> 4, c16 = chunk & 15; *(LAS bf16x8*)(lds + OFF_V + j * VP + c16 * 16) = pv[i]; }
        if (tid < 128) { vec[V_GI + tid] = pgi; vec[V_GF + tid] = pgf; }
#pragma unroll
        for (int i = 0; i < 16; ++i) *(LAS bf16_t*)(lds + OFF_C + (32 * db + crow(i, hh)) * CP + (32 * eb + r) * 2) = f2bf(Cst[i]);
        __syncthreads();
        if (cc + 1 < nc) PREFETCH(dir ? nc - 2 - cc : cc + 1);
        if (wid == 0) {
            const float gf0 = vec[V_GF + 2 * lane], gf1 = vec[V_GF + 2 * lane + 1], gi0 = vec[V_GI + 2 * lane], gi1 = vec[V_GI + 2 * lane + 1];
            const float lf0 = logsig(gf0), lf1 = logsig(gf1);
            float incl = lf0 + lf1;
#pragma unroll
            for (int d = 1; d < 64; d <<= 1) { const float t = __shfl_up(incl, d); if (lane >= d) incl += t; }
            const float b1 = incl, b0 = incl - lf1, g = __shfl(incl, 63);
            const float u0 = gi0 - b0, u1 = gi1 - b1;
            float cm = fmaxf(u0, u1);
#pragma unroll
            for (int d = 1; d < 64; d <<= 1) { const float t = __shfl_up(cm, d); if (lane >= d) cm = fmaxf(cm, t); }
            float excl = __shfl_up(cm, 1); if (lane == 0) excl = -INFINITY;
            const float cmx0 = fmaxf(excl, u0), cmx1 = cm, umax = __shfl(cm, 63);
            const float mp = m_state, mx0 = fmaxf(mp, cmx0), mx1 = fmaxf(mp, cmx1);
            vec[V_U + 2 * lane] = u0; vec[V_U + 2 * lane + 1] = u1; vec[V_MX + 2 * lane] = mx0; vec[V_MX + 2 * lane + 1] = mx1;
            vec[V_EINT + 2 * lane] = __expf(mp - mx0); vec[V_EINT + 2 * lane + 1] = __expf(mp - mx1);
            vec[V_EEND + 2 * lane] = __expf(u0 - umax); vec[V_EEND + 2 * lane + 1] = __expf(u1 - umax);
            vec[V_EMO + 2 * lane] = __expf(-(b0 + mx0)); vec[V_EMO + 2 * lane + 1] = __expf(-(b1 + mx1));
            const float m_loc = g + umax, m_new = fmaxf(g + mp, m_loc);
            if (lane == 0) { vec[V_SCAL] = __expf(g + mp - m_new); vec[V_SCAL + 1] = __expf(m_loc - m_new); }
            m_state = m_new;
        }
        bf16x8 qa[4];
#pragma unroll
        for (int ks = 0; ks < 4; ++ks) qa[ks] = *(const LAS bf16x8*)(lds + OFF_Q + (32 * rb + r) * QP + (16 * ks + 8 * hh) * 2);
        f32x16 Sv[2] = {}, Ov[2] = {};
#pragma unroll
        for (int t = 0; t < 2; ++t) {
            if (2 * ch + t <= rb) {
#pragma unroll
                for (int ks = 0; ks < 4; ++ks) { const bf16x8 kb = *(const LAS bf16x8*)(lds + OFF_K + (64 * ch + 32 * t + r) * QP + (16 * ks + 8 * hh) * 2);
                    Sv[t] = __builtin_amdgcn_mfma_f32_32x32x16_bf16(qa[ks], kb, Sv[t], 0, 0, 0); } }
        }
#pragma unroll
        for (int t = 0; t < 2; ++t) {
            const unsigned a0 = lbase + OFF_C + (8 * hh + q4) * CP + (64 * ch + 32 * t + 16 * blk + 4 * p4) * 2;
            s16x4 l0 = trr(a0), h0 = trr(a0 + 4 * CP), l1 = trr(a0 + 16 * CP), h1 = trr(a0 + 20 * CP), l2 = trr(a0 + 32 * CP), h2 = trr(a0 + 36 * CP), l3 = trr(a0 + 48 * CP), h3 = trr(a0 + 52 * CP);
            TRWAIT8(l0, h0, l1, h1, l2, h2, l3, h3);
            Ov[t] = __builtin_amdgcn_mfma_f32_32x32x16_bf16(qa[0], CAT(l0, h0), Ov[t], 0, 0, 0);
            Ov[t] = __builtin_amdgcn_mfma_f32_32x32x16_bf16(qa[1], CAT(l1, h1), Ov[t], 0, 0, 0);
            Ov[t] = __builtin_amdgcn_mfma_f32_32x32x16_bf16(qa[2], CAT(l2, h2), Ov[t], 0, 0, 0);
            Ov[t] = __builtin_amdgcn_mfma_f32_32x32x16_bf16(qa[3], CAT(l3, h3), Ov[t], 0, 0, 0);
        }
        { const int j = tid >> 2, part = tid & 3; float s = 0.f;
#pragma unroll
          for (int k2 = 0; k2 < 2; ++k2) { const bf16x8 qv = *(const LAS bf16x8*)(lds + OFF_Q + j * QP + (16 * part + 8 * k2) * 2);
#pragma unroll
              for (int e = 0; e < 8; ++e) s += bf2f((bf16_t)qv[e]) * vec[V_NST + 16 * part + 8 * k2 + e]; }
          s += __shfl_xor(s, 1); s += __shfl_xor(s, 2); if (part == 0) vec[V_QN + j] = s; }
        __syncthreads();
#pragma unroll
        for (int i = 0; i < 2; ++i) { const int chunk = tid + 512 * i, j = chunk >> 3, c8 = chunk & 7; const float ee = vec[V_EEND + j];
            const bf16x8 kv = *(const LAS bf16x8*)(lds + OFF_K + j * QP + c8 * 16); u32x4 w;
            w.x = cvt_pk_bf16(bf2f((bf16_t)kv[0]) * ee, bf2f((bf16_t)kv[1]) * ee); w.y = cvt_pk_bf16(bf2f((bf16_t)kv[2]) * ee, bf2f((bf16_t)kv[3]) * ee);
            w.z = cvt_pk_bf16(bf2f((bf16_t)kv[4]) * ee, bf2f((bf16_t)kv[5]) * ee); w.w = cvt_pk_bf16(bf2f((bf16_t)kv[6]) * ee, bf2f((bf16_t)kv[7]) * ee);
            *(LAS u32x4*)(lds + OFF_KE + j * QP + c8 * 16) = w; }
        {
            const float us0 = vec[V_U + 64 * ch + r] * L2E, us1 = vec[V_U + 64 * ch + 32 + r] * L2E;
#pragma unroll
            for (int i = 0; i < 16; ++i) { const int j = 32 * rb + crow(i, hh); const float mxj = vec[V_MX + j] * L2E, ei = vec[V_EINT + j];
                const int s0 = 64 * ch + r, s1 = s0 + 32;
                Sv[0][i] = (s0 <= j) ? Sv[0][i] * __builtin_amdgcn_exp2f(us0 - mxj) : 0.f;
                Sv[1][i] = (s1 <= j) ? Sv[1][i] * __builtin_amdgcn_exp2f(us1 - mxj) : 0.f;
                Ov[0][i] *= ei; Ov[1][i] *= ei; }
        }
        __syncthreads();
#pragma unroll
        for (int t = 0; t < 2; ++t)
#pragma unroll
            for (int i = 0; i < 16; ++i) *(LAS bf16_t*)(lds + OFF_Q + (32 * rb + crow(i, hh)) * SP + (64 * ch + 32 * t + r) * 2) = f2bf(Sv[t][i]);
        __syncthreads();
#pragma unroll 1
        for (int kp = 0; kp <= rb; ++kp) {
            const bf16x8 a0v = *(const LAS bf16x8*)(lds + OFF_Q + (32 * rb + r) * SP + (32 * kp + 8 * hh) * 2), a1v = *(const LAS bf16x8*)(lds + OFF_Q + (32 * rb + r) * SP + (32 * kp + 16 + 8 * hh) * 2);
            const unsigned a0 = lbase + OFF_V + (32 * kp + 8 * hh + q4) * VP + (64 * ch + 16 * blk + 4 * p4) * 2;
            s16x4 l0 = trr(a0), h0 = trr(a0 + 4 * VP), l1 = trr(a0 + 64), h1 = trr(a0 + 4 * VP + 64);
            s16x4 l2 = trr(a0 + 16 * VP), h2 = trr(a0 + 20 * VP), l3 = trr(a0 + 16 * VP + 64), h3 = trr(a0 + 20 * VP + 64);
            TRWAIT8(l0, h0, l1, h1, l2, h2, l3, h3);
            Ov[0] = __builtin_amdgcn_mfma_f32_32x32x16_bf16(a0v, CAT(l0, h0), Ov[0], 0, 0, 0);
            Ov[1] = __builtin_amdgcn_mfma_f32_32x32x16_bf16(a0v, CAT(l1, h1), Ov[1], 0, 0, 0);
            Ov[0] = __builtin_amdgcn_mfma_f32_32x32x16_bf16(a1v, CAT(l2, h2), Ov[0], 0, 0, 0);
            Ov[1] = __builtin_amdgcn_mfma_f32_32x32x16_bf16(a1v, CAT(l3, h3), Ov[1], 0, 0, 0);
        }
        { const int j = tid >> 2, part = tid & 3; float s = 0.f;
#pragma unroll
          for (int k4 = 0; k4 < 4; ++k4) { const bf16x8 sv = *(const LAS bf16x8*)(lds + OFF_Q + j * SP + (32 * part + 8 * k4) * 2);
#pragma unroll
              for (int e = 0; e < 8; ++e) s += bf2f((bf16_t)sv[e]); }
          s += __shfl_xor(s, 1); s += __shfl_xor(s, 2); if (part == 0) vec[V_RS + j] = s; }
        f32x16 Cl = {};
#pragma unroll 1
        for (int kp = 0; kp < 4; ++kp) {
            const unsigned aa = lbase + OFF_KE + (32 * kp + 8 * hh + q4) * QP + (32 * db + 16 * blk + 4 * p4) * 2;
            const unsigned ab = lbase + OFF_V + (32 * kp + 8 * hh + q4) * VP + (32 * eb + 16 * blk + 4 * p4) * 2;
            s16x4 la = trr(aa), ha = trr(aa + 4 * QP), lb = trr(ab), hb = trr(ab + 4 * VP), la2 = trr(aa + 16 * QP), ha2 = trr(aa + 20 * QP), lb2 = trr(ab + 16 * VP), hb2 = trr(ab + 20 * VP);
            TRWAIT8(la, ha, lb, hb, la2, ha2, lb2, hb2);
            Cl = __builtin_amdgcn_mfma_f32_32x32x16_bf16(CAT(la, ha), CAT(lb, hb), Cl, 0, 0, 0);
            Cl = __builtin_amdgcn_mfma_f32_32x32x16_bf16(CAT(la2, ha2), CAT(lb2, hb2), Cl, 0, 0, 0);
        }
        const float sa = vec[V_SCAL], sb = vec[V_SCAL + 1];
#pragma unroll
        for (int i = 0; i < 16; ++i) Cst[i] = sa * Cst[i] + sb * Cl[i];
        { const int d = tid & 63, part = tid >> 6; float s = 0.f;
#pragma unroll
          for (int k = 0; k < 16; ++k) s += bf2f(*(const LAS bf16_t*)(lds + OFF_KE + (16 * part + k) * QP + d * 2));
          vec[V_NPART + part * 64 + d] = s; }
        __syncthreads();
        if (tid < 64) { float nl = 0.f;
#pragma unroll
            for (int p = 0; p < 8; ++p) nl += vec[V_NPART + p * 64 + tid];
            vec[V_NST + tid] = sa * vec[V_NST + tid] + sb * nl; }
#pragma unroll
        for (int i = 0; i < 16; ++i) { const int j = 32 * rb + crow(i, hh);
            const float den = vec[V_EINT + j] * vec[V_QN + j] + vec[V_RS + j];
            const float scl = 1.0f / fmaxf(fabsf(den), vec[V_EMO + j]);
            *(unsigned*)(hdir + (size_t)POSB(cbase, j) * 512 + h * 128 + ch * 64 + r * 2) = cvt_pk_bf16(Ov[0][i] * scl, Ov[1][i] * scl); }
        __syncthreads();
    }
#undef POSB
#undef PREFETCH
}

__device__ __forceinline__ void mlstm_combine(const bf16_t* __restrict__ proj, const bf16_t* hf, const bf16_t* hb, bf16_t* __restrict__ mixed, const float* __restrict__ lstm_g, int seq, long row0, int h) {
    const int tid = opaque_tid(), part = tid & 3, base0 = 64 * (part >> 1) + 16 * (part & 1);
    const float* gp = lstm_g + h * 128 + base0;
    for (int r0 = 0; r0 < seq; r0 += 128) {
        const size_t row = (size_t)(row0 + r0 + (tid >> 2));
        const bf16_t* fp = hf + row * 512 + h * 128 + 32 * part; const bf16_t* bp = hb + row * 512 + h * 128 + 32 * part;
        const bf16_t* lop = proj + row * NPROJ + 2560 + h * 128 + base0; bf16_t* op = mixed + row * DM + 512 + h * 128 + base0;
        float hs[32]; float ss = 0.f;
#pragma unroll
        for (int k = 0; k < 4; ++k) { const bf16x8 a = *(const bf16x8*)(fp + 8 * k), b = *(const bf16x8*)(bp + 8 * k);
#pragma unroll
            for (int e = 0; e < 8; ++e) { const float x = bf2f((bf16_t)a[e]) + bf2f((bf16_t)b[e]); hs[8 * k + e] = x; ss += x * x; } }
        ss += __shfl_xor(ss, 1); ss += __shfl_xor(ss, 2);
        const float rs = rsqrtf(ss * (1.f / 128.f) + EPS);
#pragma unroll
        for (int t = 0; t < 2; ++t)
#pragma unroll
            for (int k = 0; k < 2; ++k) { const bf16x8 lo8 = *(const bf16x8*)(lop + 32 * t + 8 * k); float ov[8];
#pragma unroll
                for (int e = 0; e < 8; ++e) { const float lg = bf2f((bf16_t)lo8[e]); const float sg = 1.0f / (1.0f + __expf(-lg)); ov[e] = sg * hs[2 * (8 * k + e) + t] * rs * gp[32 * t + 8 * k + e]; }
                u32x4 w; w.x = cvt_pk_bf16(ov[0], ov[1]); w.y = cvt_pk_bf16(ov[2], ov[3]); w.z = cvt_pk_bf16(ov[4], ov[5]); w.w = cvt_pk_bf16(ov[6], ov[7]);
                *(u32x4*)(op + 32 * t + 8 * k) = w; }
    }
}
}

#define XB_TMO      128
#define XB_XCNT(j)  (256  + 64 * (j))
#define XB_XSUB(j)  (1280 + 64 * (j))
#define XB_XGEN(j)  (2304 + 64 * (j))
#define XB_TOP      3328
#define XB_TOPGEN   3392
#define XCD_BAR_WORDS 3456
#define XB_SPIN_CAP (1u << 22)
__device__ __forceinline__ unsigned xb_ld(unsigned* p)              { return __hip_atomic_load(p, __ATOMIC_RELAXED, __HIP_MEMORY_SCOPE_AGENT); }
__device__ __forceinline__ unsigned xb_add(unsigned* p, unsigned v) { return __hip_atomic_fetch_add(p, v, __ATOMIC_RELAXED, __HIP_MEMORY_SCOPE_AGENT); }
__device__ __forceinline__ unsigned xb_xcc_id() { return (unsigned)__builtin_amdgcn_s_getreg((3 << 11) | 20) & 0xFu; }
#define XB_SPIN(cond, bar) do { unsigned _sp = 0; while (cond) { __builtin_amdgcn_s_sleep(1); \
    if ((++_sp & 255u) == 0u) { if (xb_ld(&(bar)[XB_TMO])) break; if (_sp > XB_SPIN_CAP) { atomicAdd(&(bar)[XB_TMO], 1u); break; } } } } while (0)
__device__ __forceinline__ void xcd_barrier_complete(unsigned* bar, unsigned x, unsigned& nloc, unsigned& nx) {
    const unsigned G = gridDim.x * gridDim.y * gridDim.z;
    unsigned sum, cnt, mine, sp = 0u;
    for (;;) {
        sum = 0u; cnt = 0u; mine = 0u;
#pragma unroll
        for (unsigned j = 0; j < 16; ++j) { const unsigned c = xb_ld(&bar[XB_XCNT(j)]); sum += c; cnt += (c > 0u) ? 1u : 0u; mine = (j == x) ? c : mine; }
        if (sum == G) break;
        __builtin_amdgcn_s_sleep(1);
        if ((++sp & 255u) == 0u) { if (xb_ld(&bar[XB_TMO])) break; if (sp > XB_SPIN_CAP) { atomicAdd(&bar[XB_TMO], 1u); break; } }
    }
    nloc = mine > 0u ? mine : 1u; nx = cnt > 0u ? cnt : 1u;
}
__device__ __forceinline__ void xcd_barrier(unsigned* bar, volatile LAS unsigned* st) {
    asm volatile("s_waitcnt vmcnt(0)" ::: "memory");
    __syncthreads();
    if (threadIdx.x == 0) {
        const unsigned x = xb_xcc_id();
        __builtin_amdgcn_s_waitcnt(0);
        unsigned nloc = st[0], nx = st[1];
        if (nloc == 0u) { xcd_barrier_complete(bar, x, nloc, nx); st[0] = nloc; st[1] = nx; }
        const unsigned old = xb_add(&bar[XB_XSUB(x)], 1u);
        const unsigned gen = old / nloc;
        if (old + 1u == (gen + 1u) * nloc) {
            __builtin_amdgcn_fence(__ATOMIC_RELEASE, "agent");
            asm volatile("s_waitcnt vmcnt(0)" ::: "memory");
            const unsigned og = xb_add(&bar[XB_TOP], 1u);
            const unsigned tg = og / nx;
            if (og + 1u == (tg + 1u) * nx) xb_add(&bar[XB_TOPGEN], 1u);
            else XB_SPIN(xb_ld(&bar[XB_TOPGEN]) == tg, bar);
            __builtin_amdgcn_fence(__ATOMIC_ACQUIRE, "agent");
            xb_add(&bar[XB_XGEN(x)], 1u);
            asm volatile("s_waitcnt vmcnt(0)" ::: "memory");
        } else {
            XB_SPIN(xb_ld(&bar[XB_XGEN(x)]) == gen, bar);
            __builtin_amdgcn_fence(__ATOMIC_ACQUIRE, "agent");
            asm volatile("s_waitcnt vmcnt(0)" ::: "memory");
        }
    }
    __syncthreads();
}

struct Args {
    const float* xin[2]; const float* w_in; const float* gate_bias; const float* lam_q1; const float* lam_k1; const float* lam_q2; const float* lam_k2;
    const float* att_g; const float* lstm_g; const float* w_out; const float* ln1_g; const float* ln1_b; const float* w_gu; const float* conv_w; const float* conv_b;
    const float* w_down; const float* ln2_g; const float* ln2_b; float* out; unsigned char* ws; int ph_lo, ph_hi;
};
constexpr int NPHASE = 31;

__device__ __forceinline__ void transpose_item_fp8(const float* W, int K, int N, unsigned char* WT, int gu_map, const float* g, const float* b, float* c1, float* c2, LAS float* scr, int item, int lane) {
    const int nblk = N / 32, kb = item / nblk, nb = item % nblk, k0 = 64 * kb, n0 = 32 * nb;
    const int ncol = n0 + (lane & 31);
    float a1 = 0.f, a2 = 0.f;
#pragma unroll 8
    for (int i = 0; i < 32; ++i) { const int kk = 2 * i + (lane >> 5); float w = W[(size_t)(k0 + kk) * N + ncol];
        if (g) { a2 += w * b[k0 + kk]; w *= g[k0 + kk]; }
        w *= 64.0f;
        if (g) { const int q8 = __builtin_amdgcn_cvt_pk_fp8_f32(w, 0.f, 0, false); a1 += __builtin_amdgcn_cvt_f32_fp8(q8, 0); }
        scr[kk * 33 + (lane & 31)] = w; }
    asm volatile("s_waitcnt lgkmcnt(0)" ::: "memory");
    if (g) { a1 += __shfl_xor(a1, 32); a2 += __shfl_xor(a2, 32); }
    const int c = lane & 7;
#pragma unroll
    for (int j = 0; j < 4; ++j) { const int nl = (lane >> 3) + 8 * j; const int n = n0 + nl; const LAS float* s = scr + (8 * c) * 33 + nl;
        u32x2 o; o.x = cvt4_fp8(s[0 * 33], s[1 * 33], s[2 * 33], s[3 * 33]); o.y = cvt4_fp8(s[4 * 33], s[5 * 33], s[6 * 33], s[7 * 33]);
        int rowm = n; if (gu_map) { const int n2 = n < DFF ? n : n - DFF; rowm = 256 * (n2 >> 7) + (n < DFF ? 0 : 128) + (n2 & 127); }
        *(u32x2*)(WT + (size_t)rowm * K + k0 + 8 * c) = o; }
    if (g && lane < 32) { const int n2 = ncol < DFF ? ncol : ncol - DFF; const int rowm = 256 * (n2 >> 7) + (ncol < DFF ? 0 : 128) + (n2 & 127);
        atomicAdd(c1 + rowm, a1 * (1.0f / 64.0f)); atomicAdd(c2 + rowm, a2); }
    asm volatile("s_waitcnt lgkmcnt(0)" ::: "memory");
}
__device__ __forceinline__ void transpose_item(const float* W, int K, int N, bf16_t* WT, int gu_map, const float* g, const float* b, float* c1, float* c2, LAS float* scr, int item, int lane) {
    const int nblk = (N + 31) / 32, kb = item / nblk, nb = item % nblk, k0 = 64 * kb, n0 = 32 * nb;
    const int ncol = n0 + (lane & 31); const bool okc = ncol < N;
    float a1 = 0.f, a2 = 0.f;
#pragma unroll 8
    for (int i = 0; i < 32; ++i) { const int kk = 2 * i + (lane >> 5); float w = okc ? W[(size_t)(k0 + kk) * N + ncol] : 0.f;
        if (g) { a2 += w * b[k0 + kk]; w *= g[k0 + kk]; a1 += bf2f(f2bf(w)); }
        scr[kk * 33 + (lane & 31)] = w; }
    asm volatile("s_waitcnt lgkmcnt(0)" ::: "memory");
    if (g) { a1 += __shfl_xor(a1, 32); a2 += __shfl_xor(a2, 32); }
    const int c = lane & 7;
#pragma unroll
    for (int j = 0; j < 4; ++j) { const int nl = (lane >> 3) + 8 * j; const int n = n0 + nl; const LAS float* s = scr + (8 * c) * 33 + nl;
        u32x4 o; o.x = cvt_pk_bf16(s[0 * 33], s[1 * 33]); o.y = cvt_pk_bf16(s[2 * 33], s[3 * 33]); o.z = cvt_pk_bf16(s[4 * 33], s[5 * 33]); o.w = cvt_pk_bf16(s[6 * 33], s[7 * 33]);
        if (n < N) { int rowm = n; if (gu_map) { const int n2 = n < DFF ? n : n - DFF; rowm = 256 * (n2 >> 7) + (n < DFF ? 0 : 128) + (n2 & 127); }
            *(u32x4*)(WT + (size_t)rowm * K + k0 + 8 * c) = o; } }
    if (g && lane < 32 && okc) { int rowm = ncol; if (gu_map) { const int n2 = ncol < DFF ? ncol : ncol - DFF; rowm = 256 * (n2 >> 7) + (ncol < DFF ? 0 : 128) + (n2 & 127); }
        atomicAdd(c1 + rowm, a1); atomicAdd(c2 + rowm, a2); }
    asm volatile("s_waitcnt lgkmcnt(0)" ::: "memory");
}

__device__ __forceinline__ void cvt_rows(const float* x, bf16_t* xb, int gtid, int nthr) {
    for (size_t i = gtid; i < (size_t)MT * DM / 8; i += nthr) {
        const f32x4 a = *(const f32x4*)(x + i * 8), b = *(const f32x4*)(x + i * 8 + 4);
        u32x4 w; w.x = cvt_pk_bf16(a[0], a[1]); w.y = cvt_pk_bf16(a[2], a[3]); w.z = cvt_pk_bf16(b[0], b[1]); w.w = cvt_pk_bf16(b[2], b[3]);
        *(u32x4*)(xb + i * 8) = w; }
}

__global__ void __launch_bounds__(512, 2) fwd(Args args) {
    extern __shared__ __attribute__((aligned(16))) unsigned char lds_raw[];
    LAS unsigned char* lds = (LAS unsigned char*)lds_raw;
#if PROBE_TYPES
    unsigned long long tprev = __builtin_amdgcn_s_memrealtime(), tsel = 0; int ptype = 0;
#endif
    volatile LAS unsigned* xst = (volatile LAS unsigned*)(lds + LDS_BYTES - 32);
    if (threadIdx.x == 0) { xst[0] = 0u; xst[1] = 0u; (void)xb_add((unsigned*)(args.ws + CTL_XBAR) + XB_XCNT(xb_xcc_id()), 1u); }
    __syncthreads();
    for (int ph = args.ph_lo; ph < args.ph_hi; ++ph) {
        if (ph == args.ph_lo + 1) cg::this_grid().sync();
        else if (ph > args.ph_lo) xcd_barrier((unsigned*)(args.ws + CTL_XBAR), xst);
#if PROBE_TYPES
        { const unsigned long long tn = __builtin_amdgcn_s_memrealtime(); if (ph > args.ph_lo && ((PROBE_TYPES >> ptype) & 1)) tsel += tn - tprev; tprev = tn;
          if (ph == 0) ptype = 0; else { const int pp_ = (ph - 1) % 15; ptype = pp_ == 14 ? 8 : 1 + (pp_ % 7); } }
#endif
        const int tid = opaque_tid(), lane = tid & 63, wave = __builtin_amdgcn_readfirstlane(tid >> 6);
        const int G = gridDim.x, gtid = blockIdx.x * 512 + tid, nthr = G * 512;
        size_t wsoff = 0; asm volatile("" : "+s"(wsoff));
        unsigned char* ws = args.ws + wsoff;
        bf16_t* VB = (bf16_t*)(ws + WS_VB); unsigned char* XB8 = ws + WS_HDIR;
        bf16_t* XB = (bf16_t*)(ws + WS_XB); bf16_t* MIXED = (bf16_t*)(ws + WS_MIXED); bf16_t* PROJ = (bf16_t*)(ws + WS_PROJ); bf16_t* HMID = PROJ;
        float* GATES = (float*)(ws + WS_GATES); float* EDGE = (float*)(ws + WS_EDGE);
        f32x2* ST1 = (f32x2*)(ws + WS_ST1); f32x2* ST2 = (f32x2*)(ws + WS_ST2);
        float* LAMV = (float*)(ws + WS_LAM);
        float* C1IN = (float*)(ws + CTL_C1IN); float* C2IN = (float*)(ws + CTL_C2IN); float* C1GU = (float*)(ws + CTL_C1GU); float* C2GU = (float*)(ws + CTL_C2GU);
        unsigned* QCNT = (unsigned*)(ws + WS_CTL);
        if ((PHMASK & 1) && ph == 0) {
            LAS float* scr = (LAS float*)(lds + wave * 8448);
            const int gw = blockIdx.x * 8 + wave, NGW = G * 8;
            constexpr int I_IN = 16 * 97, I_OUT = 16 * 32, I_GU = 16 * 176, I_DN = 44 * 32, I_L = I_IN + I_OUT + I_GU + I_DN;
            for (int it = gw; it < 2 * I_L; it += NGW) {
                const int l = it / I_L; int r = it % I_L;
                if (r < I_IN) { transpose_item(args.w_in + (size_t)l * DM * NIN, DM, NIN, (bf16_t*)(ws + WS_WIN) + (size_t)l * NPROJ_PAD * DM, 0,
                                               l ? args.ln2_g : nullptr, l ? args.ln2_b : nullptr, C1IN, C2IN, scr, r, lane); continue; } r -= I_IN;
                if (r < I_OUT) { transpose_item(args.w_out + (size_t)l * DM * DM, DM, DM, (bf16_t*)(ws + WS_WOUT) + (size_t)l * DM * DM, 0, nullptr, nullptr, nullptr, nullptr, scr, r, lane); continue; } r -= I_OUT;
                if (r < I_GU) { transpose_item_fp8(args.w_gu + (size_t)l * DM * NGU, DM, NGU, (unsigned char*)(ws + WS_WGU) + (size_t)l * NGU * DM, 1,
                                                   args.ln1_g + l * DM, args.ln1_b + l * DM, C1GU + l * NGU, C2GU + l * NGU, scr, r, lane); continue; } r -= I_GU;
                transpose_item_fp8(args.w_down + (size_t)l * DFF * DM, DFF, DM, (unsigned char*)(ws + WS_WDN) + (size_t)l * DM * DFF, 0, nullptr, nullptr, nullptr, nullptr, scr, r, lane);
            }
            for (int i = gtid; i < 2 * (NPROJ_PAD - NIN) * DM / 8; i += nthr) { const int l = i / ((NPROJ_PAD - NIN) * DM / 8), o = i % ((NPROJ_PAD - NIN) * DM / 8);
                *(u32x4*)((bf16_t*)(ws + WS_WIN) + (size_t)l * NPROJ_PAD * DM + (size_t)NIN * DM + (size_t)o * 8) = (u32x4){0u, 0u, 0u, 0u}; }
            if (blockIdx.x == 0 && wave == 0) {
                for (int l = 0; l < 2; ++l) {
                    float s1 = args.lam_q1[l * 64 + lane] * args.lam_k1[l * 64 + lane], s2 = args.lam_q2[l * 64 + lane] * args.lam_k2[l * 64 + lane];
#pragma unroll
                    for (int o = 1; o < 64; o <<= 1) { s1 += __shfl_xor(s1, o); s2 += __shfl_xor(s2, o); }
                    const float lam_init = 0.8f - 0.6f * expf(-0.3f * (float)l);
                    if (lane == 0) LAMV[l] = expf(s1) - expf(s2) + lam_init;
                }
            }
            cvt_rows(args.xin[0], XB, gtid, nthr);
            continue;
        }
        const int trunk = (ph - 1) / 15, pp = (ph - 1) % 15;
        const int seq = trunk ? 2048 : 4096, nseq = trunk ? 32 : 16;
        float* V = args.out + (size_t)trunk * MT * DM;
        if ((PHMASK & 256) && pp == 14) {
            const float* g = args.ln2_g + DM; const float* b = args.ln2_b + DM;
            for (size_t i = gtid; i < (size_t)MT * DM / 8; i += nthr) { const int row = (int)(i >> 7), col = (int)(i & 127) * 8;
                float mu, rstd; row_stats(ST2, row, mu, rstd);
                const u32x4 xw = *(const u32x4*)(VB + i * 8);
                const f32x4 x0 = unph4(xw.x, xw.y), x1 = unph4(xw.z, xw.w);
                const f32x4 g0 = *(const f32x4*)(g + col), g1 = *(const f32x4*)(g + col + 4), b0 = *(const f32x4*)(b + col), b1 = *(const f32x4*)(b + col + 4);
                *(f32x4*)(V + i * 8) = (x0 - mu) * rstd * g0 + b0; *(f32x4*)(V + i * 8 + 4) = (x1 - mu) * rstd * g1 + b1; }
            if (trunk == 0) cvt_rows(args.xin[1], XB, gtid, nthr);
            continue;
        }
        const int l = pp / 7, sp0 = pp % 7, sp = sp0 == 0 ? 0 : sp0 - 1;
        unsigned* KMAX = (unsigned*)(ws + CTL_KMAX) + (trunk * 2 + l) * 128;
        if (sp0 == 1) {
            const int gw = blockIdx.x * 8 + wave, NGW = G * 8;
            for (int chunk = gw; chunk < MT / 32; chunk += NGW) {
                float mx = 0.f;
                for (int i = 0; i < 32; ++i) { const bf16x8 kv = *(const bf16x8*)(PROJ + (size_t)(chunk * 32 + i) * NPROJ + 512 + lane * 8); float ss = 0.f;
#pragma unroll
                    for (int e = 0; e < 8; ++e) { const float x = bf2f((bf16_t)kv[e]); ss += x * x; }
                    ss += __shfl_xor(ss, 1); ss += __shfl_xor(ss, 2); ss += __shfl_xor(ss, 4); mx = fmaxf(mx, ss); }
                if ((lane & 7) == 0) atomicMax(KMAX + ((chunk * 32) / seq) * 4 + (lane >> 4), __float_as_uint(mx));
            }
        } else if ((PHMASK & 2) && sp == 0) {
            pg8::Gemm g{XB, (const bf16_t*)(ws + WS_WIN) + (size_t)l * NPROJ_PAD * DM, MT, NPROJ_PAD, DM};
            pg8::StaticOrder S; S.init(MT, NPROJ_PAD, G, (int)blockIdx.x);
            EpiProj E{PROJ, GATES, args.gate_bias + l * 16, l ? ST2 : nullptr, C1IN, C2IN, (LAS f32x2*)(lds + EPI_LDS + 8192)};
            pg8::gemm_phase<EpiProj, pg8::StaticOrder>(lds, g, S, E);
        } else if ((PHMASK & 12) && sp == 1) {
            unsigned* qc = QCNT + (size_t)((trunk * 2 + l) * 8) * 64;
            const int myx = (int)(__builtin_amdgcn_s_getreg((3 << 11) | 20) & 7);
            const int npair = nseq / 2, nqb = seq / 128, nitems = npair * (2 + nqb);
            unsigned* FLAG = (unsigned*)(ws + CTL_FLAG) + (trunk * 2 + l) * 128;
            bf16_t* HDIR = (bf16_t*)(ws + WS_HDIR);
            const float lam = LAMV[l]; const float lam_init = 0.8f - 0.6f * expf(-0.3f * (float)l);
            LAS int* sitem = (LAS int*)(lds + LDS_BYTES - 64);
            for (int qq = 0; qq < 8; ++qq) {
                const int x = (myx + qq) & 7;
                for (;;) {
                    if (tid == 0) sitem[0] = (int)atomicAdd(qc + 64 * x, 1u);
                    __syncthreads();
                    const int item = sitem[0];
                    __syncthreads();
                    if (item >= nitems) break;
                    const int nbh = nseq / 8;
                    if ((PHMASK & 4) && item < 2 * npair) {
                        const int pi = item >> 1, dir = item & 1, h = 3 - pi / nbh, b = ((x - 2 * h) & 7) + 8 * (pi % nbh);
                        ml::mlstm_dir(PROJ, GATES, HDIR + (size_t)dir * MT * 512, seq, (long)b * seq, h, dir, lds);
                        __threadfence();
                        __syncthreads();
                        if (tid == 0) sitem[1] = (int)atomicAdd(FLAG + b * 4 + h, 1u);
                        __syncthreads();
                        const int old = sitem[1];
                        if (old == 1) { __threadfence(); ml::mlstm_combine(PROJ, HDIR, HDIR + (size_t)MT * 512, MIXED, args.lstm_g + l * 512, seq, (long)b * seq, h); }
                        __syncthreads();
                    } else if (PHMASK & 8) {
                        const int a = item - 2 * npair, pi = a / nqb, qb = a % nqb, h = 3 - pi / nbh, b = ((x - 2 * h) & 7) + 8 * (pi % nbh);
                        const float slope = exp2f(-2.0f * (float)(h + 1));
                        att::attn_unit(PROJ, MIXED, args.att_g + l * 512, seq, (long)b * seq, h, qb, lam, -slope, 1.0f - lam_init, __uint_as_float(KMAX[b * 4 + h]), (LAS char*)lds);
                    }
                }
            }
        } else if ((PHMASK & 16) && sp == 2) {
            pg8::Gemm g{MIXED, (const bf16_t*)(ws + WS_WOUT) + (size_t)l * DM * DM, MT, DM, DM};
            pg8::StaticOrder S; S.init(MT, DM, G, (int)blockIdx.x);
            if (l == 0) { EpiRes<true> E{XB, VB, nullptr, args.ln2_g, args.ln2_b, ST1, (LAS f32x2*)(lds + EPI_LDS), (LAS f32x2*)(lds + EPI_LDS + 8192), XB8, 1.0f, nullptr};
                          pg8::gemm_phase<EpiRes<true>, pg8::StaticOrder>(lds, g, S, E); }
            else { EpiRes<false> E{VB, VB, ST2, args.ln2_g, args.ln2_b, ST1, (LAS f32x2*)(lds + EPI_LDS), (LAS f32x2*)(lds + EPI_LDS + 8192), XB8, 1.0f, nullptr};
                   pg8::gemm_phase<EpiRes<false>, pg8::StaticOrder>(lds, g, S, E); }
        } else if ((PHMASK & 32) && sp == 3) {
            pg8::Gemm g{XB8, (const unsigned char*)(ws + WS_WGU) + (size_t)l * NGU * DM, MT, NGU, DM};
            pg8::StaticOrder S; S.init(MT, NGU, G, (int)blockIdx.x);
            EpiGU E{(unsigned char*)HMID, EDGE, ST1, C1GU + l * NGU, C2GU + l * NGU, args.conv_w + (size_t)l * 3 * DFF, args.conv_b + (size_t)l * DFF, (LAS float*)(lds + EPI_LDS), (LAS f32x2*)(lds + EPI_LDS + 8192)};
            pg8::gemm_phase<EpiGU, pg8::StaticOrder, true>(lds, g, S, E);
        } else if ((PHMASK & 64) && sp == 4) {
            const float* cw = args.conv_w + (size_t)l * 3 * DFF; const float* cb = args.conv_b + (size_t)l * DFF; const int st = seq / 256;
            for (int i = gtid; i < 256 * 2 * (DFF / 4); i += nthr) {
                const int grp = i % (DFF / 4), e2 = (i / (DFF / 4)) & 1, pm = i / (2 * (DFF / 4)), j = grp * 4;
                const float* Ep = EDGE + (size_t)pm * 6 * DFF + j;
                const f32x4 w0 = *(const f32x4*)(cw + j), w1 = *(const f32x4*)(cw + DFF + j), w2 = *(const f32x4*)(cw + 2 * DFF + j), cbv = *(const f32x4*)(cb + j);
                f32x4 ga, gb, gc, up; const f32x4 z = (f32x4){0.f, 0.f, 0.f, 0.f}; int row;
                if (e2 == 0) { ga = (pm % st == 0) ? z : *(const f32x4*)(Ep - 6 * DFF + 3 * DFF); gb = *(const f32x4*)(Ep); gc = *(const f32x4*)(Ep + DFF); up = *(const f32x4*)(Ep + 4 * DFF); row = pm * 256; }
                else { ga = *(const f32x4*)(Ep + 2 * DFF); gb = *(const f32x4*)(Ep + 3 * DFF); gc = (pm % st == st - 1) ? z : *(const f32x4*)(Ep + 6 * DFF); up = *(const f32x4*)(Ep + 5 * DFF); row = pm * 256 + 255; }
                const f32x4 cv = cbv + w0 * ga + w1 * gb + w2 * gc;
                *(unsigned*)((unsigned char*)HMID + (size_t)row * DFF + j) = cvt4_fp8(gelu_erf(cv[0]) * up[0] * 16.f, gelu_erf(cv[1]) * up[1] * 16.f, gelu_erf(cv[2]) * up[2] * 16.f, gelu_erf(cv[3]) * up[3] * 16.f); }
        } else if (PHMASK & 128) {
            pg8::Gemm g{HMID, (const unsigned char*)(ws + WS_WDN) + (size_t)l * DM * DFF, MT, DM, DFF};
            pg8::StaticOrder S; S.init(MT, DM, G, (int)blockIdx.x);
            EpiRes<false> E{VB, VB, ST1, args.ln1_g + l * DM, args.ln1_b + l * DM, ST2, (LAS f32x2*)(lds + EPI_LDS), (LAS f32x2*)(lds + EPI_LDS + 8192), nullptr, 1.0f / 1024.0f, l == 0 ? XB : nullptr};
            pg8::gemm_phase<EpiRes<false>, pg8::StaticOrder, true>(lds, g, S, E);
        }
    }
#if PROBE_TYPES
    { const unsigned long long tn = __builtin_amdgcn_s_memrealtime(); if ((PROBE_TYPES >> ptype) & 1) tsel += tn - tprev;
      if (blockIdx.x == 0 && threadIdx.x == 0) { while (__builtin_amdgcn_s_memrealtime() - tn < tsel) __builtin_amdgcn_s_sleep(8); } }
#endif
}

extern "C" void kernel_launch(void* const* d_in, const int* in_sizes, int n_in, void* d_out, int out_size, void* d_ws, size_t ws_size, hipStream_t stream) {
    static int grid = 0;
    if (grid == 0) {
        if (n_in != 19 || ws_size < WS_END) { fprintf(stderr, "kernel_launch: unexpected n_in %d / ws %zu\n", n_in, ws_size); grid = -1; return; }
        int dev = 0, cus = 0, per_cu = 0;
        hipGetDevice(&dev); hipDeviceGetAttribute(&cus, hipDeviceAttributeMultiprocessorCount, dev);
        if (hipFuncSetAttribute((const void*)fwd, hipFuncAttributeMaxDynamicSharedMemorySize, LDS_BYTES) != hipSuccess) { fprintf(stderr, "kernel_launch: hipFuncSetAttribute failed\n"); grid = -1; return; }
        hipOccupancyMaxActiveBlocksPerMultiprocessor(&per_cu, (const void*)fwd, 512, LDS_BYTES);
        (void)hipGetLastError();
        if (per_cu < 1) per_cu = 1;
        grid = cus;
    }
    if (grid < 0) return;
    hipMemsetAsync((char*)d_ws + WS_CTL, 0, CTL_BYTES, stream);
    Args a{};
    a.xin[0] = (const float*)d_in[0]; a.xin[1] = (const float*)d_in[1]; a.w_in = (const float*)d_in[2]; a.gate_bias = (const float*)d_in[3];
    a.lam_q1 = (const float*)d_in[4]; a.lam_k1 = (const float*)d_in[5]; a.lam_q2 = (const float*)d_in[6]; a.lam_k2 = (const float*)d_in[7];
    a.att_g = (const float*)d_in[8]; a.lstm_g = (const float*)d_in[9]; a.w_out = (const float*)d_in[10]; a.ln1_g = (const float*)d_in[11]; a.ln1_b = (const float*)d_in[12];
    a.w_gu = (const float*)d_in[13]; a.conv_w = (const float*)d_in[14]; a.conv_b = (const float*)d_in[15]; a.w_down = (const float*)d_in[16]; a.ln2_g = (const float*)d_in[17]; a.ln2_b = (const float*)d_in[18];
    a.out = (float*)d_out; a.ws = (unsigned char*)d_ws;
#if MK_MULTI
    for (int ph = 0; ph < NPHASE; ++ph) { a.ph_lo = ph; a.ph_hi = ph + 1; hipLaunchKernelGGL(fwd, dim3(grid), dim3(512), LDS_BYTES, stream, a); }
#else
    a.ph_lo = 0; a.ph_hi = NPHASE;
    void* kargs[] = {&a};
    hipError_t e = hipLaunchCooperativeKernel((const void*)fwd, dim3(grid), dim3(512), kargs, LDS_BYTES, stream);
    if (e != hipSuccess) fprintf(stderr, "kernel_launch: cooperative launch failed: %s (grid %d)\n", hipGetErrorString(e), grid);
#endif
}
```
